# Optimizing an MI355X kernel written in HIP

```python
import jax, jax.numpy as jnp
from jax import lax
import numpy as np

D_MODEL = 2048
BATCH = 8
SEQ = 2048
DEPTH = 1

MEM_LEN = 256
EPS = 1e-6

GLA_HEADS = 4
GLA_DK = D_MODEL // (4 * GLA_HEADS)
GLA_DV = D_MODEL // (2 * GLA_HEADS)
GLA_GATE_RANK = 16
GLA_TAU = 16.0
GLA_CHUNK = 64

SG_GROUPS = 4
SG_DIM = D_MODEL // (2 * SG_GROUPS)
SG_CHUNK = 128

XA_HEADS = 4
XA_DIM = D_MODEL // (2 * XA_HEADS)

BRANCH_W = D_MODEL // 2
N_BRANCH = 3
D_FF = 256 * ((8 * D_MODEL // 3 + 255) // 256)

IN_SPLITS = (GLA_HEADS * GLA_DK,
             GLA_HEADS * GLA_DK,
             GLA_HEADS * GLA_DV,
             GLA_HEADS * GLA_DV,
             GLA_GATE_RANK,
             SG_GROUPS * SG_DIM,
             SG_GROUPS * SG_DIM,
             XA_HEADS * XA_DIM,
             N_BRANCH * D_MODEL)
IN_WIDTH = 12304

kernel_name = "hybrid_gla_gmlp_memxattn_macaron"


def rmsnorm(x, g):
    xf = x.astype(jnp.float32)
    y = xf * lax.rsqrt(jnp.mean(xf * xf, axis=-1, keepdims=True) + EPS)
    return (y * g.astype(jnp.float32)).astype(x.dtype)


def swiglu(h, w_gate, w_up, w_down):
    return (jax.nn.silu(h @ w_gate) * (h @ w_up)) @ w_down


def gla(q, k, v, log_a, r, out_norm):
    B, S, H, dk = q.shape
    dv = v.shape[-1]
    C = GLA_CHUNK
    n = S // C

    def to_chunks(t):
        return t.astype(jnp.float32).reshape(B, n, C, H, t.shape[-1]).transpose(1, 0, 3, 2, 4)

    qc = to_chunks(q) * (dk ** -0.5)
    kc, vc, gc = to_chunks(k), to_chunks(v), to_chunks(log_a)
    mask = jnp.tril(jnp.ones((C, C), dtype=bool))[:, :, None]

    def step(state, inp):
        qb, kb, vb, gb = inp
        b = jnp.cumsum(gb, axis=2)
        inter = jnp.einsum('bhtd,bhde->bhte', qb * jnp.exp(b), state)
        diff = b[:, :, :, None, :] - b[:, :, None, :, :]
        decay = jnp.exp(jnp.where(mask, diff, -jnp.inf))
        scores = jnp.einsum('bhtd,bhsd,bhtsd->bhts', qb, kb, decay)
        intra = jnp.einsum('bhts,bhse->bhte', scores, vb)
        b_last = b[:, :, -1:, :]
        new_state = (jnp.exp(b_last[:, :, 0, :])[..., None] * state
                     + jnp.einsum('bhsd,bhse->bhde', kb * jnp.exp(b_last - b), vb))
        return new_state, inter + intra

    s0 = jnp.zeros((B, H, dk, dv), jnp.float32)
    _, o = lax.scan(step, s0, (qc, kc, vc, gc))
    o = o.transpose(1, 0, 3, 2, 4).reshape(B, S, H, dv)
    o = o * lax.rsqrt(jnp.mean(o * o, axis=-1, keepdims=True) + EPS) * out_norm.astype(jnp.float32)
    o = o * jax.nn.silu(r.astype(jnp.float32))
    return o.reshape(B, S, H * dv).astype(v.dtype)


def spatial_gating(u_pre, v_pre, ln_g, ln_b, w_s, b_s):
    B, S, _ = u_pre.shape
    G, c, T = SG_GROUPS, SG_DIM, SG_CHUNK
    u = jax.nn.gelu(u_pre, approximate=False).reshape(B, S, G, c)
    v = jax.nn.gelu(v_pre, approximate=False).reshape(B, S, G, c).astype(jnp.float32)
    mu = jnp.mean(v, axis=-1, keepdims=True)
    var = jnp.mean((v - mu) ** 2, axis=-1, keepdims=True)
    v = (v - mu) * lax.rsqrt(var + EPS) * ln_g.astype(jnp.float32) + ln_b.astype(jnp.float32)
    v = v.reshape(B, S // T, T, G, c)
    w = w_s.astype(jnp.float32) * jnp.tril(jnp.ones((T, T), jnp.float32))
    v = jnp.einsum('gts,bnsgc->bntgc', w, v) + b_s.astype(jnp.float32).T[:, :, None]
    out = u.astype(jnp.float32) * v.reshape(B, S, G, c)
    return out.reshape(B, S, G * c).astype(u_pre.dtype)


def memory_attention(q, mem_n, w_kv_mem):
    B, S, H, dh = q.shape
    M = mem_n.shape[1]
    kv = mem_n @ w_kv_mem
    k, v = jnp.split(kv, 2, axis=-1)
    k = k.reshape(B, M, H, dh)
    v = v.reshape(B, M, H, dh)
    s = jnp.einsum('bshd,bmhd->bhsm', q, k).astype(jnp.float32) * (dh ** -0.5)
    p = jax.nn.softmax(s, axis=-1).astype(v.dtype)
    o = jnp.einsum('bhsm,bmhd->bshd', p, v)
    return o.reshape(B, S, H * dh)


def mixer(h, mem_n, w_in, gla_w_gate_up, gla_gate_bias, gla_out_norm,
          sg_ln_g, sg_ln_b, sg_w_s, sg_b_s, w_kv_mem, w_branch, w_out):
    B, S, D = h.shape
    offsets = []
    acc = 0
    for width in IN_SPLITS[:-1]:
        acc += width
        offsets.append(acc)
    proj = h @ w_in
    q, k, v, r, g_lr, su, sv, xq, gate_pre = jnp.split(proj, offsets, axis=-1)

    log_a = jax.nn.log_sigmoid((g_lr @ gla_w_gate_up + gla_gate_bias).astype(jnp.float32)) / GLA_TAU
    y_gla = gla(q.reshape(B, S, GLA_HEADS, GLA_DK), k.reshape(B, S, GLA_HEADS, GLA_DK),
                v.reshape(B, S, GLA_HEADS, GLA_DV), log_a.reshape(B, S, GLA_HEADS, GLA_DK),
                r.reshape(B, S, GLA_HEADS, GLA_DV), gla_out_norm)
    y_sg = spatial_gating(su, sv, sg_ln_g, sg_ln_b, sg_w_s, sg_b_s)
    y_xa = memory_attention(xq.reshape(B, S, XA_HEADS, XA_DIM), mem_n, w_kv_mem)

    gates = jax.nn.sigmoid(gate_pre.astype(jnp.float32)).reshape(B, S, N_BRANCH, D)
    merged = jnp.zeros((B, S, D), jnp.float32)
    for i, y in enumerate((y_gla, y_sg, y_xa)):
        merged = merged + gates[:, :, i, :] * (y @ w_branch[i]).astype(jnp.float32)
    return merged.astype(h.dtype) @ w_out


def setup_inputs(seed: int = 0) -> dict:
    key = jax.random.key(seed)
    ks = jax.random.split(key, 24)
    f32 = jnp.float32
    L, D = DEPTH, D_MODEL

    def nrm(k, shape, scale):
        return jax.random.normal(k, shape, f32) * scale

    def gain(k, shape):
        return 1.0 + 0.01 * jax.random.normal(k, shape, f32)

    return {
        "x": jax.random.normal(ks[0], (BATCH, SEQ, D), f32),
        "mem": jax.random.normal(ks[1], (BATCH, MEM_LEN, D), f32),
        "ffn1_norm": gain(ks[2], (L, D)),
        "ffn1_w_gate": nrm(ks[3], (L, D, D_FF), D ** -0.5),
        "ffn1_w_up": nrm(ks[4], (L, D, D_FF), D ** -0.5),
        "ffn1_w_down": nrm(ks[5], (L, D_FF, D), D_FF ** -0.5),
        "mix_norm": gain(ks[6], (L, D)),
        "mem_norm": gain(ks[7], (L, D)),
        "w_in": nrm(ks[8], (L, D, IN_WIDTH), D ** -0.5),
        "gla_w_gate_up": nrm(ks[9], (L, GLA_GATE_RANK, GLA_HEADS * GLA_DK), GLA_GATE_RANK ** -0.5),
        "gla_gate_bias": nrm(ks[10], (L, GLA_HEADS * GLA_DK), 0.01),
        "gla_out_norm": gain(ks[11], (L, GLA_HEADS, GLA_DV)),
        "sg_ln_g": gain(ks[12], (L, SG_GROUPS, SG_DIM)),
        "sg_ln_b": nrm(ks[13], (L, SG_GROUPS, SG_DIM), 0.01),
        "sg_w_s": nrm(ks[14], (L, SG_GROUPS, SG_CHUNK, SG_CHUNK), SG_CHUNK ** -0.5),
        "sg_b_s": gain(ks[15], (L, SG_GROUPS, SG_CHUNK)),
        "w_kv_mem": nrm(ks[16], (L, D, 2 * XA_HEADS * XA_DIM), D ** -0.5),
        "w_branch": nrm(ks[17], (L, N_BRANCH, BRANCH_W, D), BRANCH_W ** -0.5),
        "w_out": nrm(ks[18], (L, D, D), D ** -0.5),
        "ffn2_norm": gain(ks[19], (L, D)),
        "ffn2_w_gate": nrm(ks[20], (L, D, D_FF), D ** -0.5),
        "ffn2_w_up": nrm(ks[21], (L, D, D_FF), D ** -0.5),
        "ffn2_w_down": nrm(ks[22], (L, D_FF, D), D_FF ** -0.5),
        "final_norm": gain(ks[23], (D,)),
    }


def reference(x, mem, ffn1_norm, ffn1_w_gate, ffn1_w_up, ffn1_w_down, mix_norm, mem_norm,
              w_in, gla_w_gate_up, gla_gate_bias, gla_out_norm, sg_ln_g, sg_ln_b, sg_w_s, sg_b_s,
              w_kv_mem, w_branch, w_out, ffn2_norm, ffn2_w_gate, ffn2_w_up, ffn2_w_down, final_norm):
    for l in range(DEPTH):
        x = x + 0.5 * swiglu(rmsnorm(x, ffn1_norm[l]), ffn1_w_gate[l], ffn1_w_up[l], ffn1_w_down[l])
        h = rmsnorm(x, mix_norm[l])
        mem_n = rmsnorm(mem, mem_norm[l])
        x = x + mixer(h, mem_n, w_in[l], gla_w_gate_up[l], gla_gate_bias[l], gla_out_norm[l],
                      sg_ln_g[l], sg_ln_b[l], sg_w_s[l], sg_b_s[l], w_kv_mem[l], w_branch[l], w_out[l])
        x = x + 0.5 * swiglu(rmsnorm(x, ffn2_norm[l]), ffn2_w_gate[l], ffn2_w_up[l], ffn2_w_down[l])
    return rmsnorm(x, final_norm)
```

```cpp
#include <hip/hip_runtime.h>
#include <cstdio>
#include <cstdint>

#ifndef MK_PER_PHASE
#define MK_PER_PHASE 0
#endif
#ifndef MK_DEBUG
#define MK_DEBUG 0
#endif
#ifndef MK_DEBUG_ONLY
#define MK_DEBUG_ONLY (-1)
#endif

#define GAS __attribute__((address_space(1)))
#define LAS __attribute__((address_space(3)))
typedef unsigned short bf16;
typedef unsigned v4u __attribute__((ext_vector_type(4)));
typedef unsigned v2u __attribute__((ext_vector_type(2)));
typedef float f32x4 __attribute__((ext_vector_type(4)));
typedef float f32x2 __attribute__((ext_vector_type(2)));
typedef float f32x16 __attribute__((ext_vector_type(16)));
typedef short bf16x8 __attribute__((ext_vector_type(8)));
typedef __bf16 bf16x2_t __attribute__((ext_vector_type(2)));

constexpr int D = 2048, BATCH = 8, SEQ = 2048, M = BATCH * SEQ, MEMLEN = 256, MROWS = BATCH * MEMLEN;
constexpr int DFF = 5632, NGU = 2 * DFF;
constexpr int INW = 12304;
constexpr int NPROJ = 6144;
constexpr float EPS = 1e-6f;
constexpr int NWAVES = 8, NTHREADS = 512;

constexpr size_t MiB = 1u << 20;
constexpr size_t WS_CTL = 0, CTL_ZERO_BYTES = 1 * MiB;
constexpr size_t WS_GLR = 1 * MiB;
constexpr size_t WS_ADEC = 2 * MiB;
constexpr size_t WS_WGLR = 2 * MiB + 512 * 1024;
constexpr size_t WS_KB = 3 * MiB;
constexpr size_t WS_VT = 7 * MiB;
constexpr size_t WS_MEMB = 11 * MiB;
constexpr size_t WS_WGU1 = 20 * MiB;
constexpr size_t WS_WD1 = 64 * MiB;
constexpr size_t WS_WIN = 86 * MiB;
constexpr size_t WS_WKV = 134 * MiB;
constexpr size_t WS_WB = 142 * MiB;
constexpr size_t WS_WO = 154 * MiB;
constexpr size_t WS_WGU2 = 162 * MiB;
constexpr size_t WS_WD2 = 206 * MiB;
constexpr size_t WS_XB = 228 * MiB;
constexpr size_t WS_C = 292 * MiB;
constexpr size_t WS_ACT = WS_C;
constexpr size_t WS_Q = WS_C;
constexpr size_t WS_K = WS_C + 16 * MiB;
constexpr size_t WS_V = WS_C + 32 * MiB;
constexpr size_t WS_SU = WS_C + 64 * MiB;
constexpr size_t WS_XQ = WS_C + 96 * MiB;
constexpr size_t WS_R = WS_C + 128 * MiB;
constexpr size_t WS_SV = WS_C + 160 * MiB;
constexpr size_t WS_MRG = WS_R;
constexpr size_t WS_G = WS_C + 192 * MiB;
constexpr size_t WS_END = WS_C + 256 * MiB;

constexpr int CW_TMO = 0;
constexpr int CW_BAR = 4096;
constexpr size_t CTL_SS1 = 128 * 1024, CTL_SS2 = 192 * 1024;
constexpr size_t CTL_DBG = 256 * 1024;

constexpr int RING_BYTES = 131072;
constexpr int MISC_OFF = RING_BYTES + 320;
constexpr int LDS_BYTES = 147456;

#define LDS_WAIT() asm volatile("s_waitcnt lgkmcnt(0)" ::: "memory")
#define VM_WAIT() asm volatile("s_waitcnt vmcnt(0)" ::: "memory")
__device__ __forceinline__ unsigned cvtpk(float lo, float hi) { f32x2 v = {lo, hi}; bf16x2_t b = __builtin_convertvector(v, bf16x2_t); return __builtin_bit_cast(unsigned, b); }
__device__ __forceinline__ float bflo(unsigned u) { return __builtin_bit_cast(float, u << 16); }
__device__ __forceinline__ float bfhi(unsigned u) { return __builtin_bit_cast(float, u & 0xffff0000u); }
__device__ __forceinline__ float bf2f(bf16 b) { return __builtin_bit_cast(float, (unsigned)b << 16); }
__device__ __forceinline__ bf16 f2bf(float f) { return (bf16)(cvtpk(f, 0.f) & 0xffffu); }
__device__ __forceinline__ float wave_sum(float v) {
#pragma unroll
    for (int o = 1; o < 64; o <<= 1) v += __shfl_xor(v, o);
    return v;
}
__device__ __forceinline__ float fast_exp(float x) { return __builtin_amdgcn_exp2f(x * 1.4426950408889634f); }
__device__ __forceinline__ float sigmoidf_(float x) { return __builtin_amdgcn_rcpf(1.0f + fast_exp(-x)); }

namespace pg8 {
constexpr int BM = 256, BK = 64, HALF = 128, HTB = HALF * BK * 2, STAGE_BYTES = 8 * HTB, NXCD = 8, WGM = 8;
__host__ __device__ __forceinline__ int lds_byte(int r, int c) { const int st = (r >> 4) * 2 + (c >> 5), rr = r & 15, cc = c & 31, ob = rr * 64 + cc * 2; return st * 1024 + (ob ^ (((ob >> 9) & 1) << 5)); }
__host__ __device__ __forceinline__ void stage_rc(int b, int& R, int& C) { const int st = b / 1024, sb = b % 1024, swz = sb ^ (((sb >> 9) & 1) << 5); R = (st >> 1) * 16 + swz / 64; C = (st & 1) * 32 + (swz % 64) / 2; }
__host__ __device__ __forceinline__ int perm32(int rho) { const int n = rho >> 4, i = rho & 15; return 8 * (i >> 2) + 4 * n + (i & 3); }

struct Unit { const char* A; const char* B; int pm, pn, kind; };

__device__ __forceinline__ void tile_of(int L, int nM, int nN, int& pm, int& pn) {
    const int nwg = nM * nN;
    int wgid = L; { const int q = nwg / NXCD, r = nwg % NXCD, xcd = wgid % NXCD, off = wgid / NXCD; wgid = (xcd < r ? xcd * (q + 1) : r * (q + 1) + (xcd - r) * q) + off; }
    const int nig = WGM * nN, gid = wgid / nig, fm = gid * WGM, gsz = (nM - fm) < WGM ? (nM - fm) : WGM;
    pm = fm + ((wgid % nig) % gsz); pn = (wgid % nig) / gsz;
}

template <class Epi, class Sched>
__device__ __forceinline__ void gemm_phase(LAS unsigned char* lds, const int K, const int lda, const int ldb, const Sched& S, const Epi& E) {
    const int tid = threadIdx.x, wid = __builtin_amdgcn_readfirstlane(tid >> 6), lane = tid & 63, wr = wid >> 2, wc = wid & 3, fr = lane & 15, fq = lane >> 4;
    const int nt = K / BK;
    unsigned voffA[2], voffB[2];
#pragma unroll
    for (int i = 0; i < 2; ++i) { int R, C; stage_rc(tid * 16 + i * 8192, R, C); const int Rb = (R & ~31) + perm32(R & 31);
        voffA[i] = (unsigned)(R * lda + C) * 2u; voffB[i] = (unsigned)(Rb * ldb + C) * 2u; }
    const size_t kstep = (size_t)(BK * 2);
    const size_t hstepA = (size_t)HALF * lda * 2, hstepB = (size_t)HALF * ldb * 2;
    const unsigned ldsw = (unsigned)wid * 1024u;
    const int aoff = lds_byte(wr * 64 + fr, fq * 8), boff = lds_byte(wc * 32 + fr, fq * 8);
#define PG8_SA(b, h) (((b) * 2 + (h)) * HTB)
#define PG8_SB(b, h) ((4 + (b) * 2 + (h)) * HTB)
#define PG8_STAGE(bufoff, gbase, voff) do { _Pragma("unroll") for (int _i = 0; _i < 2; ++_i) \
        __builtin_amdgcn_global_load_lds((const unsigned*)((const char*)(gbase) + (voff)[_i]), (LAS unsigned*)(lds + (bufoff) + ldsw + _i * 8192), 16, 0, 0); } while (0)
#define PG8_LDA(dst, b, h) do { _Pragma("unroll") for (int m = 0; m < 4; ++m) _Pragma("unroll") for (int k = 0; k < 2; ++k) dst[m][k] = *(const LAS bf16x8*)(lds + PG8_SA(b, h) + aoff + m * 2048 + k * 1024); } while (0)
#define PG8_LDB(dst, b, h) do { _Pragma("unroll") for (int n = 0; n < 2; ++n) _Pragma("unroll") for (int k = 0; k < 2; ++k) dst[n][k] = *(const LAS bf16x8*)(lds + PG8_SB(b, h) + boff + n * 2048 + k * 1024); } while (0)
#define PG8_MMA(ai, bj, At, Bt) do { __builtin_amdgcn_s_setprio(1); _Pragma("unroll") for (int m = 0; m < 4; ++m) _Pragma("unroll") for (int n = 0; n < 2; ++n) _Pragma("unroll") for (int k = 0; k < 2; ++k) \
        acc[ai][bj][m][n] = __builtin_amdgcn_mfma_f32_16x16x32_bf16(Bt[n][k], At[m][k], acc[ai][bj][m][n], 0, 0, 0); __builtin_amdgcn_s_setprio(0); } while (0)
#define PG8_WAIT_V(n) asm volatile("s_waitcnt vmcnt(" #n ")" ::: "memory")
#define PG8_WAIT_L(n) asm volatile("s_waitcnt lgkmcnt(" #n ")" ::: "memory")
#define PG8_BAR __builtin_amdgcn_s_barrier()
#define PG8_SCHED __builtin_amdgcn_sched_barrier(0)
    Unit cur, nxt; int ui = 0;
    if (!S.next(0, cur)) return;
    f32x4 acc[2][2][4][2];
#pragma unroll
    for (int a = 0; a < 2; ++a)
#pragma unroll
        for (int b = 0; b < 2; ++b)
#pragma unroll
            for (int m = 0; m < 4; ++m)
#pragma unroll
                for (int n = 0; n < 2; ++n) acc[a][b][m][n] = (f32x4){0.f, 0.f, 0.f, 0.f};
    bf16x8 At[4][2], B0[2][2], B1[2][2];
    const char* cA = cur.A; const char* cB = cur.B;
    PG8_STAGE(PG8_SB(0, 0), cB, voffB); PG8_STAGE(PG8_SB(0, 1), cB + hstepB, voffB); PG8_STAGE(PG8_SA(0, 0), cA, voffA); PG8_STAGE(PG8_SA(0, 1), cA + hstepA, voffA);
    if (wr == 1) PG8_BAR;
    PG8_WAIT_V(2); PG8_BAR;
    PG8_STAGE(PG8_SB(1, 0), cB + kstep, voffB); PG8_STAGE(PG8_SA(1, 0), cA + kstep, voffA); PG8_STAGE(PG8_SB(1, 1), cB + hstepB + kstep, voffB);
    PG8_WAIT_V(6); PG8_BAR;
    for (;;) {
        const bool has_next = S.next(ui + 1, nxt);
        const char* nA = has_next ? nxt.A : cA; const char* nB = has_next ? nxt.B : cB;
        for (int t = 0; t < nt; t += 2) {
            const bool last = (t == nt - 2);
            const char* a1 = cA + (size_t)(t + 1) * kstep;
            const char* a2 = last ? nA : cA + (size_t)(t + 2) * kstep; const char* b2 = last ? nB : cB + (size_t)(t + 2) * kstep;
            const char* a3 = a2 + kstep; const char* b3 = b2 + kstep;
            PG8_LDB(B0, 0, 0); PG8_LDB(B1, 0, 1); PG8_SCHED; PG8_LDA(At, 0, 0); PG8_STAGE(PG8_SA(1, 1), a1 + hstepA, voffA);
            PG8_WAIT_V(8); PG8_WAIT_L(0); PG8_BAR; PG8_MMA(0, 0, At, B0); PG8_MMA(0, 1, At, B1); PG8_BAR; PG8_SCHED;
            PG8_LDA(At, 0, 1); PG8_STAGE(PG8_SB(0, 0), b2, voffB); PG8_STAGE(PG8_SB(0, 1), b2 + hstepB, voffB); PG8_STAGE(PG8_SA(0, 0), a2, voffA);
            PG8_WAIT_V(8); PG8_WAIT_L(0); PG8_BAR; PG8_MMA(1, 0, At, B0); PG8_MMA(1, 1, At, B1); PG8_BAR; PG8_SCHED;
            PG8_LDB(B0, 1, 0); PG8_LDB(B1, 1, 1); PG8_SCHED; PG8_LDA(At, 1, 0); PG8_STAGE(PG8_SA(0, 1), a2 + hstepA, voffA);
            PG8_WAIT_V(8); PG8_WAIT_L(0); PG8_BAR; PG8_MMA(0, 0, At, B0); PG8_MMA(0, 1, At, B1); PG8_BAR; PG8_SCHED;
            PG8_LDA(At, 1, 1); PG8_STAGE(PG8_SB(1, 0), b3, voffB); PG8_STAGE(PG8_SB(1, 1), b3 + hstepB, voffB); PG8_STAGE(PG8_SA(1, 0), a3, voffA);
            PG8_WAIT_V(8); PG8_WAIT_L(0); PG8_BAR; PG8_MMA(1, 0, At, B0); PG8_MMA(1, 1, At, B1); PG8_BAR; PG8_SCHED;
        }
        if (wr == 0) PG8_BAR;
        E(acc, cur, wr, wc, fr, fq);
        if (!has_next) break;
#pragma unroll
        for (int a = 0; a < 2; ++a)
#pragma unroll
            for (int b = 0; b < 2; ++b)
#pragma unroll
                for (int m = 0; m < 4; ++m)
#pragma unroll
                    for (int n = 0; n < 2; ++n) acc[a][b][m][n] = (f32x4){0.f, 0.f, 0.f, 0.f};
        cur = nxt; cA = nA; cB = nB; ++ui;
        if (wr == 1) PG8_BAR;
    }
    PG8_WAIT_V(0);
    PG8_BAR;
#undef PG8_SA
#undef PG8_SB
#undef PG8_STAGE
#undef PG8_LDA
#undef PG8_LDB
#undef PG8_MMA
#undef PG8_WAIT_V
#undef PG8_WAIT_L
#undef PG8_BAR
#undef PG8_SCHED
}

__device__ __forceinline__ float gelu1(float v) {
    const float av = __builtin_fabsf(v), d = av * 0.2316418882f + 1.0f;
    const float t = __builtin_amdgcn_rcpf(d);
    float q = t * 0.5307027145f + (-0.7265760135f); q = q * t + 0.7107068705f; q = q * t + (-0.142248368f); q = q * t + 0.127414796f; q = q * t;
    const float e = __builtin_amdgcn_exp2f((v * v) * (-0.72134752044f));
    const float mm = v * (q * e), r = v - mm;
    return v < 0.f ? mm : r;
}
}

#define XB_TMO      128
#define XB_XCNT(j)  (256  + 64 * (j))
#define XB_XSUB(j)  (1280 + 64 * (j))
#define XB_XGEN(j)  (2304 + 64 * (j))
#define XB_TOP      3328
#define XB_TOPGEN   3392
#define XCD_BAR_WORDS 3456
#define XB_SPIN_CAP (1u << 18)
__device__ __forceinline__ unsigned xb_ld(unsigned* p)              { return __hip_atomic_load(p, __ATOMIC_RELAXED, __HIP_MEMORY_SCOPE_AGENT); }
__device__ __forceinline__ unsigned xb_add(unsigned* p, unsigned v) { return __hip_atomic_fetch_add(p, v, __ATOMIC_RELAXED, __HIP_MEMORY_SCOPE_AGENT); }
__device__ __forceinline__ unsigned xb_xcc_id() { return (unsigned)__builtin_amdgcn_s_getreg((3 << 11) | 20) & 0xFu; }
#define XB_SPIN(cond, bar) do { unsigned _sp = 0; while (cond) { __builtin_amdgcn_s_sleep(1); \
    if ((++_sp & 255u) == 0u) { if (xb_ld(&(bar)[XB_TMO])) break; if (_sp > XB_SPIN_CAP) { atomicAdd(&(bar)[XB_TMO], 1u); break; } } } } while (0)
struct XcdBarrier { unsigned* bar; unsigned x; volatile LAS unsigned* st; };
__device__ __forceinline__ XcdBarrier xcd_barrier_post(unsigned* bar, volatile LAS unsigned* st) {
    XcdBarrier b; b.bar = bar; b.x = xb_xcc_id(); b.st = st;
    if (threadIdx.x == 0) (void)xb_add(&bar[XB_XCNT(b.x)], 1u);
    return b;
}
__device__ __forceinline__ void xcd_barrier_complete(unsigned* bar, unsigned x, unsigned& nloc, unsigned& nx) {
    const unsigned G = gridDim.x * gridDim.y * gridDim.z;
    unsigned sum, cnt, mine, sp = 0u;
    for (;;) {
        sum = 0u; cnt = 0u; mine = 0u;
#pragma unroll
        for (unsigned j = 0; j < 16; ++j) { const unsigned c = xb_ld(&bar[XB_XCNT(j)]); sum += c; cnt += (c > 0u) ? 1u : 0u; mine = (j == x) ? c : mine; }
        if (sum == G) break;
        __builtin_amdgcn_s_sleep(1);
        if ((++sp & 255u) == 0u) { if (xb_ld(&bar[XB_TMO])) break; if (sp > XB_SPIN_CAP) { atomicAdd(&bar[XB_TMO], 1u); break; } }
    }
    nloc = mine > 0u ? mine : 1u; nx = cnt > 0u ? cnt : 1u;
}
__device__ __forceinline__ void xcd_barrier(const XcdBarrier& b) {
    asm volatile("s_waitcnt vmcnt(0)" ::: "memory");
    __syncthreads();
    if (threadIdx.x == 0) {
        unsigned* bar = b.bar;
        __builtin_amdgcn_s_waitcnt(0);
        unsigned nloc = b.st[0], nx = b.st[1];
        if (nloc == 0u) { xcd_barrier_complete(bar, b.x, nloc, nx); b.st[0] = nloc; b.st[1] = nx; }
        const unsigned old = xb_add(&bar[XB_XSUB(b.x)], 1u);
        const unsigned gen = old / nloc;
        if (old + 1u == (gen + 1u) * nloc) {
            __builtin_amdgcn_fence(__ATOMIC_RELEASE, "agent");
            asm volatile("s_waitcnt vmcnt(0)" ::: "memory");
            const unsigned og = xb_add(&bar[XB_TOP], 1u);
            const unsigned tg = og / nx;
            if (og + 1u == (tg + 1u) * nx) xb_add(&bar[XB_TOPGEN], 1u);
            else XB_SPIN(xb_ld(&bar[XB_TOPGEN]) == tg, bar);
            __builtin_amdgcn_fence(__ATOMIC_ACQUIRE, "agent");
            xb_add(&bar[XB_XGEN(b.x)], 1u);
            asm volatile("s_waitcnt vmcnt(0)" ::: "memory");
        } else {
            XB_SPIN(xb_ld(&bar[XB_XGEN(b.x)]) == gen, bar);
            __builtin_amdgcn_fence(__ATOMIC_ACQUIRE, "agent");
            asm volatile("s_waitcnt vmcnt(0)" ::: "memory");
        }
    }
    __syncthreads();
}

enum { I_X = 0, I_MEM, I_F1N, I_F1G, I_F1U, I_F1D, I_MIXN, I_MEMN, I_WIN, I_GUP, I_GB, I_GON, I_LNG, I_LNB, I_WS, I_BS, I_WKV, I_WBR, I_WOUT, I_F2N, I_F2G, I_F2U, I_F2D, I_FN, N_IN };
struct Args { const float* in[N_IN]; float* out; unsigned char* ws; int ph_lo, ph_hi; };
constexpr int N_PHASES = 20;

using pg8::Unit;
struct EpiGU {
    bf16* act; const float* ss; bf16* Kb; bf16* VT;
    __device__ __forceinline__ void operator()(const f32x4 (&acc)[2][2][4][2], const Unit& u, int wr, int wc, int fr, int fq) const {
        if (u.kind == 0) {
            const int row0 = u.pm * 256 + wr * 64 + fr, col0 = u.pn * 128 + wc * 32 + 8 * fq;
#pragma unroll
            for (int ai = 0; ai < 2; ++ai)
#pragma unroll
                for (int m = 0; m < 4; ++m) {
                    const int r = row0 + ai * 128 + m * 16;
                    const float s = ss ? __builtin_amdgcn_rsqf(ss[r] * (1.0f / D) + EPS) : 1.0f;
                    float o[8];
#pragma unroll
                    for (int n = 0; n < 2; ++n)
#pragma unroll
                        for (int j = 0; j < 4; ++j) { const float g = acc[ai][0][m][n][j] * s, uu = acc[ai][1][m][n][j] * s; o[n * 4 + j] = g * sigmoidf_(g) * uu; }
                    v4u w; w.x = cvtpk(o[0], o[1]); w.y = cvtpk(o[2], o[3]); w.z = cvtpk(o[4], o[5]); w.w = cvtpk(o[6], o[7]);
                    *(v4u*)(act + (size_t)r * DFF + col0) = w;
                }
        } else {
            bf16* base = u.kind == 1 ? Kb : VT; const int ldc = u.kind == 1 ? 1024 : 2048;
            const int row0 = u.pm * 256 + wr * 64 + fr, col0 = u.pn * 256 + wc * 32 + 8 * fq;
#pragma unroll
            for (int ai = 0; ai < 2; ++ai)
#pragma unroll
                for (int m = 0; m < 4; ++m) {
                    bf16* rowp = base + (size_t)(row0 + ai * 128 + m * 16) * ldc + col0;
#pragma unroll
                    for (int bj = 0; bj < 2; ++bj) { const f32x4 v0 = acc[ai][bj][m][0], v1 = acc[ai][bj][m][1];
                        v4u w; w.x = cvtpk(v0[0], v0[1]); w.y = cvtpk(v0[2], v0[3]); w.z = cvtpk(v1[0], v1[1]); w.w = cvtpk(v1[2], v1[3]);
                        *(v4u*)(rowp + bj * 128) = w; }
                }
        }
    }
};
struct EpiRes {
    const float* xin; float* xout; bf16* xb; float* ss; float alpha;
    __device__ __forceinline__ void operator()(const f32x4 (&acc)[2][2][4][2], const Unit& u, int wr, int wc, int fr, int fq) const {
        const int row0 = u.pm * 256 + wr * 64 + fr, col0 = u.pn * 256 + wc * 32 + 8 * fq;
#pragma unroll
        for (int ai = 0; ai < 2; ++ai)
#pragma unroll
            for (int m = 0; m < 4; ++m) {
                const int r = row0 + ai * 128 + m * 16; const size_t off = (size_t)r * D + col0; float sq = 0.f;
#pragma unroll
                for (int bj = 0; bj < 2; ++bj) {
                    const f32x4 a0 = *(const f32x4*)(xin + off + bj * 128), a1 = *(const f32x4*)(xin + off + bj * 128 + 4);
                    const f32x4 v0 = a0 + alpha * acc[ai][bj][m][0], v1 = a1 + alpha * acc[ai][bj][m][1];
                    *(f32x4*)(xout + off + bj * 128) = v0; *(f32x4*)(xout + off + bj * 128 + 4) = v1;
                    if (xb) { v4u w; w.x = cvtpk(v0[0], v0[1]); w.y = cvtpk(v0[2], v0[3]); w.z = cvtpk(v1[0], v1[1]); w.w = cvtpk(v1[2], v1[3]); *(v4u*)(xb + off + bj * 128) = w; }
                    sq += (v0[0] * v0[0] + v0[1] * v0[1]) + (v0[2] * v0[2] + v0[3] * v0[3]) + (v1[0] * v1[0] + v1[1] * v1[1]) + (v1[2] * v1[2] + v1[3] * v1[3]);
                }
                if (ss) { sq += __shfl_xor(sq, 16); sq += __shfl_xor(sq, 32); if (fq == 0) atomicAdd(ss + r, sq); }
                asm volatile("" ::: "memory");
            }
    }
};
struct EpiProj {
    const float* ss; bf16* q; bf16* k; bf16* v; bf16* r; bf16* su; bf16* sv; bf16* xq;
    __device__ __forceinline__ void operator()(const f32x4 (&acc)[2][2][4][2], const Unit& u, int wr, int wc, int fr, int fq) const {
        bf16* base; int ldc, ct; bool act = false; const int pn = u.pn;
        if (pn < 2) { base = q; ldc = 512; ct = pn; } else if (pn < 4) { base = k; ldc = 512; ct = pn - 2; } else if (pn < 8) { base = v; ldc = 1024; ct = pn - 4; }
        else if (pn < 12) { base = r; ldc = 1024; ct = pn - 8; } else if (pn < 16) { base = su; ldc = 1024; ct = pn - 12; act = true; }
        else if (pn < 20) { base = sv; ldc = 1024; ct = pn - 16; act = true; } else { base = xq; ldc = 1024; ct = pn - 20; }
        const int row0 = u.pm * 256 + wr * 64 + fr, col0 = ct * 256 + wc * 32 + 8 * fq;
#pragma unroll
        for (int ai = 0; ai < 2; ++ai)
#pragma unroll
            for (int m = 0; m < 4; ++m) {
                const int rr = row0 + ai * 128 + m * 16;
                const float s = __builtin_amdgcn_rsqf(ss[rr] * (1.0f / D) + EPS);
                bf16* rowp = base + (size_t)rr * ldc + col0;
#pragma unroll
                for (int bj = 0; bj < 2; ++bj) { f32x4 v0 = acc[ai][bj][m][0] * s, v1 = acc[ai][bj][m][1] * s;
                    if (act) {
#pragma unroll
                        for (int j = 0; j < 4; ++j) { v0[j] = pg8::gelu1(v0[j]); v1[j] = pg8::gelu1(v1[j]); } }
                    v4u w; w.x = cvtpk(v0[0], v0[1]); w.y = cvtpk(v0[2], v0[3]); w.z = cvtpk(v1[0], v1[1]); w.w = cvtpk(v1[2], v1[3]);
                    *(v4u*)(rowp + bj * 128) = w; }
            }
    }
};
struct EpiGate {
    const float* ss; bf16* g;
    __device__ __forceinline__ void operator()(const f32x4 (&acc)[2][2][4][2], const Unit& u, int wr, int wc, int fr, int fq) const {
        const int row0 = u.pm * 256 + wr * 64 + fr, col0 = u.pn * 256 + wc * 32 + 8 * fq;
#pragma unroll
        for (int ai = 0; ai < 2; ++ai)
#pragma unroll
            for (int m = 0; m < 4; ++m) {
                const int rr = row0 + ai * 128 + m * 16;
                const float s = __builtin_amdgcn_rsqf(ss[rr] * (1.0f / D) + EPS);
                bf16* rowp = g + (size_t)rr * D + col0;
#pragma unroll
                for (int bj = 0; bj < 2; ++bj) { f32x4 v0 = acc[ai][bj][m][0] * s, v1 = acc[ai][bj][m][1] * s;
#pragma unroll
                    for (int j = 0; j < 4; ++j) { v0[j] = sigmoidf_(v0[j]); v1[j] = sigmoidf_(v1[j]); }
                    v4u w; w.x = cvtpk(v0[0], v0[1]); w.y = cvtpk(v0[2], v0[3]); w.z = cvtpk(v1[0], v1[1]); w.w = cvtpk(v1[2], v1[3]);
                    *(v4u*)(rowp + bj * 128) = w; }
            }
    }
};
struct EpiMerge {
    const bf16* g; bf16* mrg; int first;
    __device__ __forceinline__ void operator()(const f32x4 (&acc)[2][2][4][2], const Unit& u, int wr, int wc, int fr, int fq) const {
        const int row0 = u.pm * 256 + wr * 64 + fr, col0 = u.pn * 256 + wc * 32 + 8 * fq;
#pragma unroll
        for (int ai = 0; ai < 2; ++ai)
#pragma unroll
            for (int m = 0; m < 4; ++m) {
                const size_t off = (size_t)(row0 + ai * 128 + m * 16) * D + col0;
#pragma unroll
                for (int bj = 0; bj < 2; ++bj) {
                    const v4u gw = *(const v4u*)(g + off + bj * 128);
                    v4u ow = (v4u){0u, 0u, 0u, 0u}; if (!first) ow = *(const v4u*)(mrg + off + bj * 128);
                    const f32x4 a0 = acc[ai][bj][m][0], a1 = acc[ai][bj][m][1];
                    float o[8];
                    o[0] = bflo(ow.x) + bflo(gw.x) * a0[0]; o[1] = bfhi(ow.x) + bfhi(gw.x) * a0[1]; o[2] = bflo(ow.y) + bflo(gw.y) * a0[2]; o[3] = bfhi(ow.y) + bfhi(gw.y) * a0[3];
                    o[4] = bflo(ow.z) + bflo(gw.z) * a1[0]; o[5] = bfhi(ow.z) + bfhi(gw.z) * a1[1]; o[6] = bflo(ow.w) + bflo(gw.w) * a1[2]; o[7] = bfhi(ow.w) + bfhi(gw.w) * a1[3];
                    v4u w; w.x = cvtpk(o[0], o[1]); w.y = cvtpk(o[2], o[3]); w.z = cvtpk(o[4], o[5]); w.w = cvtpk(o[6], o[7]);
                    *(v4u*)(mrg + off + bj * 128) = w;
                }
                asm volatile("" ::: "memory");
            }
    }
};

struct GridSched {
    const char* A; const char* B; size_t tA, tB; int nM, nN, G, c;
    __device__ __forceinline__ bool next(int i, Unit& u) const {
        const int L = i * G + c; if (L >= nM * nN) return false;
        pg8::tile_of(L, nM, nN, u.pm, u.pn); u.A = A + (size_t)u.pm * tA; u.B = B + (size_t)u.pn * tB; u.kind = 0; return true;
    }
};
struct P1Sched {
    const char* h1b; const char* wgu; const char* memb; const char* wkv; int G, c;
    __device__ __forceinline__ bool next(int i, Unit& u) const {
        const int L = i * G + c; constexpr int NF = 64 * 44; const size_t T = (size_t)256 * D * 2;
        if (L < NF) { pg8::tile_of(L, 64, 44, u.pm, u.pn); u.A = h1b + (size_t)u.pm * T; u.B = wgu + (size_t)u.pn * T; u.kind = 0; return true; }
        const int id = L - NF; if (id >= 64) return false;
        if (id < 32) { u.pm = id >> 2; u.pn = id & 3; u.A = memb + (size_t)u.pm * T; u.B = wkv + (size_t)u.pn * T; u.kind = 1; }
        else { const int j = id - 32; u.pm = j >> 3; u.pn = j & 7; u.A = wkv + (size_t)(4 + u.pm) * T; u.B = memb + (size_t)u.pn * T; u.kind = 2; }
        return true;
    }
};

__device__ __forceinline__ void transpose_item(const float* W, int ldw, int k0, int src_col0, bf16* WT, int ldk, int dst_row0, const float* gain, LAS float* scr, int lane) {
#pragma unroll 8
    for (int i = 0; i < 32; ++i) { const int kk = 2 * i + (lane >> 5); float v = W[(size_t)(k0 + kk) * ldw + src_col0 + (lane & 31)]; if (gain) v *= gain[k0 + kk]; scr[kk * 33 + (lane & 31)] = v; }
    LDS_WAIT(); asm volatile("" ::: "memory");
    const int c = lane & 7;
#pragma unroll
    for (int j = 0; j < 4; ++j) { const int n = (lane >> 3) + 8 * j; const LAS float* s = scr + (8 * c) * 33 + n;
        v4u o; o.x = cvtpk(s[0 * 33], s[1 * 33]); o.y = cvtpk(s[2 * 33], s[3 * 33]); o.z = cvtpk(s[4 * 33], s[5 * 33]); o.w = cvtpk(s[6 * 33], s[7 * 33]);
        *(GAS v4u*)(WT + (size_t)(dst_row0 + n) * ldk + k0 + 8 * c) = o; }
    LDS_WAIT(); asm volatile("" ::: "memory");
}
__device__ __forceinline__ void rms_row_to_bf16(const float* xrow, const float* gain, bf16* orow, int lane) {
    const GAS f32x4* xr = (const GAS f32x4*)xrow + lane; const GAS f32x4* gr = (const GAS f32x4*)gain + lane;
    f32x4 v[8]; float s = 0.f;
#pragma unroll
    for (int j = 0; j < 8; ++j) { v[j] = xr[64 * j]; s += (v[j].x * v[j].x + v[j].y * v[j].y) + (v[j].z * v[j].z + v[j].w * v[j].w); }
    const float rs = 1.0f / sqrtf(wave_sum(s) * (1.0f / D) + EPS);
    GAS v2u* o8 = (GAS v2u*)orow + lane;
#pragma unroll
    for (int j = 0; j < 8; ++j) { const f32x4 g = gr[64 * j]; v2u w; w.x = cvtpk(v[j].x * rs * g.x, v[j].y * rs * g.y); w.y = cvtpk(v[j].z * rs * g.z, v[j].w * rs * g.w); o8[64 * j] = w; }
}

__device__ __forceinline__ int tau32(int r) { return (r & ~12) | ((r & 4) << 1) | ((r & 8) >> 1); }
#define MFMA32(a, b, c) __builtin_amdgcn_mfma_f32_32x32x16_bf16((a), (b), (c), 0, 0, 0)
__device__ __forceinline__ bf16x8 pack8(const f32x16& x, int s) {
    v4u p; p.x = cvtpk(x[8 * s], x[8 * s + 1]); p.y = cvtpk(x[8 * s + 2], x[8 * s + 3]); p.z = cvtpk(x[8 * s + 4], x[8 * s + 5]); p.w = cvtpk(x[8 * s + 6], x[8 * s + 7]);
    return __builtin_bit_cast(bf16x8, p);
}
__device__ __forceinline__ f32x16 zero16() { f32x16 z;
#pragma unroll
    for (int i = 0; i < 16; ++i) z[i] = 0.f; return z; }

constexpr float GLA_SCALE = 0.08838834764831845f;
constexpr int VT_P = 72, KL_P = 72, QS_P = 136;

__device__ __forceinline__ void load_vT(const bf16* V, int tok0, int h, LAS bf16* VT, int wave, int lane) {
    const bf16* src = V + (size_t)(tok0 + lane) * 1024 + h * 256 + 32 * wave;
#pragma unroll
    for (int p = 0; p < 4; ++p) { const v4u raw = *(const v4u*)(src + 8 * p); const int c0 = 32 * wave + 8 * p;
        VT[(c0 + 0) * VT_P + lane] = (bf16)(raw.x & 0xffff); VT[(c0 + 1) * VT_P + lane] = (bf16)(raw.x >> 16);
        VT[(c0 + 2) * VT_P + lane] = (bf16)(raw.y & 0xffff); VT[(c0 + 3) * VT_P + lane] = (bf16)(raw.y >> 16);
        VT[(c0 + 4) * VT_P + lane] = (bf16)(raw.z & 0xffff); VT[(c0 + 5) * VT_P + lane] = (bf16)(raw.z >> 16);
        VT[(c0 + 6) * VT_P + lane] = (bf16)(raw.w & 0xffff); VT[(c0 + 7) * VT_P + lane] = (bf16)(raw.w >> 16); }
}

__device__ __forceinline__ void gla_step1(LAS unsigned char* lds, int unit, bf16* Q, bf16* Kt, const bf16* V, const float* GLR, const float* wup, const float* gbias, float* ADEC, bf16* US, int wave, int lane) {
    const int b = unit >> 7, h = (unit >> 5) & 3, n = unit & 31, tok0 = b * SEQ + n * 64, tid = wave * 64 + lane;
    LAS float* WUP = (LAS float*)lds;
    LAS float* BIAS = (LAS float*)(lds + 8192);
    LAS bf16* KLT = (LAS bf16*)(lds + 9216);
    LAS bf16* VTl = (LAS bf16*)(lds + 9216 + 128 * KL_P * 2);
    for (int i = tid; i < 16 * 128; i += NTHREADS) WUP[i] = wup[(i >> 7) * 512 + h * 128 + (i & 127)];
    if (tid < 128) BIAS[tid] = gbias[h * 128 + tid];
    load_vT(V, tok0, h, VTl, wave, lane);
    const int token = tok0 + lane;
    float gl[16];
    { const f32x4* gp = (const f32x4*)(GLR + (size_t)token * 16);
#pragma unroll
      for (int i = 0; i < 4; ++i) { const f32x4 t = gp[i]; gl[4 * i] = t.x; gl[4 * i + 1] = t.y; gl[4 * i + 2] = t.z; gl[4 * i + 3] = t.w; } }
    __syncthreads();
    float la[16];
#pragma unroll
    for (int j = 0; j < 16; ++j) {
        float z = BIAS[16 * wave + j];
#pragma unroll
        for (int r = 0; r < 16; ++r) z += gl[r] * WUP[r * 128 + 16 * wave + j];
        const float ls = fminf(z, 0.f) - __logf(1.0f + __expf(-fabsf(z)));
        float v = ls * (1.0f / 16.0f);
#pragma unroll
        for (int o = 1; o < 64; o <<= 1) { const float t = __shfl_up(v, o); if (lane >= o) v += t; }
        la[j] = v;
    }
    unsigned qraw[8], kraw[8];
    { const v4u* qp = (const v4u*)(Q + (size_t)token * 512 + h * 128 + 16 * wave); const v4u* kp = (const v4u*)(Kt + (size_t)token * 512 + h * 128 + 16 * wave);
      const v4u q0 = qp[0], q1 = qp[1], k0 = kp[0], k1 = kp[1];
      qraw[0] = q0.x; qraw[1] = q0.y; qraw[2] = q0.z; qraw[3] = q0.w; qraw[4] = q1.x; qraw[5] = q1.y; qraw[6] = q1.z; qraw[7] = q1.w;
      kraw[0] = k0.x; kraw[1] = k0.y; kraw[2] = k0.z; kraw[3] = k0.w; kraw[4] = k1.x; kraw[5] = k1.y; kraw[6] = k1.z; kraw[7] = k1.w; }
    unsigned qo[8], ko[8];
#pragma unroll
    for (int jj = 0; jj < 8; ++jj) {
        float qs2[2], ks2[2];
#pragma unroll
        for (int e = 0; e < 2; ++e) { const int j = 2 * jj + e;
            const float bb = la[j], bl = __shfl(bb, 63), a = __expf(bl), e1 = __expf(bb), e2 = __expf(-bb);
            const float qv = e ? bfhi(qraw[jj]) : bflo(qraw[jj]), kv = e ? bfhi(kraw[jj]) : bflo(kraw[jj]);
            qs2[e] = qv * (GLA_SCALE * e1); ks2[e] = kv * e2;
            KLT[(16 * wave + j) * KL_P + lane] = f2bf(kv * (e2 * a));
            if (lane == 63) ADEC[(size_t)unit * 128 + 16 * wave + j] = a; }
        qo[jj] = cvtpk(qs2[0], qs2[1]); ko[jj] = cvtpk(ks2[0], ks2[1]);
    }
    { v4u* qp = (v4u*)(Q + (size_t)token * 512 + h * 128 + 16 * wave); v4u* kp = (v4u*)(Kt + (size_t)token * 512 + h * 128 + 16 * wave);
      qp[0] = (v4u){qo[0], qo[1], qo[2], qo[3]}; qp[1] = (v4u){qo[4], qo[5], qo[6], qo[7]};
      kp[0] = (v4u){ko[0], ko[1], ko[2], ko[3]}; kp[1] = (v4u){ko[4], ko[5], ko[6], ko[7]}; }
    __syncthreads();
    const int r32 = lane & 31, hh = lane >> 5;
    f32x16 acc[4];
#pragma unroll
    for (int dt = 0; dt < 4; ++dt) acc[dt] = zero16();
#pragma unroll
    for (int kk = 0; kk < 4; ++kk) {
        const bf16x8 Bf = *(const LAS bf16x8*)(VTl + (32 * wave + r32) * VT_P + 16 * kk + 8 * hh);
#pragma unroll
        for (int dt = 0; dt < 4; ++dt) { const bf16x8 Af = *(const LAS bf16x8*)(KLT + (32 * dt + r32) * KL_P + 16 * kk + 8 * hh); acc[dt] = MFMA32(Af, Bf, acc[dt]); }
    }
    bf16* up = US + ((size_t)unit * 256 + 32 * wave + r32) * 128;
#pragma unroll
    for (int dt = 0; dt < 4; ++dt)
#pragma unroll
        for (int g4 = 0; g4 < 4; ++g4) { v2u w; w.x = cvtpk(acc[dt][4 * g4], acc[dt][4 * g4 + 1]); w.y = cvtpk(acc[dt][4 * g4 + 2], acc[dt][4 * g4 + 3]);
            *(v2u*)(up + 32 * dt + 8 * g4 + 4 * hh) = w; }
    __syncthreads();
}

__device__ __forceinline__ void gla_scan(bf16* US, const float* ADEC, int gid) {
    const int bh = gid >> 12, e = gid & 4095, dv = e >> 4, dk0 = (e & 15) * 8;
    float S[8];
#pragma unroll
    for (int i = 0; i < 8; ++i) S[i] = 0.f;
#pragma unroll 4
    for (int n = 0; n < 32; ++n) {
        const int unit = bh * 32 + n;
        v4u* p = (v4u*)(US + ((size_t)unit * 256 + dv) * 128 + dk0);
        const v4u uu = *p; const f32x4 a0 = *(const f32x4*)(ADEC + (size_t)unit * 128 + dk0), a1 = *(const f32x4*)(ADEC + (size_t)unit * 128 + dk0 + 4);
        v4u w; w.x = cvtpk(S[0], S[1]); w.y = cvtpk(S[2], S[3]); w.z = cvtpk(S[4], S[5]); w.w = cvtpk(S[6], S[7]);
        *p = w;
        S[0] = a0.x * S[0] + bflo(uu.x); S[1] = a0.y * S[1] + bfhi(uu.x); S[2] = a0.z * S[2] + bflo(uu.y); S[3] = a0.w * S[3] + bfhi(uu.y);
        S[4] = a1.x * S[4] + bflo(uu.z); S[5] = a1.y * S[5] + bfhi(uu.z); S[6] = a1.z * S[6] + bflo(uu.w); S[7] = a1.w * S[7] + bfhi(uu.w);
    }
}

__device__ __forceinline__ void gla_step3(LAS unsigned char* lds, int unit, const bf16* Q, const bf16* Kt, bf16* V, const bf16* R, const bf16* US, const float* onorm, int wave, int lane) {
    const int b = unit >> 7, h = (unit >> 5) & 3, n = unit & 31, tok0 = b * SEQ + n * 64, tid = wave * 64 + lane;
    LAS bf16* QS = (LAS bf16*)lds;
    LAS bf16* KS = (LAS bf16*)(lds + 64 * QS_P * 2);
    LAS bf16* VTl = (LAS bf16*)(lds + 2 * 64 * QS_P * 2);
    LAS float* RED = (LAS float*)(lds + 2 * 64 * QS_P * 2 + 256 * VT_P * 2);
#pragma unroll
    for (int i = 0; i < 2; ++i) { const int pc = tid + i * NTHREADS, row = pc >> 4, c8 = (pc & 15) * 8;
        *(LAS v4u*)(QS + row * QS_P + c8) = *(const v4u*)(Q + (size_t)(tok0 + row) * 512 + h * 128 + c8);
        *(LAS v4u*)(KS + row * QS_P + c8) = *(const v4u*)(Kt + (size_t)(tok0 + row) * 512 + h * 128 + c8); }
    load_vT(V, tok0, h, VTl, wave, lane);
    __syncthreads();
    const int r32 = lane & 31, hh = lane >> 5;
    f32x16 sc0 = zero16(), sc1 = zero16(), sc2 = zero16();
#pragma unroll
    for (int kk = 0; kk < 8; ++kk) {
        const bf16x8 A0 = *(const LAS bf16x8*)(KS + tau32(r32) * QS_P + 16 * kk + 8 * hh), A1 = *(const LAS bf16x8*)(KS + (32 + tau32(r32)) * QS_P + 16 * kk + 8 * hh);
        const bf16x8 B0 = *(const LAS bf16x8*)(QS + r32 * QS_P + 16 * kk + 8 * hh), B1 = *(const LAS bf16x8*)(QS + (32 + r32) * QS_P + 16 * kk + 8 * hh);
        sc0 = MFMA32(A0, B0, sc0); sc1 = MFMA32(A0, B1, sc1); sc2 = MFMA32(A1, B1, sc2);
    }
#pragma unroll
    for (int rg = 0; rg < 16; ++rg) { const int s = (rg & 3) + 4 * ((rg >> 2) & 1) + 8 * hh + 16 * (rg >> 3); if (s > r32) { sc0[rg] = 0.f; sc2[rg] = 0.f; } }
    f32x16 o0 = zero16(), o1 = zero16();
    const LAS bf16* vrow = VTl + (32 * wave + r32) * VT_P + 8 * hh;
#pragma unroll
    for (int s = 0; s < 2; ++s) {
        const bf16x8 Av0 = *(const LAS bf16x8*)(vrow + 16 * s), Av1 = *(const LAS bf16x8*)(vrow + 32 + 16 * s);
        o0 = MFMA32(Av0, pack8(sc0, s), o0); o1 = MFMA32(Av0, pack8(sc1, s), o1); o1 = MFMA32(Av1, pack8(sc2, s), o1);
    }
    const bf16* sp = US + ((size_t)unit * 256 + 32 * wave + r32) * 128 + 8 * hh;
#pragma unroll
    for (int kk = 0; kk < 8; ++kk) {
        const bf16x8 As = __builtin_bit_cast(bf16x8, *(const v4u*)(sp + 16 * kk));
        const bf16x8 B0 = *(const LAS bf16x8*)(QS + r32 * QS_P + 16 * kk + 8 * hh), B1 = *(const LAS bf16x8*)(QS + (32 + r32) * QS_P + 16 * kk + 8 * hh);
        o0 = MFMA32(As, B0, o0); o1 = MFMA32(As, B1, o1);
    }
    float q0 = 0.f, q1 = 0.f;
#pragma unroll
    for (int rg = 0; rg < 16; ++rg) { q0 += o0[rg] * o0[rg]; q1 += o1[rg] * o1[rg]; }
    q0 += __shfl_xor(q0, 32); q1 += __shfl_xor(q1, 32);
    if (hh == 0) { RED[wave * 64 + r32] = q0; RED[wave * 64 + 32 + r32] = q1; }
    __syncthreads();
    float t0 = 0.f, t1 = 0.f;
#pragma unroll
    for (int w = 0; w < 8; ++w) { t0 += RED[w * 64 + r32]; t1 += RED[w * 64 + 32 + r32]; }
    const float rs0 = 1.0f / sqrtf(t0 * (1.0f / 256.0f) + EPS), rs1 = 1.0f / sqrtf(t1 * (1.0f / 256.0f) + EPS);
#pragma unroll
    for (int tt = 0; tt < 2; ++tt) {
        const size_t rowoff = (size_t)(tok0 + 32 * tt + r32) * 1024 + h * 256 + 32 * wave + 4 * hh;
        const float rs = tt ? rs1 : rs0;
#pragma unroll
        for (int g4 = 0; g4 < 4; ++g4) {
            const v2u rw = *(const v2u*)(R + rowoff + 8 * g4); const f32x4 gn = *(const f32x4*)(onorm + h * 256 + 32 * wave + 8 * g4 + 4 * hh);
            float y[4];
#pragma unroll
            for (int j = 0; j < 4; ++j) { const float ov = tt ? o1[4 * g4 + j] : o0[4 * g4 + j]; const unsigned rr = j < 2 ? rw.x : rw.y; const float rv = (j & 1) ? bfhi(rr) : bflo(rr);
                y[j] = ov * rs * gn[j] * (rv * sigmoidf_(rv)); }
            v2u w; w.x = cvtpk(y[0], y[1]); w.y = cvtpk(y[2], y[3]); *(v2u*)(V + rowoff + 8 * g4) = w;
        }
    }
    __syncthreads();
}

__device__ __forceinline__ void sg_unit(LAS unsigned char* lds, int unit, bf16* SU, const bf16* SV, const float* lng, const float* lnb, const float* ws, const float* bs, int wave, int lane) {
    const int b = unit >> 6, n = (unit >> 2) & 15, g = unit & 3, tok0 = b * SEQ + n * 128, tid = wave * 64 + lane;
    LAS bf16* VNT = (LAS bf16*)lds;
    LAS bf16* WB = (LAS bf16*)(lds + 256 * QS_P * 2);
    LAS f32x2* RED = (LAS f32x2*)(lds + 256 * QS_P * 2 + 128 * QS_P * 2);
    { const int t = tid >> 2, s0 = (tid & 3) * 32; const float* wp = ws + ((size_t)g * 128 + t) * 128 + s0;
#pragma unroll
      for (int i = 0; i < 4; ++i) { const f32x4 a = *(const f32x4*)(wp + 8 * i), c = *(const f32x4*)(wp + 8 * i + 4); const int s = s0 + 8 * i;
          v4u w; w.x = cvtpk(s + 0 <= t ? a.x : 0.f, s + 1 <= t ? a.y : 0.f); w.y = cvtpk(s + 2 <= t ? a.z : 0.f, s + 3 <= t ? a.w : 0.f);
          w.z = cvtpk(s + 4 <= t ? c.x : 0.f, s + 5 <= t ? c.y : 0.f); w.w = cvtpk(s + 6 <= t ? c.z : 0.f, s + 7 <= t ? c.w : 0.f);
          *(LAS v4u*)(WB + t * QS_P + s) = w; } }
    const int tok = lane + 64 * (wave & 1), cq = wave >> 1;
    unsigned raw[32]; float s1 = 0.f, s2 = 0.f;
    { const v4u* p = (const v4u*)(SV + (size_t)(tok0 + tok) * 1024 + g * 256 + 64 * cq);
#pragma unroll
      for (int i = 0; i < 8; ++i) { const v4u t = p[i]; raw[4 * i] = t.x; raw[4 * i + 1] = t.y; raw[4 * i + 2] = t.z; raw[4 * i + 3] = t.w; } }
#pragma unroll
    for (int i = 0; i < 32; ++i) { const float a = bflo(raw[i]), c = bfhi(raw[i]); s1 += a + c; s2 += a * a + c * c; }
    RED[tok * 4 + cq] = (f32x2){s1, s2};
    __syncthreads();
    { const f32x2 p0 = RED[tok * 4], p1 = RED[tok * 4 + 1], p2 = RED[tok * 4 + 2], p3 = RED[tok * 4 + 3];
      const float mu = ((p0.x + p1.x) + (p2.x + p3.x)) * (1.0f / 256.0f); const float var = fmaxf(((p0.y + p1.y) + (p2.y + p3.y)) * (1.0f / 256.0f) - mu * mu, 0.f);
      const float rstd = 1.0f / sqrtf(var + EPS);
      const float* gp = lng + g * 256 + 64 * cq; const float* bp = lnb + g * 256 + 64 * cq;
#pragma unroll
      for (int i = 0; i < 32; ++i) { const int c = 64 * cq + 2 * i;
          VNT[c * QS_P + tok] = f2bf((bflo(raw[i]) - mu) * rstd * gp[2 * i] + bp[2 * i]);
          VNT[(c + 1) * QS_P + tok] = f2bf((bfhi(raw[i]) - mu) * rstd * gp[2 * i + 1] + bp[2 * i + 1]); } }
    __syncthreads();
    const int r32 = lane & 31, hh = lane >> 5;
    f32x16 acc[4];
#pragma unroll
    for (int j = 0; j < 4; ++j) {
        acc[j] = zero16();
#pragma unroll
        for (int kk = 0; kk < 2 * (j + 1); ++kk) {
            const bf16x8 Af = *(const LAS bf16x8*)(VNT + (32 * wave + r32) * QS_P + 16 * kk + 8 * hh), Bf = *(const LAS bf16x8*)(WB + (32 * j + r32) * QS_P + 16 * kk + 8 * hh);
            acc[j] = MFMA32(Af, Bf, acc[j]);
        }
    }
#pragma unroll
    for (int j = 0; j < 4; ++j) {
        const int t = 32 * j + r32; const float bias = bs[g * 128 + t];
        bf16* up = SU + (size_t)(tok0 + t) * 1024 + g * 256 + 32 * wave + 4 * hh;
#pragma unroll
        for (int g4 = 0; g4 < 4; ++g4) { const v2u uw = *(const v2u*)(up + 8 * g4);
            v2u w; w.x = cvtpk(bflo(uw.x) * (acc[j][4 * g4] + bias), bfhi(uw.x) * (acc[j][4 * g4 + 1] + bias)); w.y = cvtpk(bflo(uw.y) * (acc[j][4 * g4 + 2] + bias), bfhi(uw.y) * (acc[j][4 * g4 + 3] + bias));
            *(v2u*)(up + 8 * g4) = w; }
    }
    __syncthreads();
}

__device__ __forceinline__ void xa_task(int task, bf16* XQ, const bf16* Kb, const bf16* VTg, int lane) {
    const int qblk = task & 63, h = (task >> 6) & 3, b = task >> 8;
    const int r32 = lane & 31, hh = lane >> 5; const size_t token = (size_t)b * SEQ + 32 * qblk + r32;
    bf16x8 qf[16];
    { const bf16* qp = XQ + token * 1024 + h * 256 + 8 * hh;
#pragma unroll
      for (int kk = 0; kk < 16; ++kk) qf[kk] = __builtin_bit_cast(bf16x8, *(const v4u*)(qp + 16 * kk)); }
    f32x16 s[8];
#pragma unroll
    for (int kt = 0; kt < 8; ++kt) {
        s[kt] = zero16();
        const bf16* kp = Kb + (size_t)(b * 256 + 32 * kt + tau32(r32)) * 1024 + h * 256 + 8 * hh;
#pragma unroll
        for (int kk = 0; kk < 16; ++kk) { const bf16x8 Af = __builtin_bit_cast(bf16x8, *(const v4u*)(kp + 16 * kk)); s[kt] = MFMA32(Af, qf[kk], s[kt]); }
    }
    float mx = -3.0e38f;
#pragma unroll
    for (int kt = 0; kt < 8; ++kt)
#pragma unroll
        for (int rg = 0; rg < 16; ++rg) mx = fmaxf(mx, s[kt][rg]);
    mx = fmaxf(mx, __shfl_xor(mx, 32));
    float sum = 0.f; constexpr float C2 = 0.0625f * 1.4426950408889634f;
#pragma unroll
    for (int kt = 0; kt < 8; ++kt)
#pragma unroll
        for (int rg = 0; rg < 16; ++rg) { const float p = __builtin_amdgcn_exp2f((s[kt][rg] - mx) * C2); s[kt][rg] = p; sum += p; }
    sum += __shfl_xor(sum, 32);
    const float inv = 1.0f / sum;
    bf16x8 pf[8][2];
#pragma unroll
    for (int kt = 0; kt < 8; ++kt) { pf[kt][0] = pack8(s[kt], 0); pf[kt][1] = pack8(s[kt], 1); }
    bf16* yp = XQ + token * 1024 + h * 256 + 4 * hh;
#pragma unroll 1
    for (int dt = 0; dt < 8; ++dt) {
        f32x16 o = zero16();
        const bf16* vp = VTg + (size_t)(h * 256 + 32 * dt + r32) * 2048 + b * 256 + 8 * hh;
#pragma unroll
        for (int kt = 0; kt < 8; ++kt)
#pragma unroll
            for (int s2 = 0; s2 < 2; ++s2) { const bf16x8 Af = __builtin_bit_cast(bf16x8, *(const v4u*)(vp + 32 * kt + 16 * s2)); o = MFMA32(Af, pf[kt][s2], o); }
#pragma unroll
        for (int g4 = 0; g4 < 4; ++g4) { v2u w; w.x = cvtpk(o[4 * g4] * inv, o[4 * g4 + 1] * inv); w.y = cvtpk(o[4 * g4 + 2] * inv, o[4 * g4 + 3] * inv);
            *(v2u*)(yp + 32 * dt + 8 * g4) = w; }
    }
}

__device__ __forceinline__ void glr_tile(int tile, const bf16* XB, const bf16* Wg, const float* ss, float* GLR, int lane) {
    const int r16 = lane & 15, q4 = lane >> 4;
    const bf16* ap = XB + (size_t)(16 * tile + r16) * D + 8 * q4; const bf16* bp = Wg + (size_t)r16 * D + 8 * q4;
    f32x4 acc = (f32x4){0.f, 0.f, 0.f, 0.f};
#pragma unroll 8
    for (int kk = 0; kk < 64; ++kk) {
        const bf16x8 Af = __builtin_bit_cast(bf16x8, *(const v4u*)(ap + 32 * kk)), Bf = __builtin_bit_cast(bf16x8, *(const v4u*)(bp + 32 * kk));
        acc = __builtin_amdgcn_mfma_f32_16x16x32_bf16(Af, Bf, acc, 0, 0, 0);
    }
#pragma unroll
    for (int j = 0; j < 4; ++j) { const int token = 16 * tile + 4 * q4 + j; const float s = 1.0f / sqrtf(ss[token] * (1.0f / D) + EPS); GLR[(size_t)token * 16 + r16] = acc[j] * s; }
}

__global__ void __launch_bounds__(NTHREADS, 2) mk_fwd(Args args) {
    extern __shared__ __attribute__((aligned(16))) unsigned char lds_raw[];
    LAS unsigned char* lds = (LAS unsigned char*)lds_raw;
    const int tid = threadIdx.x, lane = tid & 63, wave = __builtin_amdgcn_readfirstlane(tid >> 6);
    const int G = gridDim.x, bx = blockIdx.x;
    unsigned char* ws = args.ws;
    unsigned* ctl = (unsigned*)(ws + WS_CTL);
    volatile LAS unsigned* MISC = (volatile LAS unsigned*)(lds + MISC_OFF);
    for (int u = tid; u < (LDS_BYTES - RING_BYTES) / 4; u += NTHREADS) ((LAS unsigned*)(lds + RING_BYTES))[u] = 0u;
    __syncthreads();
#if MK_PER_PHASE
#define GRID_BAR() do {} while (0)
#else
    XcdBarrier bar = xcd_barrier_post(ctl + CW_BAR, MISC + 8);
#define GRID_BAR() xcd_barrier(bar)
#endif
    const int lo = args.ph_lo, hi = args.ph_hi;
#define IN(k) (lo <= (k) && (k) < hi)
#define SEAM(k) do { if (IN((k) + 1)) GRID_BAR(); } while (0)

    const float* x = args.in[I_X]; float* out = args.out;
    float* SS1 = (float*)(ws + CTL_SS1); float* SS2 = (float*)(ws + CTL_SS2);
    float* GLR = (float*)(ws + WS_GLR); float* ADEC = (float*)(ws + WS_ADEC);
    bf16* WGLR = (bf16*)(ws + WS_WGLR); bf16* KB = (bf16*)(ws + WS_KB); bf16* VTG = (bf16*)(ws + WS_VT); bf16* MEMB = (bf16*)(ws + WS_MEMB);
    bf16* WGU1 = (bf16*)(ws + WS_WGU1); bf16* WD1 = (bf16*)(ws + WS_WD1); bf16* WIN = (bf16*)(ws + WS_WIN); bf16* WKV = (bf16*)(ws + WS_WKV);
    bf16* WBR = (bf16*)(ws + WS_WB); bf16* WO = (bf16*)(ws + WS_WO); bf16* WGU2 = (bf16*)(ws + WS_WGU2); bf16* WD2 = (bf16*)(ws + WS_WD2);
    bf16* XB = (bf16*)(ws + WS_XB); bf16* ACT = (bf16*)(ws + WS_ACT);
    bf16* Qb = (bf16*)(ws + WS_Q); bf16* Kt = (bf16*)(ws + WS_K); bf16* Vb = (bf16*)(ws + WS_V); bf16* Rb = (bf16*)(ws + WS_R);
    bf16* SUb = (bf16*)(ws + WS_SU); bf16* SVb = (bf16*)(ws + WS_SV); bf16* XQb = (bf16*)(ws + WS_XQ);
    bf16* MRG = (bf16*)(ws + WS_MRG); bf16* GT = (bf16*)(ws + WS_G); bf16* US = (bf16*)(ws + WS_G);
    const int gw = bx * NWAVES + wave, NGW = G * NWAVES;

    if (IN(0)) {
        LAS float* scr = (LAS float*)(lds + wave * 16384);
        constexpr int I_GU = 32 * 352, I_DN = 88 * 64, I_IN = 32 * 384, I_KV = 32 * 64, I_BR = 3 * 16 * 64, I_WO = 32 * 64;
        constexpr int NITEMS = 2 * I_GU + 2 * I_DN + I_IN + I_KV + I_BR + I_WO;
        for (int it = gw; it < NITEMS; it += NGW) {
            int r = it;
            if (r < 2 * I_GU) { const int second = r >= I_GU; if (second) r -= I_GU; const int kb = r / 352, nb = r % 352, tile = nb >> 3, w8 = nb & 7;
                const float* src = args.in[second ? (w8 < 4 ? I_F2G : I_F2U) : (w8 < 4 ? I_F1G : I_F1U)];
                transpose_item(src, DFF, 64 * kb, 128 * tile + 32 * (w8 & 3), second ? WGU2 : WGU1, D, 32 * nb, second ? args.in[I_F2N] : nullptr, scr, lane); continue; }
            r -= 2 * I_GU;
            if (r < 2 * I_DN) { const int second = r >= I_DN; if (second) r -= I_DN; const int kb = r / 64, nb = r % 64;
                transpose_item(args.in[second ? I_F2D : I_F1D], D, 64 * kb, 32 * nb, second ? WD2 : WD1, DFF, 32 * nb, nullptr, scr, lane); continue; }
            r -= 2 * I_DN;
            if (r < I_IN) { const int kb = r / 384, nb = r % 384; transpose_item(args.in[I_WIN], INW, 64 * kb, 32 * nb + (32 * nb >= 3072 ? 16 : 0), WIN, D, 32 * nb, args.in[I_MIXN], scr, lane); continue; }
            r -= I_IN;
            if (r < I_KV) { const int kb = r / 64, nb = r % 64; transpose_item(args.in[I_WKV], D, 64 * kb, 32 * nb, WKV, D, 32 * nb, nullptr, scr, lane); continue; }
            r -= I_KV;
            if (r < I_BR) { const int i = r / 1024, rr = r % 1024, kb = rr / 64, nb = rr % 64;
                transpose_item(args.in[I_WBR] + (size_t)i * 1024 * D, D, 64 * kb, 32 * nb, WBR + (size_t)i * D * 1024, 1024, 32 * nb, nullptr, scr, lane); continue; }
            r -= I_BR;
            { const int kb = r / 64, nb = r % 64; transpose_item(args.in[I_WOUT], D, 64 * kb, 32 * nb, WO, D, 32 * nb, nullptr, scr, lane); }
        }
        for (int i = bx * NTHREADS + tid; i < 16 * D; i += G * NTHREADS) { const int r = i / D, k = i % D; WGLR[i] = f2bf(args.in[I_WIN][(size_t)k * INW + 3072 + r] * args.in[I_MIXN][k]); }
        for (int m = gw; m < M; m += NGW) rms_row_to_bf16(x + (size_t)m * D, args.in[I_F1N], XB + (size_t)m * D, lane);
        for (int m = gw; m < MROWS; m += NGW) rms_row_to_bf16(args.in[I_MEM] + (size_t)m * D, args.in[I_MEMN], MEMB + (size_t)m * D, lane);
        SEAM(0);
    }
    if (IN(1)) {
        P1Sched S{(const char*)XB, (const char*)WGU1, (const char*)MEMB, (const char*)WKV, G, bx};
        EpiGU E{ACT, nullptr, KB, VTG};
        pg8::gemm_phase(lds, D, D, D, S, E);
        SEAM(1);
    }
    if (IN(2)) {
        GridSched S{(const char*)ACT, (const char*)WD1, (size_t)256 * DFF * 2, (size_t)256 * DFF * 2, 64, 8, G, bx};
        EpiRes E{x, out, XB, SS1, 0.5f};
        pg8::gemm_phase(lds, DFF, DFF, DFF, S, E);
        SEAM(2);
    }
    if (IN(3)) {
        GridSched S{(const char*)XB, (const char*)WIN, (size_t)256 * D * 2, (size_t)256 * D * 2, 64, 24, G, bx};
        EpiProj E{SS1, Qb, Kt, Vb, Rb, SUb, SVb, XQb};
        pg8::gemm_phase(lds, D, D, D, S, E);
        if (wave < 4) glr_tile(bx * 4 + wave, XB, WGLR, SS1, GLR, lane);
        SEAM(3);
    }
    if (IN(4)) {
        for (int i = 0; i < 4; ++i) gla_step1(lds, bx * 4 + i, Qb, Kt, Vb, GLR, args.in[I_GUP], args.in[I_GB], ADEC, US, wave, lane);
        for (int i = 0; i < 2; ++i) sg_unit(lds, bx * 2 + i, SUb, SVb, args.in[I_LNG], args.in[I_LNB], args.in[I_WS], args.in[I_BS], wave, lane);
        SEAM(4);
    }
    if (IN(5)) {
        gla_scan(US, ADEC, bx * NTHREADS + tid);
        xa_task(bx * 8 + wave, XQb, KB, VTG, lane);
        SEAM(5);
    }
    if (IN(6)) {
        for (int i = 0; i < 4; ++i) gla_step3(lds, bx * 4 + i, Qb, Kt, Vb, Rb, US, args.in[I_GON], wave, lane);
        SEAM(6);
    }
#pragma unroll
    for (int i = 0; i < 3; ++i) {
        if (IN(7 + 2 * i)) {
            GridSched S{(const char*)XB, (const char*)(WIN + (size_t)(NPROJ + i * D) * D), (size_t)256 * D * 2, (size_t)256 * D * 2, 64, 8, G, bx};
            EpiGate E{SS1, GT};
            pg8::gemm_phase(lds, D, D, D, S, E);
            SEAM(7 + 2 * i);
        }
        if (IN(8 + 2 * i)) {
            const bf16* Y = i == 0 ? Vb : (i == 1 ? SUb : XQb);
            GridSched S{(const char*)Y, (const char*)(WBR + (size_t)i * D * 1024), (size_t)256 * 1024 * 2, (size_t)256 * 1024 * 2, 64, 8, G, bx};
            EpiMerge E{GT, MRG, i == 0};
            pg8::gemm_phase(lds, 1024, 1024, 1024, S, E);
            SEAM(8 + 2 * i);
        }
    }
    if (IN(13)) {
        GridSched S{(const char*)MRG, (const char*)WO, (size_t)256 * D * 2, (size_t)256 * D * 2, 64, 8, G, bx};
        EpiRes E{out, out, XB, SS2, 1.0f};
        pg8::gemm_phase(lds, D, D, D, S, E);
        SEAM(13);
    }
    if (IN(14)) {
        GridSched S{(const char*)XB, (const char*)WGU2, (size_t)256 * D * 2, (size_t)256 * D * 2, 64, 44, G, bx};
        EpiGU E{ACT, SS2, nullptr, nullptr};
        pg8::gemm_phase(lds, D, D, D, S, E);
        SEAM(14);
    }
    if (IN(15)) {
        GridSched S{(const char*)ACT, (const char*)WD2, (size_t)256 * DFF * 2, (size_t)256 * DFF * 2, 64, 8, G, bx};
        EpiRes E{out, out, nullptr, nullptr, 0.5f};
        pg8::gemm_phase(lds, DFF, DFF, DFF, S, E);
        SEAM(15);
    }
    if (IN(16)) {
        const float* fg = args.in[I_FN];
        for (int m = gw; m < M; m += NGW) {
            GAS f32x4* xr = (GAS f32x4*)(out + (size_t)m * D) + lane; const GAS f32x4* gr = (const GAS f32x4*)fg + lane;
            f32x4 v[8]; float s = 0.f;
#pragma unroll
            for (int j = 0; j < 8; ++j) { v[j] = xr[64 * j]; s += (v[j].x * v[j].x + v[j].y * v[j].y) + (v[j].z * v[j].z + v[j].w * v[j].w); }
            const float rs = 1.0f / sqrtf(wave_sum(s) * (1.0f / D) + EPS);
#pragma unroll
            for (int j = 0; j < 8; ++j) xr[64 * j] = v[j] * rs * gr[64 * j];
        }
    }
#undef IN
#undef SEAM
}
constexpr int LAST_PHASE = 17;


#if MK_DEBUG
constexpr size_t WS_DBG = 548 * MiB;
constexpr size_t DBG_SAVE = WS_DBG;
constexpr size_t DBG_QREF = WS_DBG + 2 * MiB, DBG_KREF = WS_DBG + 3 * MiB, DBG_VREF = WS_DBG + 4 * MiB, DBG_OREF = WS_DBG + 6 * MiB, DBG_AREF = WS_DBG + 8 * MiB;
constexpr int NSAVE = 64;
__device__ __forceinline__ unsigned hsh(unsigned a) { a ^= a >> 16; a *= 0x7feb352dU; a ^= a >> 15; a *= 0x846ca68bU; a ^= a >> 16; return a; }
__device__ __forceinline__ int save_row(int i) { return (int)(hsh(1000u + i) % M); }
__device__ __forceinline__ float block_sum(float v) {
    __shared__ float red[4]; __shared__ float tot;
    v = wave_sum(v); __syncthreads(); if ((threadIdx.x & 63) == 0) red[threadIdx.x >> 6] = v; __syncthreads();
    if (threadIdx.x == 0) tot = (red[0] + red[1]) + (red[2] + red[3]); __syncthreads(); return tot;
}
__device__ __forceinline__ float block_max(float v) {
    __shared__ float redm[4]; __shared__ float totm;
#pragma unroll
    for (int o = 1; o < 64; o <<= 1) v = fmaxf(v, __shfl_xor(v, o));
    __syncthreads(); if ((threadIdx.x & 63) == 0) redm[threadIdx.x >> 6] = v; __syncthreads();
    if (threadIdx.x == 0) totm = fmaxf(fmaxf(redm[0], redm[1]), fmaxf(redm[2], redm[3])); __syncthreads(); return totm;
}
__device__ __forceinline__ void dbg_add(float* dbg, int id, float got, float exp) { const float d = got - exp; atomicAdd(dbg + 2 * id, d * d); atomicAdd(dbg + 2 * id + 1, exp * exp); }
__device__ __forceinline__ float bdot(const bf16* a, const float* w, int ldw, int K, const float* gain) {
    float s = 0.f; for (int k = threadIdx.x; k < K; k += 256) s += bf2f(a[k]) * w[(size_t)k * ldw] * (gain ? gain[k] : 1.0f); return block_sum(s);
}
__device__ __forceinline__ float geluf_(float v) { return 0.5f * v * (1.0f + erff(v * 0.70710678f)); }
__device__ __forceinline__ float rsof(const float* ss, int r) { return 1.0f / sqrtf(ss[r] * (1.0f / D) + EPS); }

__global__ void chk_wt(const bf16* WT, int ldk, int nrows, const float* src, const float* src2, int ldw, int mode, const float* gain, float* dbg, int id) {
    const unsigned i = blockIdx.x * 256 + threadIdx.x; const int n = hsh(i * 2 + 1) % nrows, k = hsh(i * 2 + 2) % ldk;
    const float* s = src; int col = n;
    if (mode == 1) { const int tile = n / 256, w = n % 256; s = w < 128 ? src : src2; col = 128 * tile + (w & 127); }
    if (mode == 2) col = n < 3072 ? n : n + 16;
    if (mode == 3) col = 3072 + n;
    dbg_add(dbg, id, bf2f(WT[(size_t)n * ldk + k]), s[(size_t)k * ldw + col] * (gain ? gain[k] : 1.0f));
}
__global__ void chk_rms(const float* x, const float* gain, const bf16* xb, int nrows, float* dbg, int id) {
    const int r = hsh(77u + blockIdx.x) % nrows; float s = 0.f;
    for (int k = threadIdx.x; k < D; k += 256) { const float v = x[(size_t)r * D + k]; s += v * v; }
    const float rs = 1.0f / sqrtf(block_sum(s) * (1.0f / D) + EPS);
    for (int k = threadIdx.x; k < D; k += 256) dbg_add(dbg, id, bf2f(xb[(size_t)r * D + k]), x[(size_t)r * D + k] * rs * gain[k]);
}
__global__ void chk_act(const bf16* XBp, const float* wg, const float* wu, const float* gain, const float* ss, const bf16* ACTp, float* dbg, int id) {
    const int row = hsh(3u * blockIdx.x + 11u) % M, hid = hsh(3u * blockIdx.x + 12u) % DFF;
    float g = bdot(XBp + (size_t)row * D, wg + hid, DFF, D, gain), u = bdot(XBp + (size_t)row * D, wu + hid, DFF, D, gain);
    if (ss) { const float s = rsof(ss, row); g *= s; u *= s; }
    if (threadIdx.x == 0) dbg_add(dbg, id, bf2f(ACTp[(size_t)row * DFF + hid]), g / (1.0f + expf(-g)) * u);
}
__global__ void chk_kv(const bf16* MEMBp, const float* wkv, const bf16* KBp, const bf16* VTp, float* dbg, int idk, int idv) {
    const int row = hsh(5u * blockIdx.x + 1u) % MROWS, col = hsh(5u * blockIdx.x + 2u) % 2048;
    const float v = bdot(MEMBp + (size_t)row * D, wkv + col, D, D, nullptr);
    if (threadIdx.x == 0) { if (col < 1024) dbg_add(dbg, idk, bf2f(KBp[(size_t)row * 1024 + col]), v); else dbg_add(dbg, idv, bf2f(VTp[(size_t)(col - 1024) * 2048 + row]), v); }
}
__global__ void save_rows(const float* src, float* dst) { const int r = save_row(blockIdx.x); for (int k = threadIdx.x; k < D; k += 256) dst[(size_t)blockIdx.x * D + k] = src[(size_t)r * D + k]; }
__global__ void chk_res(const float* base, int base_saved, const bf16* a, int K, const float* w, float alpha, const float* outp, const bf16* xb, float* dbg, int id, int idb) {
    const int si = blockIdx.x % NSAVE, row = save_row(si), col = hsh(7u * blockIdx.x + 3u) % D;
    const float b = base_saved ? base[(size_t)si * D + col] : base[(size_t)row * D + col];
    const float v = b + alpha * bdot(a + (size_t)row * K, w + col, D, K, nullptr);
    if (threadIdx.x == 0) { dbg_add(dbg, id, outp[(size_t)row * D + col], v); if (xb) dbg_add(dbg, idb, bf2f(xb[(size_t)row * D + col]), v); }
}
__global__ void chk_ss(const float* outp, const float* ss, float* dbg, int id) {
    const int row = hsh(91u + blockIdx.x) % M; float s = 0.f;
    for (int k = threadIdx.x; k < D; k += 256) { const float v = outp[(size_t)row * D + k]; s += v * v; }
    s = block_sum(s); if (threadIdx.x == 0) dbg_add(dbg, id, ss[row], s);
}
__global__ void chk_proj(const bf16* XBp, const float* win, const float* mixn, const float* ss, const unsigned char* ws, float* dbg, int id, int idg) {
    const int row = hsh(9u * blockIdx.x + 1u) % M, j = hsh(9u * blockIdx.x + 2u) % (NPROJ + 16);
    const int srccol = j < 3072 ? j : (j < NPROJ ? j + 16 : 3072 + (j - NPROJ));
    float v = rsof(ss, row) * bdot(XBp + (size_t)row * D, win + srccol, INW, D, mixn);
    if (threadIdx.x != 0) return;
    if (j >= NPROJ) { dbg_add(dbg, idg, ((const float*)(ws + WS_GLR))[(size_t)row * 16 + (j - NPROJ)], v); return; }
    float got;
    if (j < 512) got = bf2f(((const bf16*)(ws + WS_Q))[(size_t)row * 512 + j]);
    else if (j < 1024) got = bf2f(((const bf16*)(ws + WS_K))[(size_t)row * 512 + j - 512]);
    else if (j < 2048) got = bf2f(((const bf16*)(ws + WS_V))[(size_t)row * 1024 + j - 1024]);
    else if (j < 3072) got = bf2f(((const bf16*)(ws + WS_R))[(size_t)row * 1024 + j - 2048]);
    else if (j < 4096) { got = bf2f(((const bf16*)(ws + WS_SU))[(size_t)row * 1024 + j - 3072]); v = geluf_(v); }
    else if (j < 5120) { got = bf2f(((const bf16*)(ws + WS_SV))[(size_t)row * 1024 + j - 4096]); v = geluf_(v); }
    else got = bf2f(((const bf16*)(ws + WS_XQ))[(size_t)row * 1024 + j - 5120]);
    dbg_add(dbg, id, got, v);
}
__global__ void chk_sg(const bf16* XBp, const float* win, const float* mixn, const float* ss, const bf16* SVp, const bf16* Ysg, const float* lng, const float* lnb, const float* wsp, const float* bsp, float* dbg, int id) {
    const int tok = hsh(13u * blockIdx.x + 1u) % M, g = hsh(13u * blockIdx.x + 2u) % 4, c = hsh(13u * blockIdx.x + 3u) % 256;
    const int t = tok % 128, tok0 = tok - t;
    const float su = geluf_(rsof(ss, tok) * bdot(XBp + (size_t)tok * D, win + 3088 + g * 256 + c, INW, D, mixn));
    float part = 0.f;
    if (threadIdx.x <= t && threadIdx.x < 128) { const int s = threadIdx.x; const bf16* p = SVp + (size_t)(tok0 + s) * 1024 + g * 256; float s1 = 0.f, s2 = 0.f;
        for (int k = 0; k < 256; ++k) { const float v = bf2f(p[k]); s1 += v; s2 += v * v; }
        const float mu = s1 / 256.0f, var = fmaxf(s2 / 256.0f - mu * mu, 0.f);
        const float vn = (bf2f(p[c]) - mu) / sqrtf(var + EPS) * lng[g * 256 + c] + lnb[g * 256 + c];
        part = wsp[((size_t)g * 128 + t) * 128 + s] * vn; }
    const float acc = block_sum(part);
    if (threadIdx.x == 0) dbg_add(dbg, id, bf2f(Ysg[(size_t)tok * 1024 + g * 256 + c]), su * (acc + bsp[g * 128 + t]));
}
__global__ void chk_xa(const bf16* XBp, const float* win, const float* mixn, const float* ss, const bf16* KBp, const bf16* VTp, const bf16* Yxa, float* dbg, int id) {
    __shared__ float qsh[256];
    const int tok = hsh(17u * blockIdx.x + 1u) % M, h = hsh(17u * blockIdx.x + 2u) % 4, e = hsh(17u * blockIdx.x + 3u) % 256, b = tok / SEQ;
    { const int d = threadIdx.x; float s = 0.f; const bf16* a = XBp + (size_t)tok * D; const float* w = win + 5136 + h * 256 + d;
      for (int k = 0; k < D; ++k) s += bf2f(a[k]) * w[(size_t)k * INW] * mixn[k];
      qsh[d] = s * rsof(ss, tok); }
    __syncthreads();
    const int m = threadIdx.x; float sc = 0.f; const bf16* kp = KBp + (size_t)(b * 256 + m) * 1024 + h * 256;
    for (int d = 0; d < 256; ++d) sc += qsh[d] * bf2f(kp[d]);
    sc *= 0.0625f;
    const float mx = block_max(sc), p = expf(sc - mx), sum = block_sum(p);
    const float o = block_sum(p * bf2f(VTp[(size_t)(h * 256 + e) * 2048 + b * 256 + m])) / sum;
    if (threadIdx.x == 0) dbg_add(dbg, id, bf2f(Yxa[(size_t)tok * 1024 + h * 256 + e]), o);
}
__global__ void gla_refA(const bf16* XBp, const float* win, const float* mixn, const float* ss, const float* GLRp, const float* wup, const float* gbias, int b, int h, float* qref, float* kref, float* vref, float* aref) {
    const int t = blockIdx.x, tok = b * SEQ + t; const bf16* a = XBp + (size_t)tok * D; const float rs = rsof(ss, tok);
    for (int o = threadIdx.x; o < 512; o += 256) {
        const int srccol = o < 128 ? h * 128 + o : (o < 256 ? 512 + h * 128 + (o - 128) : 1024 + h * 256 + (o - 256));
        float s = 0.f; const float* w = win + srccol; for (int k = 0; k < D; ++k) s += bf2f(a[k]) * w[(size_t)k * INW] * mixn[k];
        s *= rs; if (o < 128) qref[t * 128 + o] = s; else if (o < 256) kref[t * 128 + o - 128] = s; else vref[t * 256 + o - 256] = s;
    }
    if (threadIdx.x < 128) { const int d = threadIdx.x; float z = gbias[h * 128 + d]; for (int r = 0; r < 16; ++r) z += GLRp[(size_t)tok * 16 + r] * wup[r * 512 + h * 128 + d];
        const float ls = fminf(z, 0.f) - log1pf(expf(-fabsf(z))); aref[t * 128 + d] = expf(ls / 16.0f); }
}
__global__ void gla_refB(const float* qref, const float* kref, const float* vref, const float* aref, float* oref) {
    const int e = blockIdx.x, d = threadIdx.x & 127; const bool act = threadIdx.x < 128; float S = 0.f;
    for (int t = 0; t < SEQ; ++t) { float p = 0.f; if (act) { S = aref[t * 128 + d] * S + kref[t * 128 + d] * vref[t * 256 + e]; p = qref[t * 128 + d] * GLA_SCALE * S; }
        const float o = block_sum(p); if (threadIdx.x == 0) oref[t * 256 + e] = o; }
}
__global__ void gla_refC(const float* oref, const bf16* Rp, const bf16* Ygla, const float* onorm, int b, int h, float* dbg, int id) {
    const int t = blockIdx.x, e = threadIdx.x, tok = b * SEQ + t; const float o = oref[t * 256 + e];
    const float rs = 1.0f / sqrtf(block_sum(o * o) / 256.0f + EPS); const float r = bf2f(Rp[(size_t)tok * 1024 + h * 256 + e]);
    dbg_add(dbg, id, bf2f(Ygla[(size_t)tok * 1024 + h * 256 + e]), o * rs * onorm[h * 256 + e] * (r / (1.0f + expf(-r))));
}
__global__ void chk_gate(const bf16* XBp, const float* win, const float* mixn, const float* ss, const bf16* GTp, int i, float* dbg, int id) {
    const int row = hsh(19u * blockIdx.x + 1u) % M, col = hsh(19u * blockIdx.x + 2u) % D;
    const float v = rsof(ss, row) * bdot(XBp + (size_t)row * D, win + 6160 + i * D + col, INW, D, mixn);
    if (threadIdx.x == 0) dbg_add(dbg, id, bf2f(GTp[(size_t)row * D + col]), 1.0f / (1.0f + expf(-v)));
}
__global__ void chk_mrg(const bf16* XBp, const float* win, const float* mixn, const float* ss, const bf16* Y0, const bf16* Y1, const bf16* Y2, const float* wbr, const bf16* MRGp, float* dbg, int id) {
    const int row = hsh(23u * blockIdx.x + 1u) % M, col = hsh(23u * blockIdx.x + 2u) % D; float tot = 0.f;
    for (int i = 0; i < 3; ++i) { const float gp = rsof(ss, row) * bdot(XBp + (size_t)row * D, win + 6160 + i * D + col, INW, D, mixn);
        const bf16* Y = i == 0 ? Y0 : (i == 1 ? Y1 : Y2); const float z = bdot(Y + (size_t)row * 1024, wbr + (size_t)i * 1024 * D + col, D, 1024, nullptr);
        tot += z / (1.0f + expf(-gp)); }
    if (threadIdx.x == 0) dbg_add(dbg, id, bf2f(MRGp[(size_t)row * D + col]), tot);
}
__global__ void chk_final(const float* saved, const float* fn, const float* outp, float* dbg, int id) {
    const int si = blockIdx.x, row = save_row(si); float s = 0.f;
    for (int k = threadIdx.x; k < D; k += 256) { const float v = saved[(size_t)si * D + k]; s += v * v; }
    const float rs = 1.0f / sqrtf(block_sum(s) * (1.0f / D) + EPS);
    for (int k = threadIdx.x; k < D; k += 256) dbg_add(dbg, id, outp[(size_t)row * D + k], saved[(size_t)si * D + k] * rs * fn[k]);
}
__global__ void dbg_report(const float* dbg, float* outp, int nchk, int only) {
    int bad = -1;
    for (int k = 0; k < nchk; ++k) { const float num = dbg[2 * k], den = dbg[2 * k + 1]; if (num == 0.f && den == 0.f) continue; if (!(num < 1e-3f * den)) { bad = k; break; } }
    if (only >= 0) { const float num = dbg[2 * only], den = dbg[2 * only + 1]; bad = -1; if (!(num < 1e-3f * den)) bad = only; }
    if (bad < 0) return;
    const float c = (float)(bad + 2);
    for (size_t i = (size_t)blockIdx.x * 256 + threadIdx.x; i < (size_t)M * D; i += (size_t)gridDim.x * 256) outp[i] = c;
}
#endif

extern "C" void kernel_launch(void* const* d_in, const int* in_sizes, int n_in, void* d_out, int out_size, void* d_ws, size_t ws_size, hipStream_t stream) {
    static int grid = 0;
    if (grid == 0) {
        if (n_in != N_IN || in_sizes[0] != M * D || out_size != M * D || ws_size < WS_END) {
            fprintf(stderr, "kernel_launch: unexpected problem (n_in %d, in0 %d, out %d, ws %zu, need %zu); nothing launched\n", n_in, n_in > 0 ? in_sizes[0] : -1, out_size, ws_size, (size_t)WS_END); grid = -1; return; }
        int dev = 0, cus = 0, per_cu = 0;
        if (hipGetDevice(&dev) != hipSuccess || hipDeviceGetAttribute(&cus, hipDeviceAttributeMultiprocessorCount, dev) != hipSuccess) { grid = -1; return; }
        if (hipFuncSetAttribute((const void*)mk_fwd, hipFuncAttributeMaxDynamicSharedMemorySize, LDS_BYTES) != hipSuccess) { fprintf(stderr, "kernel_launch: hipFuncSetAttribute failed\n"); grid = -1; return; }
        if (hipOccupancyMaxActiveBlocksPerMultiprocessor(&per_cu, (const void*)mk_fwd, NTHREADS, LDS_BYTES) != hipSuccess || per_cu < 1)
            fprintf(stderr, "kernel_launch: note: occupancy query reports %d workgroups per CU\n", per_cu);
        (void)hipGetLastError();
        grid = cus;
        if (grid != 256) fprintf(stderr, "kernel_launch: %d CUs; this kernel's static work split assumes 256\n", grid);
    }
    if (grid < 0) return;
    if (hipMemsetAsync((char*)d_ws + WS_CTL, 0, CTL_ZERO_BYTES, stream) != hipSuccess) return;
    Args a{};
    for (int i = 0; i < N_IN; ++i) a.in[i] = (const float*)d_in[i];
    a.out = (float*)d_out; a.ws = (unsigned char*)d_ws;
#if MK_PER_PHASE
    for (int p = 0; p < LAST_PHASE; ++p) { a.ph_lo = p; a.ph_hi = p + 1; hipLaunchKernelGGL(mk_fwd, dim3(grid), dim3(NTHREADS), LDS_BYTES, stream, a);
#if MK_DEBUG
        unsigned char* ws = (unsigned char*)d_ws; float* dbg = (float*)(ws + CTL_DBG); const float** in = (const float**)a.in; float* outp = (float*)d_out;
        const bf16* XBp = (const bf16*)(ws + WS_XB); const float* SS1p = (const float*)(ws + CTL_SS1); const float* SS2p = (const float*)(ws + CTL_SS2);
        float* sv1 = (float*)(ws + DBG_SAVE); float* sv2 = sv1 + NSAVE * D; float* sv3 = sv2 + NSAVE * D;
        if (p == 0) {
            chk_rms<<<64, 256, 0, stream>>>(in[I_X], in[I_F1N], XBp, M, dbg, 0);
            chk_wt<<<64, 256, 0, stream>>>((const bf16*)(ws + WS_WGU1), D, NGU, in[I_F1G], in[I_F1U], DFF, 1, nullptr, dbg, 1);
            chk_wt<<<64, 256, 0, stream>>>((const bf16*)(ws + WS_WIN), D, 12288, in[I_WIN], nullptr, INW, 2, in[I_MIXN], dbg, 2);
            chk_wt<<<64, 256, 0, stream>>>((const bf16*)(ws + WS_WD1), DFF, D, in[I_F1D], nullptr, D, 0, nullptr, dbg, 3);
            chk_wt<<<64, 256, 0, stream>>>((const bf16*)(ws + WS_WKV), D, D, in[I_WKV], nullptr, D, 0, nullptr, dbg, 4);
            for (int i = 0; i < 3; ++i) chk_wt<<<32, 256, 0, stream>>>((const bf16*)(ws + WS_WB) + (size_t)i * D * 1024, 1024, D, in[I_WBR] + (size_t)i * 1024 * D, nullptr, D, 0, nullptr, dbg, 5);
            chk_wt<<<64, 256, 0, stream>>>((const bf16*)(ws + WS_WO), D, D, in[I_WOUT], nullptr, D, 0, nullptr, dbg, 6);
            chk_wt<<<64, 256, 0, stream>>>((const bf16*)(ws + WS_WGU2), D, NGU, in[I_F2G], in[I_F2U], DFF, 1, in[I_F2N], dbg, 7);
            chk_wt<<<64, 256, 0, stream>>>((const bf16*)(ws + WS_WD2), DFF, D, in[I_F2D], nullptr, D, 0, nullptr, dbg, 8);
            chk_rms<<<64, 256, 0, stream>>>(in[I_MEM], in[I_MEMN], (const bf16*)(ws + WS_MEMB), MROWS, dbg, 9);
            chk_wt<<<16, 256, 0, stream>>>((const bf16*)(ws + WS_WGLR), D, 16, in[I_WIN], nullptr, INW, 3, in[I_MIXN], dbg, 10);
        }
        if (p == 1) { chk_act<<<512, 256, 0, stream>>>(XBp, in[I_F1G], in[I_F1U], nullptr, nullptr, (const bf16*)(ws + WS_ACT), dbg, 11);
            chk_kv<<<512, 256, 0, stream>>>((const bf16*)(ws + WS_MEMB), in[I_WKV], (const bf16*)(ws + WS_KB), (const bf16*)(ws + WS_VT), dbg, 12, 13); }
        if (p == 2) { chk_res<<<512, 256, 0, stream>>>(in[I_X], 0, (const bf16*)(ws + WS_ACT), DFF, in[I_F1D], 0.5f, outp, XBp, dbg, 14, 15);
            chk_ss<<<64, 256, 0, stream>>>(outp, SS1p, dbg, 16); save_rows<<<NSAVE, 256, 0, stream>>>(outp, sv1); }
        if (p == 3) chk_proj<<<1024, 256, 0, stream>>>(XBp, in[I_WIN], in[I_MIXN], SS1p, ws, dbg, 17, 18);
        if (p == 6) {
            chk_sg<<<256, 256, 0, stream>>>(XBp, in[I_WIN], in[I_MIXN], SS1p, (const bf16*)(ws + WS_SV), (const bf16*)(ws + WS_SU), in[I_LNG], in[I_LNB], in[I_WS], in[I_BS], dbg, 19);
            chk_xa<<<256, 256, 0, stream>>>(XBp, in[I_WIN], in[I_MIXN], SS1p, (const bf16*)(ws + WS_KB), (const bf16*)(ws + WS_VT), (const bf16*)(ws + WS_XQ), dbg, 20);
            const int gb = 3, gh = 2; float* qr = (float*)(ws + DBG_QREF); float* kr = (float*)(ws + DBG_KREF); float* vr = (float*)(ws + DBG_VREF); float* orf = (float*)(ws + DBG_OREF); float* ar = (float*)(ws + DBG_AREF);
            gla_refA<<<SEQ, 256, 0, stream>>>(XBp, in[I_WIN], in[I_MIXN], SS1p, (const float*)(ws + WS_GLR), in[I_GUP], in[I_GB], gb, gh, qr, kr, vr, ar);
            gla_refB<<<256, 256, 0, stream>>>(qr, kr, vr, ar, orf);
            gla_refC<<<SEQ, 256, 0, stream>>>(orf, (const bf16*)(ws + WS_R), (const bf16*)(ws + WS_V), in[I_GON], gb, gh, dbg, 21);
        }
        if (p == 7 || p == 9 || p == 11) chk_gate<<<256, 256, 0, stream>>>(XBp, in[I_WIN], in[I_MIXN], SS1p, (const bf16*)(ws + WS_G), (p - 7) / 2, dbg, 22 + (p - 7) / 2);
        if (p == 12) chk_mrg<<<256, 256, 0, stream>>>(XBp, in[I_WIN], in[I_MIXN], SS1p, (const bf16*)(ws + WS_V), (const bf16*)(ws + WS_SU), (const bf16*)(ws + WS_XQ), in[I_WBR], (const bf16*)(ws + WS_MRG), dbg, 25);
        if (p == 13) { chk_res<<<512, 256, 0, stream>>>(sv1, 1, (const bf16*)(ws + WS_MRG), D, in[I_WOUT], 1.0f, outp, XBp, dbg, 26, 27);
            chk_ss<<<64, 256, 0, stream>>>(outp, SS2p, dbg, 28); save_rows<<<NSAVE, 256, 0, stream>>>(outp, sv2); }
        if (p == 14) chk_act<<<512, 256, 0, stream>>>(XBp, in[I_F2G], in[I_F2U], in[I_F2N], SS2p, (const bf16*)(ws + WS_ACT), dbg, 29);
        if (p == 15) { chk_res<<<512, 256, 0, stream>>>(sv2, 1, (const bf16*)(ws + WS_ACT), DFF, in[I_F2D], 0.5f, outp, nullptr, dbg, 30, 30); save_rows<<<NSAVE, 256, 0, stream>>>(outp, sv3); }
        if (p == 16) { chk_final<<<NSAVE, 256, 0, stream>>>(sv3, in[I_FN], outp, dbg, 31); dbg_report<<<1024, 256, 0, stream>>>(dbg, outp, 32, MK_DEBUG_ONLY); }
#endif
    }
#else
    a.ph_lo = 0; a.ph_hi = LAST_PHASE;
    hipLaunchKernelGGL(mk_fwd, dim3(grid), dim3(NTHREADS), LDS_BYTES, stream, a);
#endif
}
```

```cpp
#include <hip/hip_runtime.h>
#include <cstdio>
#include <cstdint>

#ifndef MK_PER_PHASE
#define MK_PER_PHASE 0
#endif
#ifndef MK_DEBUG
#define MK_DEBUG 0
#endif
#ifndef MK_STAMP
#define MK_STAMP 0
#endif
#ifndef MK_STAMP_A
#define MK_STAMP_A 20
#endif
#ifndef MK_STAMP_B
#define MK_STAMP_B 0
#endif
#ifndef MK_DUP
#define MK_DUP (-1)
#endif
#ifndef MK_DEBUG_ONLY
#define MK_DEBUG_ONLY (-1)
#endif

#define GAS __attribute__((address_space(1)))
#define LAS __attribute__((address_space(3)))
typedef unsigned short bf16;
typedef unsigned v4u __attribute__((ext_vector_type(4)));
typedef unsigned v2u __attribute__((ext_vector_type(2)));
typedef float f32x4 __attribute__((ext_vector_type(4)));
typedef float f32x2 __attribute__((ext_vector_type(2)));
typedef float f32x16 __attribute__((ext_vector_type(16)));
typedef short bf16x8 __attribute__((ext_vector_type(8)));
typedef __bf16 bf16x2_t __attribute__((ext_vector_type(2)));

constexpr int D = 2048, BATCH = 8, SEQ = 2048, M = BATCH * SEQ, MEMLEN = 256, MROWS = BATCH * MEMLEN;
constexpr int DFF = 5632, NGU = 2 * DFF;
constexpr int INW = 12304;
constexpr int NPROJ = 6144;
constexpr float EPS = 1e-6f;
constexpr int NWAVES = 8, NTHREADS = 512;

constexpr size_t MiB = 1u << 20;
constexpr size_t WS_CTL = 0, CTL_ZERO_BYTES = 1 * MiB;
constexpr size_t WS_GLR = 1 * MiB;
constexpr size_t WS_ADEC = 2 * MiB;
constexpr size_t WS_WGLR = 2 * MiB + 512 * 1024;
constexpr size_t WS_KB = 3 * MiB;
constexpr size_t WS_VT = 7 * MiB;
constexpr size_t WS_MEMB = 11 * MiB;
constexpr size_t WS_WGU1 = 20 * MiB;
constexpr size_t WS_WD1 = 64 * MiB;
constexpr size_t WS_WIN = 86 * MiB;
constexpr size_t WS_WKV = 134 * MiB;
constexpr size_t WS_WB = 142 * MiB;
constexpr size_t WS_WO = 154 * MiB;
constexpr size_t WS_WGU2 = 162 * MiB;
constexpr size_t WS_WD2 = 206 * MiB;
constexpr size_t WS_XB = 228 * MiB;
constexpr size_t WS_C = 292 * MiB;
constexpr size_t WS_ACT = WS_C;
constexpr size_t WS_Q = WS_C;
constexpr size_t WS_K = WS_C + 16 * MiB;
constexpr size_t WS_V = WS_C + 32 * MiB;
constexpr size_t WS_SU = WS_C + 64 * MiB;
constexpr size_t WS_XQ = WS_C + 96 * MiB;
constexpr size_t WS_R = WS_C + 128 * MiB;
constexpr size_t WS_SV = WS_C + 160 * MiB;
constexpr size_t WS_MRG = WS_R;
constexpr size_t WS_G = WS_C + 192 * MiB;
constexpr size_t WS_END = WS_C + 256 * MiB;

constexpr int CW_TMO = 0;
constexpr int CW_BAR = 4096;
constexpr size_t CTL_SS1 = 128 * 1024, CTL_SS2 = 192 * 1024, CTL_SS0 = 320 * 1024, CTL_SS3 = 384 * 1024;
constexpr size_t CTL_DBG = 256 * 1024;

constexpr int RING_BYTES = 131072;
constexpr int MISC_OFF = RING_BYTES + 320;
constexpr int LDS_BYTES = 147456;

#define LDS_WAIT() asm volatile("s_waitcnt lgkmcnt(0)" ::: "memory")
#define VM_WAIT() asm volatile("s_waitcnt vmcnt(0)" ::: "memory")
__device__ __forceinline__ unsigned cvtpk(float lo, float hi) { f32x2 v = {lo, hi}; bf16x2_t b = __builtin_convertvector(v, bf16x2_t); return __builtin_bit_cast(unsigned, b); }
__device__ __forceinline__ float bflo(unsigned u) { return __builtin_bit_cast(float, u << 16); }
__device__ __forceinline__ float bfhi(unsigned u) { return __builtin_bit_cast(float, u & 0xffff0000u); }
__device__ __forceinline__ float bf2f(bf16 b) { return __builtin_bit_cast(float, (unsigned)b << 16); }
__device__ __forceinline__ bf16 f2bf(float f) { return (bf16)(cvtpk(f, 0.f) & 0xffffu); }
__device__ __forceinline__ float wave_sum(float v) {
#pragma unroll
    for (int o = 1; o < 64; o <<= 1) v += __shfl_xor(v, o);
    return v;
}
__device__ __forceinline__ float fast_exp(float x) { return __builtin_amdgcn_exp2f(x * 1.4426950408889634f); }
__device__ __forceinline__ float sigmoidf_(float x) { return __builtin_amdgcn_rcpf(1.0f + fast_exp(-x)); }

namespace pg8 {
constexpr int BM = 256, BK = 64, HALF = 128, HTB = HALF * BK * 2, STAGE_BYTES = 8 * HTB, NXCD = 8, WGM = 8;
__host__ __device__ __forceinline__ int lds_byte(int r, int c) { const int st = (r >> 4) * 2 + (c >> 5), rr = r & 15, cc = c & 31, ob = rr * 64 + cc * 2; return st * 1024 + (ob ^ (((ob >> 9) & 1) << 5)); }
__host__ __device__ __forceinline__ void stage_rc(int b, int& R, int& C) { const int st = b / 1024, sb = b % 1024, swz = sb ^ (((sb >> 9) & 1) << 5); R = (st >> 1) * 16 + swz / 64; C = (st & 1) * 32 + (swz % 64) / 2; }
__host__ __device__ __forceinline__ int perm32(int rho) { const int n = rho >> 4, i = rho & 15; return 8 * (i >> 2) + 4 * n + (i & 3); }

struct Unit { const char* A; const char* B; int pm, pn, kind, seq; };

__device__ __forceinline__ void tile_of(int L, int nM, int nN, int& pm, int& pn) {
    const int nwg = nM * nN;
    int wgid = L; { const int q = nwg / NXCD, r = nwg % NXCD, xcd = wgid % NXCD, off = wgid / NXCD; wgid = (xcd < r ? xcd * (q + 1) : r * (q + 1) + (xcd - r) * q) + off; }
    const int nig = WGM * nN, gid = wgid / nig, fm = gid * WGM, gsz = (nM - fm) < WGM ? (nM - fm) : WGM;
    pm = fm + ((wgid % nig) % gsz); pn = (wgid % nig) / gsz;
}

template <class Epi, class Sched, bool STAMP = false>
__device__ __forceinline__ void gemm_phase(LAS unsigned char* lds, const int K, const int lda, const int ldb, const Sched& S, const Epi& E, unsigned long long* st = nullptr) {
    unsigned long long kc = 0, ec = 0, t0 = 0; unsigned nun = 0;
    int tid = threadIdx.x; asm volatile("" : "+v"(tid));
    const int wid = __builtin_amdgcn_readfirstlane(tid >> 6), lane = tid & 63, wr = wid >> 2, wc = wid & 3, fr = lane & 15, fq = lane >> 4;
    const int nt = K / BK;
    unsigned voffA[2], voffB[2];
#pragma unroll
    for (int i = 0; i < 2; ++i) { int R, C; stage_rc(tid * 16 + i * 8192, R, C); const int Rb = (R & ~31) + perm32(R & 31);
        voffA[i] = (unsigned)(R * lda + C) * 2u; voffB[i] = (unsigned)(Rb * ldb + C) * 2u; }
    const size_t kstep = (size_t)(BK * 2);
    const size_t hstepA = (size_t)HALF * lda * 2, hstepB = (size_t)HALF * ldb * 2;
    const unsigned ldsw = (unsigned)wid * 1024u;
    const int aoff = lds_byte(wr * 64 + fr, fq * 8), boff = lds_byte(wc * 32 + fr, fq * 8);
#define PG8_SA(b, h) (((b) * 2 + (h)) * HTB)
#define PG8_SB(b, h) ((4 + (b) * 2 + (h)) * HTB)
#define PG8_STAGE(bufoff, gbase, voff) do { _Pragma("unroll") for (int _i = 0; _i < 2; ++_i) \
        __builtin_amdgcn_global_load_lds((const unsigned*)((const char*)(gbase) + (voff)[_i]), (LAS unsigned*)(lds + (bufoff) + ldsw + _i * 8192), 16, 0, 0); } while (0)
#define PG8_LDA(dst, b, h) do { _Pragma("unroll") for (int m = 0; m < 4; ++m) _Pragma("unroll") for (int k = 0; k < 2; ++k) dst[m][k] = *(const LAS bf16x8*)(lds + PG8_SA(b, h) + aoff + m * 2048 + k * 1024); } while (0)
#define PG8_LDB(dst, b, h) do { _Pragma("unroll") for (int n = 0; n < 2; ++n) _Pragma("unroll") for (int k = 0; k < 2; ++k) dst[n][k] = *(const LAS bf16x8*)(lds + PG8_SB(b, h) + boff + n * 2048 + k * 1024); } while (0)
#define PG8_MMA(ai, bj, At, Bt) do { __builtin_amdgcn_s_setprio(1); _Pragma("unroll") for (int m = 0; m < 4; ++m) _Pragma("unroll") for (int n = 0; n < 2; ++n) _Pragma("unroll") for (int k = 0; k < 2; ++k) \
        acc[ai][bj][m][n] = __builtin_amdgcn_mfma_f32_16x16x32_bf16(Bt[n][k], At[m][k], acc[ai][bj][m][n], 0, 0, 0); __builtin_amdgcn_s_setprio(0); } while (0)
#define PG8_WAIT_V(n) asm volatile("s_waitcnt vmcnt(" #n ")" ::: "memory")
#define PG8_WAIT_L(n) asm volatile("s_waitcnt lgkmcnt(" #n ")" ::: "memory")
#define PG8_BAR __builtin_amdgcn_s_barrier()
#define PG8_SCHED __builtin_amdgcn_sched_barrier(0)
    Unit cur, nxt; int ui = 0;
    if (!S.next(0, cur)) return;
    f32x4 acc[2][2][4][2];
#pragma unroll
    for (int a = 0; a < 2; ++a)
#pragma unroll
        for (int b = 0; b < 2; ++b)
#pragma unroll
            for (int m = 0; m < 4; ++m)
#pragma unroll
                for (int n = 0; n < 2; ++n) acc[a][b][m][n] = (f32x4){0.f, 0.f, 0.f, 0.f};
    bf16x8 At[4][2], B0[2][2], B1[2][2];
    const char* cA = cur.A; const char* cB = cur.B;
    PG8_STAGE(PG8_SB(0, 0), cB, voffB); PG8_STAGE(PG8_SB(0, 1), cB + hstepB, voffB); PG8_STAGE(PG8_SA(0, 0), cA, voffA); PG8_STAGE(PG8_SA(0, 1), cA + hstepA, voffA);
    if (wr == 1) PG8_BAR;
    PG8_WAIT_V(2); PG8_BAR;
    PG8_STAGE(PG8_SB(1, 0), cB + kstep, voffB); PG8_STAGE(PG8_SA(1, 0), cA + kstep, voffA); PG8_STAGE(PG8_SB(1, 1), cB + hstepB + kstep, voffB);
    PG8_WAIT_V(6); PG8_BAR;
    for (;;) {
        const bool has_next = S.next(ui + 1, nxt);
        const char* nA = has_next ? nxt.A : cA; const char* nB = has_next ? nxt.B : cB;
        if (STAMP) t0 = __builtin_amdgcn_s_memtime();
        for (int t = 0; t < nt; t += 2) {
            const bool last = (t == nt - 2);
            const char* a1 = cA + (size_t)(t + 1) * kstep;
            const char* a2 = last ? nA : cA + (size_t)(t + 2) * kstep; const char* b2 = last ? nB : cB + (size_t)(t + 2) * kstep;
            const char* a3 = a2 + kstep; const char* b3 = b2 + kstep;
            PG8_LDB(B0, 0, 0); PG8_LDB(B1, 0, 1); PG8_SCHED; PG8_LDA(At, 0, 0); PG8_STAGE(PG8_SA(1, 1), a1 + hstepA, voffA);
            PG8_WAIT_V(8); PG8_WAIT_L(0); PG8_BAR; PG8_MMA(0, 0, At, B0); PG8_MMA(0, 1, At, B1); PG8_BAR; PG8_SCHED;
            PG8_LDA(At, 0, 1); PG8_STAGE(PG8_SB(0, 0), b2, voffB); PG8_STAGE(PG8_SB(0, 1), b2 + hstepB, voffB); PG8_STAGE(PG8_SA(0, 0), a2, voffA);
            PG8_WAIT_V(8); PG8_WAIT_L(0); PG8_BAR; PG8_MMA(1, 0, At, B0); PG8_MMA(1, 1, At, B1); PG8_BAR; PG8_SCHED;
            PG8_LDB(B0, 1, 0); PG8_LDB(B1, 1, 1); PG8_SCHED; PG8_LDA(At, 1, 0); PG8_STAGE(PG8_SA(0, 1), a2 + hstepA, voffA);
            PG8_WAIT_V(8); PG8_WAIT_L(0); PG8_BAR; PG8_MMA(0, 0, At, B0); PG8_MMA(0, 1, At, B1); PG8_BAR; PG8_SCHED;
            PG8_LDA(At, 1, 1); PG8_STAGE(PG8_SB(1, 0), b3, voffB); PG8_STAGE(PG8_SB(1, 1), b3 + hstepB, voffB); PG8_STAGE(PG8_SA(1, 0), a3, voffA);
            PG8_WAIT_V(8); PG8_WAIT_L(0); PG8_BAR; PG8_MMA(1, 0, At, B0); PG8_MMA(1, 1, At, B1); PG8_BAR; PG8_SCHED;
        }
        if (STAMP) { const unsigned long long t1 = __builtin_amdgcn_s_memtime(); kc += t1 - t0; t0 = t1; }
        if (wr == 0) PG8_BAR;
        E(acc, cur, wr, wc, fr, fq);
        if (STAMP) { asm volatile("s_waitcnt vmcnt(0)" ::: "memory"); const unsigned long long t1 = __builtin_amdgcn_s_memtime(); ec += t1 - t0; ++nun; }
        if (!has_next) break;
#pragma unroll
        for (int a = 0; a < 2; ++a)
#pragma unroll
            for (int b = 0; b < 2; ++b)
#pragma unroll
                for (int m = 0; m < 4; ++m)
#pragma unroll
                    for (int n = 0; n < 2; ++n) acc[a][b][m][n] = (f32x4){0.f, 0.f, 0.f, 0.f};
        cur = nxt; cA = nA; cB = nB; ++ui;
        if (wr == 1) PG8_BAR;
    }
    PG8_WAIT_V(0);
    PG8_BAR;
    if (STAMP && st && threadIdx.x == 0) { st[0] = kc; st[1] = ec; st[2] = nun; }
#undef PG8_SA
#undef PG8_SB
#undef PG8_STAGE
#undef PG8_LDA
#undef PG8_LDB
#undef PG8_MMA
#undef PG8_WAIT_V
#undef PG8_WAIT_L
#undef PG8_BAR
#undef PG8_SCHED
}

__device__ __forceinline__ float gelu1(float v) {
    const float av = __builtin_fabsf(v), d = av * 0.2316418882f + 1.0f;
    const float t = __builtin_amdgcn_rcpf(d);
    float q = t * 0.5307027145f + (-0.7265760135f); q = q * t + 0.7107068705f; q = q * t + (-0.142248368f); q = q * t + 0.127414796f; q = q * t;
    const float e = __builtin_amdgcn_exp2f((v * v) * (-0.72134752044f));
    const float mm = v * (q * e), r = v - mm;
    return v < 0.f ? mm : r;
}
__device__ __forceinline__ f32x2 gelu_pk(f32x2 v) {
    const f32x2 av = __builtin_elementwise_abs(v), d = av * 0.2316418882f + 1.0f;
    f32x2 t; t.x = __builtin_amdgcn_rcpf(d.x); t.y = __builtin_amdgcn_rcpf(d.y);
    f32x2 q = t * 0.5307027145f + (-0.7265760135f); q = q * t + 0.7107068705f; q = q * t + (-0.142248368f); q = q * t + 0.127414796f; q = q * t;
    const f32x2 s = (v * v) * (-0.72134752044f);
    f32x2 e; e.x = __builtin_amdgcn_exp2f(s.x); e.y = __builtin_amdgcn_exp2f(s.y);
    const f32x2 m = v * (q * e), r = v - m;
    f32x2 o; o.x = v.x < 0.f ? m.x : r.x; o.y = v.y < 0.f ? m.y : r.y; return o;
}
__device__ __forceinline__ f32x2 rcp1pexp2_pk(f32x2 t) {
    f32x2 e; e.x = __builtin_amdgcn_exp2f(t.x); e.y = __builtin_amdgcn_exp2f(t.y);
    const f32x2 d = e + 1.0f; f32x2 r; r.x = __builtin_amdgcn_rcpf(d.x); r.y = __builtin_amdgcn_rcpf(d.y); return r;
}
}

#define XB_TMO      128
#define XB_XCNT(j)  (256  + 64 * (j))
#define XB_XSUB(j)  (1280 + 64 * (j))
#define XB_XGEN(j)  (2304 + 64 * (j))
#define XB_TOP      3328
#define XB_TOPGEN   3392
#define XCD_BAR_WORDS 3456
#define XB_SPIN_CAP (1u << 18)
__device__ __forceinline__ unsigned xb_ld(unsigned* p)              { return __hip_atomic_load(p, __ATOMIC_RELAXED, __HIP_MEMORY_SCOPE_AGENT); }
__device__ __forceinline__ unsigned xb_add(unsigned* p, unsigned v) { return __hip_atomic_fetch_add(p, v, __ATOMIC_RELAXED, __HIP_MEMORY_SCOPE_AGENT); }
__device__ __forceinline__ unsigned xb_xcc_id() { return (unsigned)__builtin_amdgcn_s_getreg((3 << 11) | 20) & 0xFu; }
#define XB_SPIN(cond, bar) do { unsigned _sp = 0; while (cond) { __builtin_amdgcn_s_sleep(1); \
    if ((++_sp & 255u) == 0u) { if (xb_ld(&(bar)[XB_TMO])) break; if (_sp > XB_SPIN_CAP) { atomicAdd(&(bar)[XB_TMO], 1u); break; } } } } while (0)
struct XcdBarrier { unsigned* bar; unsigned x; volatile LAS unsigned* st; };
__device__ __forceinline__ XcdBarrier xcd_barrier_post(unsigned* bar, volatile LAS unsigned* st) {
    XcdBarrier b; b.bar = bar; b.x = xb_xcc_id(); b.st = st;
    if (threadIdx.x == 0) (void)xb_add(&bar[XB_XCNT(b.x)], 1u);
    return b;
}
__device__ __forceinline__ void xcd_barrier_complete(unsigned* bar, unsigned x, unsigned& nloc, unsigned& nx) {
    const unsigned G = gridDim.x * gridDim.y * gridDim.z;
    unsigned sum, cnt, mine, sp = 0u;
    for (;;) {
        sum = 0u; cnt = 0u; mine = 0u;
#pragma unroll
        for (unsigned j = 0; j < 16; ++j) { const unsigned c = xb_ld(&bar[XB_XCNT(j)]); sum += c; cnt += (c > 0u) ? 1u : 0u; mine = (j == x) ? c : mine; }
        if (sum == G) break;
        __builtin_amdgcn_s_sleep(1);
        if ((++sp & 255u) == 0u) { if (xb_ld(&bar[XB_TMO])) break; if (sp > XB_SPIN_CAP) { atomicAdd(&bar[XB_TMO], 1u); break; } }
    }
    nloc = mine > 0u ? mine : 1u; nx = cnt > 0u ? cnt : 1u;
}
__device__ __forceinline__ void xcd_barrier(const XcdBarrier& b) {
    asm volatile("s_waitcnt vmcnt(0)" ::: "memory");
    __syncthreads();
    if (threadIdx.x == 0) {
        unsigned* bar = b.bar;
        __builtin_amdgcn_s_waitcnt(0);
        unsigned nloc = b.st[0], nx = b.st[1];
        if (nloc == 0u) { xcd_barrier_complete(bar, b.x, nloc, nx); b.st[0] = nloc; b.st[1] = nx; }
        const unsigned old = xb_add(&bar[XB_XSUB(b.x)], 1u);
        const unsigned gen = old / nloc;
        if (old + 1u == (gen + 1u) * nloc) {
            __builtin_amdgcn_fence(__ATOMIC_RELEASE, "agent");
            asm volatile("s_waitcnt vmcnt(0)" ::: "memory");
            const unsigned og = xb_add(&bar[XB_TOP], 1u);
            const unsigned tg = og / nx;
            if (og + 1u == (tg + 1u) * nx) xb_add(&bar[XB_TOPGEN], 1u);
            else XB_SPIN(xb_ld(&bar[XB_TOPGEN]) == tg, bar);
            __builtin_amdgcn_fence(__ATOMIC_ACQUIRE, "agent");
            xb_add(&bar[XB_XGEN(b.x)], 1u);
            asm volatile("s_waitcnt vmcnt(0)" ::: "memory");
        } else {
            XB_SPIN(xb_ld(&bar[XB_XGEN(b.x)]) == gen, bar);
            __builtin_amdgcn_fence(__ATOMIC_ACQUIRE, "agent");
            asm volatile("s_waitcnt vmcnt(0)" ::: "memory");
        }
    }
    __syncthreads();
}

enum { I_X = 0, I_MEM, I_F1N, I_F1G, I_F1U, I_F1D, I_MIXN, I_MEMN, I_WIN, I_GUP, I_GB, I_GON, I_LNG, I_LNB, I_WS, I_BS, I_WKV, I_WBR, I_WOUT, I_F2N, I_F2G, I_F2U, I_F2D, I_FN, N_IN };
struct Args { const float* in[N_IN]; float* out; unsigned char* ws; int ph_lo, ph_hi; };
constexpr int N_PHASES = 20;

struct ConvCtx { const float* const* in; bf16 *WGU1, *WGU2, *WD1, *WD2, *WIN, *WKV, *WBR, *WO; };
struct ConvItem { const float* src; const float* gain; bf16* dst; int ldw, k0, src_col0, ldk, dst_row0; };
constexpr int CI_GU = 4 * 176, CI_DN = 11 * 32, CI_IN = 4 * 192, CI_KV = 4 * 32, CI_BR = 3 * 2 * 32, CI_WO = 4 * 32;
constexpr int CONV_EARLY = CI_GU + CI_KV;
constexpr int CONV_LATE = CI_DN + CI_IN + CI_BR + CI_WO + CI_GU + CI_DN;
constexpr int CONV_EPI = 1400;
__device__ __forceinline__ void conv_gu(const ConvCtx& c, int r, int second, int wave, ConvItem& o) {
    const int kb = (r / 176) * 8 + wave, nb = r % 176, tile = nb >> 2, w4 = nb & 3;
    o.src = c.in[second ? (w4 < 2 ? I_F2G : I_F2U) : (w4 < 2 ? I_F1G : I_F1U)]; o.gain = c.in[second ? I_F2N : I_F1N]; o.dst = second ? c.WGU2 : c.WGU1;
    o.ldw = DFF; o.k0 = 64 * kb; o.src_col0 = 128 * tile + 64 * (w4 & 1); o.ldk = D; o.dst_row0 = 64 * nb;
}
__device__ __forceinline__ void conv_plain(const float* src, bf16* dst, int r, int nbs, int ldw, int ldk, int wave, ConvItem& o) {
    const int kb = (r / nbs) * 8 + wave, nb = r % nbs; o.src = src; o.gain = nullptr; o.dst = dst; o.ldw = ldw; o.k0 = 64 * kb; o.src_col0 = 64 * nb; o.ldk = ldk; o.dst_row0 = 64 * nb;
}
__device__ __forceinline__ void conv_early(const ConvCtx& c, int r, int wave, ConvItem& o) {
    if (r < CI_GU) { conv_gu(c, r, 0, wave, o); return; }
    conv_plain(c.in[I_WKV], c.WKV, r - CI_GU, 32, D, D, wave, o);
}
__device__ __forceinline__ void conv_late(const ConvCtx& c, int r, int wave, ConvItem& o) {
    if (r < CI_DN) { conv_plain(c.in[I_F1D], c.WD1, r, 32, D, DFF, wave, o); return; } r -= CI_DN;
    if (r < CI_IN) { const int kb = (r / 192) * 8 + wave, nb = r % 192; o.src = c.in[I_WIN]; o.gain = c.in[I_MIXN]; o.dst = c.WIN; o.ldw = INW; o.k0 = 64 * kb; o.src_col0 = 64 * nb + (64 * nb >= 3072 ? 16 : 0); o.ldk = D; o.dst_row0 = 64 * nb; return; } r -= CI_IN;
    if (r < CI_BR) { const int i = r / 64; conv_plain(c.in[I_WBR] + (size_t)i * 1024 * D, c.WBR + (size_t)i * D * 1024, r % 64, 32, D, 1024, wave, o); return; } r -= CI_BR;
    if (r < CI_WO) { conv_plain(c.in[I_WOUT], c.WO, r, 32, D, D, wave, o); return; } r -= CI_WO;
    if (r < CI_GU) { conv_gu(c, r, 1, wave, o); return; } r -= CI_GU;
    conv_plain(c.in[I_F2D], c.WD2, r, 32, D, DFF, wave, o);
}
__device__ __forceinline__ void conv_issue(const ConvItem& it, f32x4 (&v)[16], int lane) {
    const float* p = it.src + (size_t)(it.k0 + 16 * (lane >> 4)) * it.ldw + it.src_col0 + (lane & 15) * 4;
#pragma unroll
    for (int i = 0; i < 16; ++i) v[i] = __builtin_nontemporal_load((const GAS f32x4*)(p + (size_t)i * it.ldw));
}
__device__ __forceinline__ void conv_finish(const ConvItem& it, f32x4 (&v)[16], int lane) {
    const int q = lane >> 4, c4 = (lane & 15) * 4;
    if (it.gain) {
#pragma unroll
        for (int i4 = 0; i4 < 4; ++i4) { const f32x4 g = *(const f32x4*)(it.gain + it.k0 + 16 * q + 4 * i4);
            v[4 * i4] *= g.x; v[4 * i4 + 1] *= g.y; v[4 * i4 + 2] *= g.z; v[4 * i4 + 3] *= g.w; }
    }
#pragma unroll
    for (int j = 0; j < 4; ++j) {
        bf16* o = it.dst + (size_t)(it.dst_row0 + c4 + j) * it.ldk + it.k0 + 16 * q;
        v4u w0, w1;
        w0.x = cvtpk(v[0][j], v[1][j]); w0.y = cvtpk(v[2][j], v[3][j]); w0.z = cvtpk(v[4][j], v[5][j]); w0.w = cvtpk(v[6][j], v[7][j]);
        w1.x = cvtpk(v[8][j], v[9][j]); w1.y = cvtpk(v[10][j], v[11][j]); w1.z = cvtpk(v[12][j], v[13][j]); w1.w = cvtpk(v[14][j], v[15][j]);
        *(GAS v4u*)o = w0; *(GAS v4u*)(o + 8) = w1;
    }
}

using pg8::Unit;
struct EpiGU {
    bf16* act; const float* ss; bf16* Kb; bf16* VT; const ConvCtx* cv; int cvbase, cvstride;
    __device__ __forceinline__ void operator()(const f32x4 (&acc)[2][2][4][2], const Unit& u, int wr, int wc, int fr, int fq) const {
        f32x4 cvv[16]; ConvItem cit; const int cvi = u.seq * (cvstride >> 1) + (cvbase >> 1); const bool docv = cv && u.seq < 11 && ((cvbase + u.seq) & 1) == 0 && cvi < CONV_EPI;
        if (docv) { conv_late(*cv, cvi, wr * 4 + wc, cit); conv_issue(cit, cvv, fq * 16 + fr); }
        epi(acc, u, wr, wc, fr, fq);
        if (docv) conv_finish(cit, cvv, fq * 16 + fr);
    }
    __device__ __forceinline__ void epi(const f32x4 (&acc)[2][2][4][2], const Unit& u, int wr, int wc, int fr, int fq) const {
        if (u.kind == 0) {
            const int row0 = u.pm * 256 + wr * 64 + fr, col0 = u.pn * 128 + wc * 32 + 8 * fq;
            const float* sp = ss + u.pm * 256 + wr * 64 + fq * 16 + fr; const float run0 = ss ? sp[0] : 0.f, run1 = ss ? sp[128] : 0.f;
#pragma unroll
            for (int ai = 0; ai < 2; ++ai)
#pragma unroll
                for (int m = 0; m < 4; ++m) {
                    const int r = row0 + ai * 128 + m * 16;
                    const float s = ss ? __builtin_amdgcn_rsqf(__shfl(ai ? run1 : run0, m * 16 + fr) * (1.0f / D) + EPS) : 1.0f;
                    const float c1 = -1.4426950408889634f * s, s2 = s * s;
                    f32x2 o[4];
#pragma unroll
                    for (int n = 0; n < 2; ++n)
#pragma unroll
                        for (int jp = 0; jp < 2; ++jp) { const f32x2 g = {acc[ai][0][m][n][2 * jp], acc[ai][0][m][n][2 * jp + 1]}, uu = {acc[ai][1][m][n][2 * jp], acc[ai][1][m][n][2 * jp + 1]};
                            o[n * 2 + jp] = (g * uu) * (pg8::rcp1pexp2_pk(g * c1) * s2); }
                    v4u w; w.x = cvtpk(o[0].x, o[0].y); w.y = cvtpk(o[1].x, o[1].y); w.z = cvtpk(o[2].x, o[2].y); w.w = cvtpk(o[3].x, o[3].y);
                    *(v4u*)(act + (size_t)r * DFF + col0) = w;
                }
        } else {
            bf16* base = u.kind == 1 ? Kb : VT; const int ldc = u.kind == 1 ? 1024 : 2048;
            const int row0 = u.pm * 256 + wr * 64 + fr, col0 = u.pn * 256 + wc * 32 + 8 * fq;
#pragma unroll
            for (int ai = 0; ai < 2; ++ai)
#pragma unroll
                for (int m = 0; m < 4; ++m) {
                    bf16* rowp = base + (size_t)(row0 + ai * 128 + m * 16) * ldc + col0;
#pragma unroll
                    for (int bj = 0; bj < 2; ++bj) { const f32x4 v0 = acc[ai][bj][m][0], v1 = acc[ai][bj][m][1];
                        v4u w; w.x = cvtpk(v0[0], v0[1]); w.y = cvtpk(v0[2], v0[3]); w.z = cvtpk(v1[0], v1[1]); w.w = cvtpk(v1[2], v1[3]);
                        *(v4u*)(rowp + bj * 128) = w; }
                }
        }
    }
};
struct EpiRes {
    bf16* xb; float* ss; float alpha;
    __device__ __forceinline__ void operator()(const f32x4 (&acc)[2][2][4][2], const Unit& u, int wr, int wc, int fr, int fq) const {
        const int row0 = u.pm * 256 + wr * 64 + fr, col0 = u.pn * 256 + wc * 32 + 8 * fq;
#pragma unroll
        for (int ai = 0; ai < 2; ++ai) {
            v4u old[4][2];
#pragma unroll
            for (int m = 0; m < 4; ++m)
#pragma unroll
                for (int bj = 0; bj < 2; ++bj) old[m][bj] = *(const v4u*)(xb + (size_t)(row0 + ai * 128 + m * 16) * D + col0 + bj * 128);
#pragma unroll
            for (int m = 0; m < 4; ++m) {
                const int r = row0 + ai * 128 + m * 16; const size_t off = (size_t)r * D + col0; float sq = 0.f;
#pragma unroll
                for (int bj = 0; bj < 2; ++bj) {
                    const v4u o = old[m][bj]; const f32x4 a0 = acc[ai][bj][m][0], a1 = acc[ai][bj][m][1];
                    float v[8];
                    v[0] = bflo(o.x) + alpha * a0[0]; v[1] = bfhi(o.x) + alpha * a0[1]; v[2] = bflo(o.y) + alpha * a0[2]; v[3] = bfhi(o.y) + alpha * a0[3];
                    v[4] = bflo(o.z) + alpha * a1[0]; v[5] = bfhi(o.z) + alpha * a1[1]; v[6] = bflo(o.w) + alpha * a1[2]; v[7] = bfhi(o.w) + alpha * a1[3];
                    v4u w; w.x = cvtpk(v[0], v[1]); w.y = cvtpk(v[2], v[3]); w.z = cvtpk(v[4], v[5]); w.w = cvtpk(v[6], v[7]);
                    *(v4u*)(xb + off + bj * 128) = w;
                    sq += (v[0] * v[0] + v[1] * v[1]) + (v[2] * v[2] + v[3] * v[3]) + (v[4] * v[4] + v[5] * v[5]) + (v[6] * v[6] + v[7] * v[7]);
                }
                if (ss) { sq += __shfl_xor(sq, 16); sq += __shfl_xor(sq, 32); if (fq == 0) atomicAdd(ss + r, sq); }
            }
            asm volatile("" ::: "memory");
        }
    }
};
struct EpiProj {
    const float* ss; bf16* q; bf16* k; bf16* v; bf16* r; bf16* su; bf16* sv; bf16* xq; bf16* g0;
    __device__ __forceinline__ void operator()(const f32x4 (&acc)[2][2][4][2], const Unit& u, int wr, int wc, int fr, int fq) const {
        bf16* base; int ldc, ct; bool act = false; const int pn = u.pn;
        if (pn < 2) { base = q; ldc = 512; ct = pn; } else if (pn < 4) { base = k; ldc = 512; ct = pn - 2; } else if (pn < 8) { base = v; ldc = 1024; ct = pn - 4; }
        else if (pn < 12) { base = r; ldc = 1024; ct = pn - 8; } else if (pn < 16) { base = su; ldc = 1024; ct = pn - 12; act = true; }
        else if (pn < 20) { base = sv; ldc = 1024; ct = pn - 16; act = true; } else if (pn < 24) { base = xq; ldc = 1024; ct = pn - 20; } else { base = g0; ldc = D; ct = pn - 24; }
        const bool gate = pn >= 24;
        const int row0 = u.pm * 256 + wr * 64 + fr, col0 = ct * 256 + wc * 32 + 8 * fq;
        const float* sp = ss + u.pm * 256 + wr * 64 + fq * 16 + fr; const float run0 = sp[0], run1 = sp[128];
#pragma unroll
        for (int ai = 0; ai < 2; ++ai)
#pragma unroll
            for (int m = 0; m < 4; ++m) {
                const int rr = row0 + ai * 128 + m * 16;
                const float s = __builtin_amdgcn_rsqf(__shfl(ai ? run1 : run0, m * 16 + fr) * (1.0f / D) + EPS);
                bf16* rowp = base + (size_t)rr * ldc + col0;
#pragma unroll
                for (int bj = 0; bj < 2; ++bj) { f32x4 v0 = acc[ai][bj][m][0] * s, v1 = acc[ai][bj][m][1] * s;
                    if (act) { const f32x2 a = pg8::gelu_pk((f32x2){v0[0], v0[1]}), b = pg8::gelu_pk((f32x2){v0[2], v0[3]}), c = pg8::gelu_pk((f32x2){v1[0], v1[1]}), d = pg8::gelu_pk((f32x2){v1[2], v1[3]});
                        v0 = (f32x4){a.x, a.y, b.x, b.y}; v1 = (f32x4){c.x, c.y, d.x, d.y}; }
                    if (gate) { const float c1 = -1.4426950408889634f; const f32x2 a = pg8::rcp1pexp2_pk((f32x2){v0[0], v0[1]} * c1), b = pg8::rcp1pexp2_pk((f32x2){v0[2], v0[3]} * c1), c = pg8::rcp1pexp2_pk((f32x2){v1[0], v1[1]} * c1), d = pg8::rcp1pexp2_pk((f32x2){v1[2], v1[3]} * c1);
                        v0 = (f32x4){a.x, a.y, b.x, b.y}; v1 = (f32x4){c.x, c.y, d.x, d.y}; }
                    v4u w; w.x = cvtpk(v0[0], v0[1]); w.y = cvtpk(v0[2], v0[3]); w.z = cvtpk(v1[0], v1[1]); w.w = cvtpk(v1[2], v1[3]);
                    *(v4u*)(rowp + bj * 128) = w; }
            }
    }
};
struct EpiGate {
    const float* ss; bf16* g;
    __device__ __forceinline__ void operator()(const f32x4 (&acc)[2][2][4][2], const Unit& u, int wr, int wc, int fr, int fq) const {
        const int row0 = u.pm * 256 + wr * 64 + fr, col0 = u.pn * 256 + wc * 32 + 8 * fq;
        const float* sp = ss + u.pm * 256 + wr * 64 + fq * 16 + fr; const float run0 = sp[0], run1 = sp[128];
#pragma unroll
        for (int ai = 0; ai < 2; ++ai)
#pragma unroll
            for (int m = 0; m < 4; ++m) {
                const int rr = row0 + ai * 128 + m * 16;
                const float s = __builtin_amdgcn_rsqf(__shfl(ai ? run1 : run0, m * 16 + fr) * (1.0f / D) + EPS);
                bf16* rowp = g + (size_t)rr * D + col0;
                const float c1 = -1.4426950408889634f * s;
#pragma unroll
                for (int bj = 0; bj < 2; ++bj) { const f32x4 a0 = acc[ai][bj][m][0], a1 = acc[ai][bj][m][1];
                    const f32x2 p = pg8::rcp1pexp2_pk((f32x2){a0[0], a0[1]} * c1), q = pg8::rcp1pexp2_pk((f32x2){a0[2], a0[3]} * c1), rr2 = pg8::rcp1pexp2_pk((f32x2){a1[0], a1[1]} * c1), t2 = pg8::rcp1pexp2_pk((f32x2){a1[2], a1[3]} * c1);
                    const f32x4 v0 = (f32x4){p.x, p.y, q.x, q.y}, v1 = (f32x4){rr2.x, rr2.y, t2.x, t2.y};
                    v4u w; w.x = cvtpk(v0[0], v0[1]); w.y = cvtpk(v0[2], v0[3]); w.z = cvtpk(v1[0], v1[1]); w.w = cvtpk(v1[2], v1[3]);
                    *(v4u*)(rowp + bj * 128) = w; }
            }
    }
};
struct EpiMerge {
    const bf16* g; bf16* mrg; int first;
    __device__ __forceinline__ void operator()(const f32x4 (&acc)[2][2][4][2], const Unit& u, int wr, int wc, int fr, int fq) const {
        const int row0 = u.pm * 256 + wr * 64 + fr, col0 = u.pn * 256 + wc * 32 + 8 * fq;
#pragma unroll
        for (int ai = 0; ai < 2; ++ai) {
            v4u gws[4][2], ows[4][2];
#pragma unroll
            for (int m = 0; m < 4; ++m)
#pragma unroll
                for (int bj = 0; bj < 2; ++bj) { const size_t off = (size_t)(row0 + ai * 128 + m * 16) * D + col0 + bj * 128;
                    gws[m][bj] = *(const v4u*)(g + off); ows[m][bj] = first ? (v4u){0u, 0u, 0u, 0u} : *(const v4u*)(mrg + off); }
#pragma unroll
            for (int m = 0; m < 4; ++m)
#pragma unroll
                for (int bj = 0; bj < 2; ++bj) {
                    const size_t off = (size_t)(row0 + ai * 128 + m * 16) * D + col0 + bj * 128;
                    const v4u gw = gws[m][bj], ow = ows[m][bj]; const f32x4 a0 = acc[ai][bj][m][0], a1 = acc[ai][bj][m][1];
                    float o[8];
                    o[0] = bflo(ow.x) + bflo(gw.x) * a0[0]; o[1] = bfhi(ow.x) + bfhi(gw.x) * a0[1]; o[2] = bflo(ow.y) + bflo(gw.y) * a0[2]; o[3] = bfhi(ow.y) + bfhi(gw.y) * a0[3];
                    o[4] = bflo(ow.z) + bflo(gw.z) * a1[0]; o[5] = bfhi(ow.z) + bfhi(gw.z) * a1[1]; o[6] = bflo(ow.w) + bflo(gw.w) * a1[2]; o[7] = bfhi(ow.w) + bfhi(gw.w) * a1[3];
                    v4u w; w.x = cvtpk(o[0], o[1]); w.y = cvtpk(o[2], o[3]); w.z = cvtpk(o[4], o[5]); w.w = cvtpk(o[6], o[7]);
                    *(v4u*)(mrg + off) = w;
                }
            asm volatile("" ::: "memory");
        }
    }
};

struct GridSched {
    const char* A; const char* B; size_t tA, tB; int nM, nN, G, c;
    __device__ __forceinline__ bool next(int i, Unit& u) const {
        const int L = i * G + c; if (L >= nM * nN) return false;
        pg8::tile_of(L, nM, nN, u.pm, u.pn); u.A = A + (size_t)u.pm * tA; u.B = B + (size_t)u.pn * tB; u.kind = 0; u.seq = i; return true;
    }
};
struct P1Sched {
    const char* h1b; const char* wgu; const char* memb; const char* wkv; int G, c;
    __device__ __forceinline__ bool next(int i, Unit& u) const {
        const int L = i * G + c; constexpr int NF = 64 * 44; const size_t T = (size_t)256 * D * 2; u.seq = i;
        if (L < NF) { pg8::tile_of(L, 64, 44, u.pm, u.pn); u.A = h1b + (size_t)u.pm * T; u.B = wgu + (size_t)u.pn * T; u.kind = 0; return true; }
        const int id = L - NF; if (id >= 64) return false;
        if (id < 32) { u.pm = id >> 2; u.pn = id & 3; u.A = memb + (size_t)u.pm * T; u.B = wkv + (size_t)u.pn * T; u.kind = 1; }
        else { const int j = id - 32; u.pm = j >> 3; u.pn = j & 7; u.A = wkv + (size_t)(4 + u.pm) * T; u.B = memb + (size_t)u.pn * T; u.kind = 2; }
        return true;
    }
};

__device__ __forceinline__ void transpose64(const float* W, int ldw, int k0, int src_col0, bf16* WT, int ldk, int dst_row0, const float* gain, LAS unsigned* T, int lane) {
    const int q = lane >> 4, c4 = (lane & 15) * 4;
    const float* p = W + (size_t)(k0 + 16 * q) * ldw + src_col0 + c4;
    f32x4 v[16];
#pragma unroll
    for (int i = 0; i < 16; ++i) v[i] = __builtin_nontemporal_load((const GAS f32x4*)(p + (size_t)i * ldw));
    if (gain) {
#pragma unroll
        for (int i4 = 0; i4 < 4; ++i4) { const f32x4 g = *(const f32x4*)(gain + k0 + 16 * q + 4 * i4);
            v[4 * i4] *= g.x; v[4 * i4 + 1] *= g.y; v[4 * i4 + 2] *= g.z; v[4 * i4 + 3] *= g.w; }
    }
#pragma unroll
    for (int j = 0; j < 4; ++j) {
        v4u w0, w1;
        w0.x = cvtpk(v[0][j], v[1][j]); w0.y = cvtpk(v[2][j], v[3][j]); w0.z = cvtpk(v[4][j], v[5][j]); w0.w = cvtpk(v[6][j], v[7][j]);
        w1.x = cvtpk(v[8][j], v[9][j]); w1.y = cvtpk(v[10][j], v[11][j]); w1.z = cvtpk(v[12][j], v[13][j]); w1.w = cvtpk(v[14][j], v[15][j]);
        LAS v4u* t = (LAS v4u*)(T + (c4 + j) * 36 + 8 * q); t[0] = w0; t[1] = w1;
    }
    LDS_WAIT(); asm volatile("" ::: "memory");
#pragma unroll
    for (int r = 0; r < 8; ++r) { const int n = 8 * r + (lane >> 3), ch = lane & 7;
        const v4u w = *(const LAS v4u*)(T + n * 36 + 4 * ch);
        *(GAS v4u*)(WT + (size_t)(dst_row0 + n) * ldk + k0 + 8 * ch) = w; }
    LDS_WAIT(); asm volatile("" ::: "memory");
}
__device__ __forceinline__ void row_to_bf16_ss(const float* xrow, bf16* orow, float* ssp, int lane) {
    const GAS f32x4* xr = (const GAS f32x4*)xrow + lane;
    f32x4 v[8]; float s = 0.f;
#pragma unroll
    for (int j = 0; j < 8; ++j) { v[j] = xr[64 * j]; s += (v[j].x * v[j].x + v[j].y * v[j].y) + (v[j].z * v[j].z + v[j].w * v[j].w); }
    s = wave_sum(s); if (lane == 0) *ssp = s;
    GAS v2u* o8 = (GAS v2u*)orow + lane;
#pragma unroll
    for (int j = 0; j < 8; ++j) { v2u w; w.x = cvtpk(v[j].x, v[j].y); w.y = cvtpk(v[j].z, v[j].w); o8[64 * j] = w; }
}
__device__ __forceinline__ void rms_row_to_bf16(const float* xrow, const float* gain, bf16* orow, int lane) {
    const GAS f32x4* xr = (const GAS f32x4*)xrow + lane; const GAS f32x4* gr = (const GAS f32x4*)gain + lane;
    f32x4 v[8]; float s = 0.f;
#pragma unroll
    for (int j = 0; j < 8; ++j) { v[j] = xr[64 * j]; s += (v[j].x * v[j].x + v[j].y * v[j].y) + (v[j].z * v[j].z + v[j].w * v[j].w); }
    const float rs = 1.0f / sqrtf(wave_sum(s) * (1.0f / D) + EPS);
    GAS v2u* o8 = (GAS v2u*)orow + lane;
#pragma unroll
    for (int j = 0; j < 8; ++j) { const f32x4 g = gr[64 * j]; v2u w; w.x = cvtpk(v[j].x * rs * g.x, v[j].y * rs * g.y); w.y = cvtpk(v[j].z * rs * g.z, v[j].w * rs * g.w); o8[64 * j] = w; }
}

__device__ __forceinline__ int tau32(int r) { return (r & ~12) | ((r & 4) << 1) | ((r & 8) >> 1); }
#define MFMA32(a, b, c) __builtin_amdgcn_mfma_f32_32x32x16_bf16((a), (b), (c), 0, 0, 0)
__device__ __forceinline__ bf16x8 pack8(const f32x16& x, int s) {
    v4u p; p.x = cvtpk(x[8 * s], x[8 * s + 1]); p.y = cvtpk(x[8 * s + 2], x[8 * s + 3]); p.z = cvtpk(x[8 * s + 4], x[8 * s + 5]); p.w = cvtpk(x[8 * s + 6], x[8 * s + 7]);
    return __builtin_bit_cast(bf16x8, p);
}
__device__ __forceinline__ f32x16 zero16() { f32x16 z;
#pragma unroll
    for (int i = 0; i < 16; ++i) z[i] = 0.f; return z; }

constexpr float GLA_SCALE = 0.08838834764831845f;
constexpr int VT_P = 72, KL_P = 72, QS_P = 136;

__device__ __forceinline__ void load_vT(const bf16* V, int tok0, int h, LAS bf16* VT, int wave, int lane) {
    const bf16* src = V + (size_t)(tok0 + lane) * 1024 + h * 256 + 32 * wave;
#pragma unroll
    for (int p = 0; p < 4; ++p) { const v4u raw = *(const v4u*)(src + 8 * p); const int c0 = 32 * wave + 8 * p;
        VT[(c0 + 0) * VT_P + lane] = (bf16)(raw.x & 0xffff); VT[(c0 + 1) * VT_P + lane] = (bf16)(raw.x >> 16);
        VT[(c0 + 2) * VT_P + lane] = (bf16)(raw.y & 0xffff); VT[(c0 + 3) * VT_P + lane] = (bf16)(raw.y >> 16);
        VT[(c0 + 4) * VT_P + lane] = (bf16)(raw.z & 0xffff); VT[(c0 + 5) * VT_P + lane] = (bf16)(raw.z >> 16);
        VT[(c0 + 6) * VT_P + lane] = (bf16)(raw.w & 0xffff); VT[(c0 + 7) * VT_P + lane] = (bf16)(raw.w >> 16); }
}

__device__ __forceinline__ void gla_step1(LAS unsigned char* lds, int unit, bf16* Q, bf16* Kt, const bf16* V, const float* GLR, const float* wup, const float* gbias, float* ADEC, bf16* US, int wave, int lane) {
    const int b = unit >> 7, h = (unit >> 5) & 3, n = unit & 31, tok0 = b * SEQ + n * 64, tid = wave * 64 + lane;
    LAS float* WUP = (LAS float*)lds;
    LAS float* BIAS = (LAS float*)(lds + 8192);
    LAS bf16* KLT = (LAS bf16*)(lds + 9216);
    LAS bf16* VTl = (LAS bf16*)(lds + 9216 + 128 * KL_P * 2);
    for (int i = tid; i < 16 * 128; i += NTHREADS) WUP[i] = wup[(i >> 7) * 512 + h * 128 + (i & 127)];
    if (tid < 128) BIAS[tid] = gbias[h * 128 + tid];
    load_vT(V, tok0, h, VTl, wave, lane);
    const int token = tok0 + lane;
    float gl[16];
    { const f32x4* gp = (const f32x4*)(GLR + (size_t)token * 16);
#pragma unroll
      for (int i = 0; i < 4; ++i) { const f32x4 t = gp[i]; gl[4 * i] = t.x; gl[4 * i + 1] = t.y; gl[4 * i + 2] = t.z; gl[4 * i + 3] = t.w; } }
    __syncthreads();
    float la[16];
#pragma unroll
    for (int j = 0; j < 16; ++j) {
        float z = BIAS[16 * wave + j];
#pragma unroll
        for (int r = 0; r < 16; ++r) z += gl[r] * WUP[r * 128 + 16 * wave + j];
        const float ls = fminf(z, 0.f) - __logf(1.0f + __expf(-fabsf(z)));
        float v = ls * (1.0f / 16.0f);
#pragma unroll
        for (int o = 1; o < 64; o <<= 1) { const float t = __shfl_up(v, o); if (lane >= o) v += t; }
        la[j] = v;
    }
    unsigned qraw[8], kraw[8];
    { const v4u* qp = (const v4u*)(Q + (size_t)token * 512 + h * 128 + 16 * wave); const v4u* kp = (const v4u*)(Kt + (size_t)token * 512 + h * 128 + 16 * wave);
      const v4u q0 = qp[0], q1 = qp[1], k0 = kp[0], k1 = kp[1];
      qraw[0] = q0.x; qraw[1] = q0.y; qraw[2] = q0.z; qraw[3] = q0.w; qraw[4] = q1.x; qraw[5] = q1.y; qraw[6] = q1.z; qraw[7] = q1.w;
      kraw[0] = k0.x; kraw[1] = k0.y; kraw[2] = k0.z; kraw[3] = k0.w; kraw[4] = k1.x; kraw[5] = k1.y; kraw[6] = k1.z; kraw[7] = k1.w; }
    unsigned qo[8], ko[8];
#pragma unroll
    for (int jj = 0; jj < 8; ++jj) {
        float qs2[2], ks2[2];
#pragma unroll
        for (int e = 0; e < 2; ++e) { const int j = 2 * jj + e;
            const float bb = la[j], bl = __shfl(bb, 63), a = __expf(bl), e1 = __expf(bb), e2 = __expf(-bb);
            const float qv = e ? bfhi(qraw[jj]) : bflo(qraw[jj]), kv = e ? bfhi(kraw[jj]) : bflo(kraw[jj]);
            qs2[e] = qv * (GLA_SCALE * e1); ks2[e] = kv * e2;
            KLT[(16 * wave + j) * KL_P + lane] = f2bf(kv * (e2 * a));
            if (lane == 63) ADEC[(size_t)unit * 128 + 16 * wave + j] = a; }
        qo[jj] = cvtpk(qs2[0], qs2[1]); ko[jj] = cvtpk(ks2[0], ks2[1]);
    }
    { v4u* qp = (v4u*)(Q + (size_t)token * 512 + h * 128 + 16 * wave); v4u* kp = (v4u*)(Kt + (size_t)token * 512 + h * 128 + 16 * wave);
      qp[0] = (v4u){qo[0], qo[1], qo[2], qo[3]}; qp[1] = (v4u){qo[4], qo[5], qo[6], qo[7]};
      kp[0] = (v4u){ko[0], ko[1], ko[2], ko[3]}; kp[1] = (v4u){ko[4], ko[5], ko[6], ko[7]}; }
    __syncthreads();
    const int r32 = lane & 31, hh = lane >> 5;
    f32x16 acc[4];
#pragma unroll
    for (int dt = 0; dt < 4; ++dt) acc[dt] = zero16();
#pragma unroll
    for (int kk = 0; kk < 4; ++kk) {
        const bf16x8 Bf = *(const LAS bf16x8*)(VTl + (32 * wave + r32) * VT_P + 16 * kk + 8 * hh);
#pragma unroll
        for (int dt = 0; dt < 4; ++dt) { const bf16x8 Af = *(const LAS bf16x8*)(KLT + (32 * dt + r32) * KL_P + 16 * kk + 8 * hh); acc[dt] = MFMA32(Af, Bf, acc[dt]); }
    }
    bf16* up = US + ((size_t)unit * 256 + 32 * wave + r32) * 128;
#pragma unroll
    for (int dt = 0; dt < 4; ++dt)
#pragma unroll
        for (int g4 = 0; g4 < 4; ++g4) { v2u w; w.x = cvtpk(acc[dt][4 * g4], acc[dt][4 * g4 + 1]); w.y = cvtpk(acc[dt][4 * g4 + 2], acc[dt][4 * g4 + 3]);
            *(v2u*)(up + 32 * dt + 8 * g4 + 4 * hh) = w; }
    __syncthreads();
}

__device__ __forceinline__ void gla_scan(bf16* US, const float* ADEC, int gid) {
    const int bh = gid >> 12, e = gid & 4095, dv = e >> 4, dk0 = (e & 15) * 8;
    float S[8];
#pragma unroll
    for (int i = 0; i < 8; ++i) S[i] = 0.f;
#pragma unroll 4
    for (int n = 0; n < 32; ++n) {
        const int unit = bh * 32 + n;
        v4u* p = (v4u*)(US + ((size_t)unit * 256 + dv) * 128 + dk0);
        const v4u uu = *p; const f32x4 a0 = *(const f32x4*)(ADEC + (size_t)unit * 128 + dk0), a1 = *(const f32x4*)(ADEC + (size_t)unit * 128 + dk0 + 4);
        v4u w; w.x = cvtpk(S[0], S[1]); w.y = cvtpk(S[2], S[3]); w.z = cvtpk(S[4], S[5]); w.w = cvtpk(S[6], S[7]);
        *p = w;
        S[0] = a0.x * S[0] + bflo(uu.x); S[1] = a0.y * S[1] + bfhi(uu.x); S[2] = a0.z * S[2] + bflo(uu.y); S[3] = a0.w * S[3] + bfhi(uu.y);
        S[4] = a1.x * S[4] + bflo(uu.z); S[5] = a1.y * S[5] + bfhi(uu.z); S[6] = a1.z * S[6] + bflo(uu.w); S[7] = a1.w * S[7] + bfhi(uu.w);
    }
}

__device__ __forceinline__ void gla_step3(LAS unsigned char* lds, int unit, const bf16* Q, const bf16* Kt, bf16* V, const bf16* R, const bf16* US, const float* onorm, int wave, int lane) {
    const int b = unit >> 7, h = (unit >> 5) & 3, n = unit & 31, tok0 = b * SEQ + n * 64, tid = wave * 64 + lane;
    LAS bf16* QS = (LAS bf16*)lds;
    LAS bf16* KS = (LAS bf16*)(lds + 64 * QS_P * 2);
    LAS bf16* VTl = (LAS bf16*)(lds + 2 * 64 * QS_P * 2);
    LAS float* RED = (LAS float*)(lds + 2 * 64 * QS_P * 2 + 256 * VT_P * 2);
#pragma unroll
    for (int i = 0; i < 2; ++i) { const int pc = tid + i * NTHREADS, row = pc >> 4, c8 = (pc & 15) * 8;
        *(LAS v4u*)(QS + row * QS_P + c8) = *(const v4u*)(Q + (size_t)(tok0 + row) * 512 + h * 128 + c8);
        *(LAS v4u*)(KS + row * QS_P + c8) = *(const v4u*)(Kt + (size_t)(tok0 + row) * 512 + h * 128 + c8); }
    load_vT(V, tok0, h, VTl, wave, lane);
    __syncthreads();
    const int r32 = lane & 31, hh = lane >> 5;
    f32x16 sc0 = zero16(), sc1 = zero16(), sc2 = zero16();
#pragma unroll
    for (int kk = 0; kk < 8; ++kk) {
        const bf16x8 A0 = *(const LAS bf16x8*)(KS + tau32(r32) * QS_P + 16 * kk + 8 * hh), A1 = *(const LAS bf16x8*)(KS + (32 + tau32(r32)) * QS_P + 16 * kk + 8 * hh);
        const bf16x8 B0 = *(const LAS bf16x8*)(QS + r32 * QS_P + 16 * kk + 8 * hh), B1 = *(const LAS bf16x8*)(QS + (32 + r32) * QS_P + 16 * kk + 8 * hh);
        sc0 = MFMA32(A0, B0, sc0); sc1 = MFMA32(A0, B1, sc1); sc2 = MFMA32(A1, B1, sc2);
    }
#pragma unroll
    for (int rg = 0; rg < 16; ++rg) { const int s = (rg & 3) + 4 * ((rg >> 2) & 1) + 8 * hh + 16 * (rg >> 3); if (s > r32) { sc0[rg] = 0.f; sc2[rg] = 0.f; } }
    f32x16 o0 = zero16(), o1 = zero16();
    const LAS bf16* vrow = VTl + (32 * wave + r32) * VT_P + 8 * hh;
#pragma unroll
    for (int s = 0; s < 2; ++s) {
        const bf16x8 Av0 = *(const LAS bf16x8*)(vrow + 16 * s), Av1 = *(const LAS bf16x8*)(vrow + 32 + 16 * s);
        o0 = MFMA32(Av0, pack8(sc0, s), o0); o1 = MFMA32(Av0, pack8(sc1, s), o1); o1 = MFMA32(Av1, pack8(sc2, s), o1);
    }
    const bf16* sp = US + ((size_t)unit * 256 + 32 * wave + r32) * 128 + 8 * hh;
#pragma unroll
    for (int kk = 0; kk < 8; ++kk) {
        const bf16x8 As = __builtin_bit_cast(bf16x8, *(const v4u*)(sp + 16 * kk));
        const bf16x8 B0 = *(const LAS bf16x8*)(QS + r32 * QS_P + 16 * kk + 8 * hh), B1 = *(const LAS bf16x8*)(QS + (32 + r32) * QS_P + 16 * kk + 8 * hh);
        o0 = MFMA32(As, B0, o0); o1 = MFMA32(As, B1, o1);
    }
    float q0 = 0.f, q1 = 0.f;
#pragma unroll
    for (int rg = 0; rg < 16; ++rg) { q0 += o0[rg] * o0[rg]; q1 += o1[rg] * o1[rg]; }
    q0 += __shfl_xor(q0, 32); q1 += __shfl_xor(q1, 32);
    if (hh == 0) { RED[wave * 64 + r32] = q0; RED[wave * 64 + 32 + r32] = q1; }
    __syncthreads();
    float t0 = 0.f, t1 = 0.f;
#pragma unroll
    for (int w = 0; w < 8; ++w) { t0 += RED[w * 64 + r32]; t1 += RED[w * 64 + 32 + r32]; }
    const float rs0 = 1.0f / sqrtf(t0 * (1.0f / 256.0f) + EPS), rs1 = 1.0f / sqrtf(t1 * (1.0f / 256.0f) + EPS);
#pragma unroll
    for (int tt = 0; tt < 2; ++tt) {
        const size_t rowoff = (size_t)(tok0 + 32 * tt + r32) * 1024 + h * 256 + 32 * wave + 4 * hh;
        const float rs = tt ? rs1 : rs0;
#pragma unroll
        for (int g4 = 0; g4 < 4; ++g4) {
            const v2u rw = *(const v2u*)(R + rowoff + 8 * g4); const f32x4 gn = *(const f32x4*)(onorm + h * 256 + 32 * wave + 8 * g4 + 4 * hh);
            float y[4];
#pragma unroll
            for (int j = 0; j < 4; ++j) { const float ov = tt ? o1[4 * g4 + j] : o0[4 * g4 + j]; const unsigned rr = j < 2 ? rw.x : rw.y; const float rv = (j & 1) ? bfhi(rr) : bflo(rr);
                y[j] = ov * rs * gn[j] * (rv * sigmoidf_(rv)); }
            v2u w; w.x = cvtpk(y[0], y[1]); w.y = cvtpk(y[2], y[3]); *(v2u*)(V + rowoff + 8 * g4) = w;
        }
    }
    __syncthreads();
}

__device__ __forceinline__ void sg_unit(LAS unsigned char* lds, int unit, bf16* SU, const bf16* SV, const float* lng, const float* lnb, const float* ws, const float* bs, int wave, int lane) {
    const int b = unit >> 6, n = (unit >> 2) & 15, g = unit & 3, tok0 = b * SEQ + n * 128, tid = wave * 64 + lane;
    LAS bf16* VNT = (LAS bf16*)lds;
    LAS bf16* WB = (LAS bf16*)(lds + 256 * QS_P * 2);
    LAS f32x2* RED = (LAS f32x2*)(lds + 256 * QS_P * 2 + 128 * QS_P * 2);
    { const int t = tid >> 2, s0 = (tid & 3) * 32; const float* wp = ws + ((size_t)g * 128 + t) * 128 + s0;
#pragma unroll
      for (int i = 0; i < 4; ++i) { const f32x4 a = *(const f32x4*)(wp + 8 * i), c = *(const f32x4*)(wp + 8 * i + 4); const int s = s0 + 8 * i;
          v4u w; w.x = cvtpk(s + 0 <= t ? a.x : 0.f, s + 1 <= t ? a.y : 0.f); w.y = cvtpk(s + 2 <= t ? a.z : 0.f, s + 3 <= t ? a.w : 0.f);
          w.z = cvtpk(s + 4 <= t ? c.x : 0.f, s + 5 <= t ? c.y : 0.f); w.w = cvtpk(s + 6 <= t ? c.z : 0.f, s + 7 <= t ? c.w : 0.f);
          *(LAS v4u*)(WB + t * QS_P + s) = w; } }
    const int tok = lane + 64 * (wave & 1), cq = wave >> 1;
    unsigned raw[32]; float s1 = 0.f, s2 = 0.f;
    { const v4u* p = (const v4u*)(SV + (size_t)(tok0 + tok) * 1024 + g * 256 + 64 * cq);
#pragma unroll
      for (int i = 0; i < 8; ++i) { const v4u t = p[i]; raw[4 * i] = t.x; raw[4 * i + 1] = t.y; raw[4 * i + 2] = t.z; raw[4 * i + 3] = t.w; } }
#pragma unroll
    for (int i = 0; i < 32; ++i) { const float a = bflo(raw[i]), c = bfhi(raw[i]); s1 += a + c; s2 += a * a + c * c; }
    RED[tok * 4 + cq] = (f32x2){s1, s2};
    __syncthreads();
    { const f32x2 p0 = RED[tok * 4], p1 = RED[tok * 4 + 1], p2 = RED[tok * 4 + 2], p3 = RED[tok * 4 + 3];
      const float mu = ((p0.x + p1.x) + (p2.x + p3.x)) * (1.0f / 256.0f); const float var = fmaxf(((p0.y + p1.y) + (p2.y + p3.y)) * (1.0f / 256.0f) - mu * mu, 0.f);
      const float rstd = 1.0f / sqrtf(var + EPS);
      const float* gp = lng + g * 256 + 64 * cq; const float* bp = lnb + g * 256 + 64 * cq;
#pragma unroll
      for (int i = 0; i < 32; ++i) { const int c = 64 * cq + 2 * i;
          VNT[c * QS_P + tok] = f2bf((bflo(raw[i]) - mu) * rstd * gp[2 * i] + bp[2 * i]);
          VNT[(c + 1) * QS_P + tok] = f2bf((bfhi(raw[i]) - mu) * rstd * gp[2 * i + 1] + bp[2 * i + 1]); } }
    __syncthreads();
    const int r32 = lane & 31, hh = lane >> 5;
    f32x16 acc[4];
#pragma unroll
    for (int j = 0; j < 4; ++j) {
        acc[j] = zero16();
#pragma unroll
        for (int kk = 0; kk < 2 * (j + 1); ++kk) {
            const bf16x8 Af = *(const LAS bf16x8*)(VNT + (32 * wave + r32) * QS_P + 16 * kk + 8 * hh), Bf = *(const LAS bf16x8*)(WB + (32 * j + r32) * QS_P + 16 * kk + 8 * hh);
            acc[j] = MFMA32(Af, Bf, acc[j]);
        }
    }
#pragma unroll
    for (int j = 0; j < 4; ++j) {
        const int t = 32 * j + r32; const float bias = bs[g * 128 + t];
        bf16* up = SU + (size_t)(tok0 + t) * 1024 + g * 256 + 32 * wave + 4 * hh;
#pragma unroll
        for (int g4 = 0; g4 < 4; ++g4) { const v2u uw = *(const v2u*)(up + 8 * g4);
            v2u w; w.x = cvtpk(bflo(uw.x) * (acc[j][4 * g4] + bias), bfhi(uw.x) * (acc[j][4 * g4 + 1] + bias)); w.y = cvtpk(bflo(uw.y) * (acc[j][4 * g4 + 2] + bias), bfhi(uw.y) * (acc[j][4 * g4 + 3] + bias));
            *(v2u*)(up + 8 * g4) = w; }
    }
    __syncthreads();
}

__device__ __forceinline__ void xa_task(int task, bf16* XQ, const bf16* Kb, const bf16* VTg, int lane) {
    const int qblk = task & 63, h = (task >> 6) & 3, b = task >> 8;
    const int r32 = lane & 31, hh = lane >> 5; const size_t token = (size_t)b * SEQ + 32 * qblk + r32;
    bf16x8 qf[16];
    { const bf16* qp = XQ + token * 1024 + h * 256 + 8 * hh;
#pragma unroll
      for (int kk = 0; kk < 16; ++kk) qf[kk] = __builtin_bit_cast(bf16x8, *(const v4u*)(qp + 16 * kk)); }
    f32x16 s[8];
#pragma unroll
    for (int kt = 0; kt < 8; ++kt) {
        s[kt] = zero16();
        const bf16* kp = Kb + (size_t)(b * 256 + 32 * kt + tau32(r32)) * 1024 + h * 256 + 8 * hh;
#pragma unroll
        for (int kk = 0; kk < 16; ++kk) { const bf16x8 Af = __builtin_bit_cast(bf16x8, *(const v4u*)(kp + 16 * kk)); s[kt] = MFMA32(Af, qf[kk], s[kt]); }
    }
    float mx = -3.0e38f;
#pragma unroll
    for (int kt = 0; kt < 8; ++kt)
#pragma unroll
        for (int rg = 0; rg < 16; ++rg) mx = fmaxf(mx, s[kt][rg]);
    mx = fmaxf(mx, __shfl_xor(mx, 32));
    float sum = 0.f; constexpr float C2 = 0.0625f * 1.4426950408889634f;
#pragma unroll
    for (int kt = 0; kt < 8; ++kt)
#pragma unroll
        for (int rg = 0; rg < 16; ++rg) { const float p = __builtin_amdgcn_exp2f((s[kt][rg] - mx) * C2); s[kt][rg] = p; sum += p; }
    sum += __shfl_xor(sum, 32);
    const float inv = 1.0f / sum;
    bf16x8 pf[8][2];
#pragma unroll
    for (int kt = 0; kt < 8; ++kt) { pf[kt][0] = pack8(s[kt], 0); pf[kt][1] = pack8(s[kt], 1); }
    bf16* yp = XQ + token * 1024 + h * 256 + 4 * hh;
#pragma unroll 1
    for (int dt = 0; dt < 8; ++dt) {
        f32x16 o = zero16();
        const bf16* vp = VTg + (size_t)(h * 256 + 32 * dt + r32) * 2048 + b * 256 + 8 * hh;
#pragma unroll
        for (int kt = 0; kt < 8; ++kt)
#pragma unroll
            for (int s2 = 0; s2 < 2; ++s2) { const bf16x8 Af = __builtin_bit_cast(bf16x8, *(const v4u*)(vp + 32 * kt + 16 * s2)); o = MFMA32(Af, pf[kt][s2], o); }
#pragma unroll
        for (int g4 = 0; g4 < 4; ++g4) { v2u w; w.x = cvtpk(o[4 * g4] * inv, o[4 * g4 + 1] * inv); w.y = cvtpk(o[4 * g4 + 2] * inv, o[4 * g4 + 3] * inv);
            *(v2u*)(yp + 32 * dt + 8 * g4) = w; }
    }
}

__device__ __forceinline__ void glr_tile(int tile, const bf16* XB, const bf16* Wg, const float* ss, float* GLR, int lane) {
    const int r16 = lane & 15, q4 = lane >> 4;
    const bf16* ap = XB + (size_t)(16 * tile + r16) * D + 8 * q4; const bf16* bp = Wg + (size_t)r16 * D + 8 * q4;
    f32x4 acc = (f32x4){0.f, 0.f, 0.f, 0.f};
#pragma unroll 8
    for (int kk = 0; kk < 64; ++kk) {
        const bf16x8 Af = __builtin_bit_cast(bf16x8, *(const v4u*)(ap + 32 * kk)), Bf = __builtin_bit_cast(bf16x8, *(const v4u*)(bp + 32 * kk));
        acc = __builtin_amdgcn_mfma_f32_16x16x32_bf16(Af, Bf, acc, 0, 0, 0);
    }
#pragma unroll
    for (int j = 0; j < 4; ++j) { const int token = 16 * tile + 4 * q4 + j; const float s = 1.0f / sqrtf(ss[token] * (1.0f / D) + EPS); GLR[(size_t)token * 16 + r16] = acc[j] * s; }
}

__global__ void __launch_bounds__(NTHREADS, 2) mk_fwd(Args args) {
    extern __shared__ __attribute__((aligned(16))) unsigned char lds_raw[];
    LAS unsigned char* lds = (LAS unsigned char*)lds_raw;
    const int tid = threadIdx.x, lane = tid & 63, wave = __builtin_amdgcn_readfirstlane(tid >> 6);
    const int G = gridDim.x, bx = blockIdx.x;
    unsigned char* ws = args.ws;
    unsigned* ctl = (unsigned*)(ws + WS_CTL);
    volatile LAS unsigned* MISC = (volatile LAS unsigned*)(lds + MISC_OFF);
    for (int u = tid; u < (LDS_BYTES - RING_BYTES) / 4; u += NTHREADS) ((LAS unsigned*)(lds + RING_BYTES))[u] = 0u;
    __syncthreads();
#if MK_PER_PHASE
#define GRID_BAR() do {} while (0)
#else
    XcdBarrier bar = xcd_barrier_post(ctl + CW_BAR, MISC + 8);
#define GRID_BAR() xcd_barrier(bar)
#endif
    const int lo = args.ph_lo, hi = args.ph_hi;
#if MK_STAMP
    if (bx == 0 && tid == 0) ((unsigned long long*)(ws + CTL_DBG))[32 + 20] = __builtin_amdgcn_s_memrealtime();
#endif
#define IN(k) (lo <= (k) && (k) < hi)
#if MK_STAMP
#define SEAM(k) do { if (IN((k) + 1)) GRID_BAR(); if (bx == 0 && tid == 0) ((unsigned long long*)(ws + CTL_DBG))[32 + (k)] = __builtin_amdgcn_s_memrealtime(); } while (0)
#else
#define SEAM(k) do { if (IN((k) + 1)) GRID_BAR(); } while (0)
#endif

    const float* x = args.in[I_X]; float* out = args.out;
    float* SS1 = (float*)(ws + CTL_SS1); float* SS2 = (float*)(ws + CTL_SS2); float* SS0 = (float*)(ws + CTL_SS0); float* SS3 = (float*)(ws + CTL_SS3);
    float* GLR = (float*)(ws + WS_GLR); float* ADEC = (float*)(ws + WS_ADEC);
    bf16* WGLR = (bf16*)(ws + WS_WGLR); bf16* KB = (bf16*)(ws + WS_KB); bf16* VTG = (bf16*)(ws + WS_VT); bf16* MEMB = (bf16*)(ws + WS_MEMB);
    bf16* WGU1 = (bf16*)(ws + WS_WGU1); bf16* WD1 = (bf16*)(ws + WS_WD1); bf16* WIN = (bf16*)(ws + WS_WIN); bf16* WKV = (bf16*)(ws + WS_WKV);
    bf16* WBR = (bf16*)(ws + WS_WB); bf16* WO = (bf16*)(ws + WS_WO); bf16* WGU2 = (bf16*)(ws + WS_WGU2); bf16* WD2 = (bf16*)(ws + WS_WD2);
    bf16* XB = (bf16*)(ws + WS_XB); bf16* ACT = (bf16*)(ws + WS_ACT);
    bf16* Qb = (bf16*)(ws + WS_Q); bf16* Kt = (bf16*)(ws + WS_K); bf16* Vb = (bf16*)(ws + WS_V); bf16* Rb = (bf16*)(ws + WS_R);
    bf16* SUb = (bf16*)(ws + WS_SU); bf16* SVb = (bf16*)(ws + WS_SV); bf16* XQb = (bf16*)(ws + WS_XQ);
    bf16* MRG = (bf16*)(ws + WS_MRG); bf16* GA = (bf16*)(ws + WS_WGU1); bf16* GB = (bf16*)(ws + WS_G); bf16* US = (bf16*)(ws + WS_G);
    const int gw = bx * NWAVES + wave, NGW = G * NWAVES;
    const ConvCtx cvx{args.in, WGU1, WGU2, WD1, WD2, WIN, WKV, WBR, WO};

    if (IN(0)) {
      for (int rep = 0; rep < (MK_DUP == 0 ? 2 : 1); ++rep) {
        for (int it = bx; it < CONV_EARLY; it += G) { ConvItem ci; f32x4 v[16]; conv_early(cvx, it, wave, ci); conv_issue(ci, v, lane); conv_finish(ci, v, lane); }
        for (int i = bx * NTHREADS + tid; i < 16 * D; i += G * NTHREADS) { const int r = i / D, k = i % D; WGLR[i] = f2bf(args.in[I_WIN][(size_t)k * INW + 3072 + r] * args.in[I_MIXN][k]); }
        for (int m = gw; m < M; m += NGW) row_to_bf16_ss(x + (size_t)m * D, XB + (size_t)m * D, SS0 + m, lane);
        for (int m = gw; m < MROWS; m += NGW) rms_row_to_bf16(args.in[I_MEM] + (size_t)m * D, args.in[I_MEMN], MEMB + (size_t)m * D, lane);
        __syncthreads();
      }
        SEAM(0);
    }
    if (IN(1)) {
        P1Sched S{(const char*)XB, (const char*)WGU1, (const char*)MEMB, (const char*)WKV, G, bx};
        EpiGU E{ACT, SS0, KB, VTG, &cvx, bx, G};
        pg8::gemm_phase(lds, D, D, D, S, E);
        if (bx >= 64) { for (int it = CONV_EPI + (bx - 64); it < CONV_LATE; it += G - 64) { ConvItem ci; f32x4 v[16]; conv_late(cvx, it, wave, ci); conv_issue(ci, v, lane); conv_finish(ci, v, lane); } }
        if (MK_DUP == 1) pg8::gemm_phase(lds, D, D, D, S, E);
        SEAM(1);
    }
    if (IN(2)) {
        GridSched S{(const char*)ACT, (const char*)WD1, (size_t)256 * DFF * 2, (size_t)256 * DFF * 2, 64, 8, G, bx};
        EpiRes E{XB, SS1, 0.5f};
        pg8::gemm_phase(lds, DFF, DFF, DFF, S, E);
        SEAM(2);
    }
    if (IN(3)) {
        GridSched S{(const char*)XB, (const char*)WIN, (size_t)256 * D * 2, (size_t)256 * D * 2, 64, 32, G, bx};
        EpiProj E{SS1, Qb, Kt, Vb, Rb, SUb, SVb, XQb, GA};
        pg8::gemm_phase(lds, D, D, D, S, E);
        if (MK_DUP == 3) pg8::gemm_phase(lds, D, D, D, S, E);
        if (wave < 4) glr_tile(bx * 4 + wave, XB, WGLR, SS1, GLR, lane);
        SEAM(3);
    }
    if (IN(4)) {
        for (int i = 0; i < 4; ++i) gla_step1(lds, bx * 4 + i, Qb, Kt, Vb, GLR, args.in[I_GUP], args.in[I_GB], ADEC, US, wave, lane);
        for (int i = 0; i < 2; ++i) sg_unit(lds, bx * 2 + i, SUb, SVb, args.in[I_LNG], args.in[I_LNB], args.in[I_WS], args.in[I_BS], wave, lane);
        SEAM(4);
    }
    if (IN(5)) {
        gla_scan(US, ADEC, bx * NTHREADS + tid);
        xa_task(bx * 8 + wave, XQb, KB, VTG, lane);
        SEAM(5);
    }
    if (IN(6)) {
        for (int i = 0; i < 4; ++i) gla_step3(lds, bx * 4 + i, Qb, Kt, Vb, Rb, US, args.in[I_GON], wave, lane);
        SEAM(6);
    }
#pragma unroll
    for (int i = 0; i < 3; ++i) {
        if (IN(7 + i)) {
            bf16* Gcur = (i & 1) ? GB : GA; bf16* Gnxt = (i & 1) ? GA : GB;
            { const bf16* Y = i == 0 ? Vb : (i == 1 ? SUb : XQb);
              GridSched S{(const char*)Y, (const char*)(WBR + (size_t)i * D * 1024), (size_t)256 * 1024 * 2, (size_t)256 * 1024 * 2, 64, 8, G, bx};
              EpiMerge E{Gcur, MRG, i == 0};
              pg8::gemm_phase(lds, 1024, 1024, 1024, S, E); }
            if (i < 2) {
              GridSched S{(const char*)XB, (const char*)(WIN + (size_t)(NPROJ + (i + 1) * D) * D), (size_t)256 * D * 2, (size_t)256 * D * 2, 64, 8, G, bx};
              EpiGate E{SS1, Gnxt};
              pg8::gemm_phase(lds, D, D, D, S, E); }
            SEAM(7 + i);
        }
    }
    if (IN(10)) {
        GridSched S{(const char*)MRG, (const char*)WO, (size_t)256 * D * 2, (size_t)256 * D * 2, 64, 8, G, bx};
        EpiRes E{XB, SS2, 1.0f};
        pg8::gemm_phase(lds, D, D, D, S, E);
        SEAM(10);
    }
    if (IN(11)) {
        GridSched S{(const char*)XB, (const char*)WGU2, (size_t)256 * D * 2, (size_t)256 * D * 2, 64, 44, G, bx};
        EpiGU E{ACT, SS2, nullptr, nullptr, nullptr, 0, 0};
#if MK_STAMP
        unsigned long long* stp = (unsigned long long*)(ws + CTL_DBG) + (bx == 37 ? 0 : 8);
        const unsigned long long c0 = __builtin_amdgcn_s_memtime(), r0 = __builtin_amdgcn_s_memrealtime();
        pg8::gemm_phase<EpiGU, GridSched, true>(lds, D, D, D, S, E, stp);
        const unsigned long long c1 = __builtin_amdgcn_s_memtime(), r1 = __builtin_amdgcn_s_memrealtime();
        if (tid == 0) { stp[3] = c1 - c0; stp[4] = r1 - r0; }
#else
        pg8::gemm_phase(lds, D, D, D, S, E);
#endif
        if (MK_DUP == 14) pg8::gemm_phase(lds, D, D, D, S, E);
        SEAM(11);
    }
    if (IN(12)) {
        GridSched S{(const char*)ACT, (const char*)WD2, (size_t)256 * DFF * 2, (size_t)256 * DFF * 2, 64, 8, G, bx};
        EpiRes E{XB, SS3, 0.5f};
        pg8::gemm_phase(lds, DFF, DFF, DFF, S, E);
        SEAM(12);
    }
    if (IN(13)) {
        const float* fg = args.in[I_FN];
        for (int m = gw; m < M; m += NGW) {
            const GAS v4u* xr = (const GAS v4u*)(XB + (size_t)m * D) + lane; GAS f32x4* orow = (GAS f32x4*)(out + (size_t)m * D); const GAS f32x4* gr = (const GAS f32x4*)fg;
            const float rs = 1.0f / sqrtf(SS3[m] * (1.0f / D) + EPS);
#pragma unroll
            for (int j = 0; j < 4; ++j) { const v4u w = xr[64 * j]; const int c = (64 * j + lane) * 2; const f32x4 g0 = gr[c], g1 = gr[c + 1];
                orow[c] = (f32x4){bflo(w.x) * rs * g0.x, bfhi(w.x) * rs * g0.y, bflo(w.y) * rs * g0.z, bfhi(w.y) * rs * g0.w};
                orow[c + 1] = (f32x4){bflo(w.z) * rs * g1.x, bfhi(w.z) * rs * g1.y, bflo(w.w) * rs * g1.z, bfhi(w.w) * rs * g1.w}; }
        }
#if MK_STAMP
        { const unsigned long long* stp = (const unsigned long long*)(ws + CTL_DBG);
          const float kc = (float)stp[0], ec = (float)stp[1], nun = (float)stp[2], cyc = (float)stp[3], rt = (float)stp[4];
          float c = 0.f;
          if (MK_STAMP == 1) c = floorf(4.0f * log2f(cyc / rt * 100.0f)) - 36.0f;
          if (MK_STAMP == 2) c = floorf(12.0f * log2f(kc / (nun * 32.0f))) - 120.0f;
          if (MK_STAMP == 3) c = floorf(8.0f * log2f(ec / nun)) - 90.0f;
          if (MK_STAMP == 4) c = floorf(12.0f * log2f(cyc / nun)) - 180.0f;
          if (MK_STAMP == 5) { const float us = (float)(stp[32 + MK_STAMP_B] - stp[32 + MK_STAMP_A]) * 0.01f; c = floorf(12.0f * log2f(us)) - 50.0f; }
          __syncthreads();
          for (int m = gw; m < M; m += NGW) { GAS f32x4* xr = (GAS f32x4*)(out + (size_t)m * D) + lane;
#pragma unroll
              for (int j = 0; j < 8; ++j) xr[64 * j] = (f32x4){c, c, c, c}; } }
#endif
    }
#undef IN
#undef SEAM
}
constexpr int LAST_PHASE = 14;


#if MK_DEBUG
constexpr size_t WS_DBG = 548 * MiB;
constexpr size_t DBG_SAVE = WS_DBG;
constexpr size_t DBG_QREF = WS_DBG + 2 * MiB, DBG_KREF = WS_DBG + 3 * MiB, DBG_VREF = WS_DBG + 4 * MiB, DBG_OREF = WS_DBG + 6 * MiB, DBG_AREF = WS_DBG + 8 * MiB;
constexpr int NSAVE = 64;
__device__ __forceinline__ unsigned hsh(unsigned a) { a ^= a >> 16; a *= 0x7feb352dU; a ^= a >> 15; a *= 0x846ca68bU; a ^= a >> 16; return a; }
__device__ __forceinline__ int save_row(int i) { return (int)(hsh(1000u + i) % M); }
__device__ __forceinline__ float block_sum(float v) {
    __shared__ float red[4]; __shared__ float tot;
    v = wave_sum(v); __syncthreads(); if ((threadIdx.x & 63) == 0) red[threadIdx.x >> 6] = v; __syncthreads();
    if (threadIdx.x == 0) tot = (red[0] + red[1]) + (red[2] + red[3]); __syncthreads(); return tot;
}
__device__ __forceinline__ float block_max(float v) {
    __shared__ float redm[4]; __shared__ float totm;
#pragma unroll
    for (int o = 1; o < 64; o <<= 1) v = fmaxf(v, __shfl_xor(v, o));
    __syncthreads(); if ((threadIdx.x & 63) == 0) redm[threadIdx.x >> 6] = v; __syncthreads();
    if (threadIdx.x == 0) totm = fmaxf(fmaxf(redm[0], redm[1]), fmaxf(redm[2], redm[3])); __syncthreads(); return totm;
}
__device__ __forceinline__ void dbg_add(float* dbg, int id, float got, float exp) { const float d = got - exp; atomicAdd(dbg + 2 * id, d * d); atomicAdd(dbg + 2 * id + 1, exp * exp); }
__device__ __forceinline__ float bdot(const bf16* a, const float* w, int ldw, int K, const float* gain) {
    float s = 0.f; for (int k = threadIdx.x; k < K; k += 256) s += bf2f(a[k]) * w[(size_t)k * ldw] * (gain ? gain[k] : 1.0f); return block_sum(s);
}
__device__ __forceinline__ float geluf_(float v) { return 0.5f * v * (1.0f + erff(v * 0.70710678f)); }
__device__ __forceinline__ float rsof(const float* ss, int r) { return 1.0f / sqrtf(ss[r] * (1.0f / D) + EPS); }

__global__ void chk_wt(const bf16* WT, int ldk, int nrows, const float* src, const float* src2, int ldw, int mode, const float* gain, float* dbg, int id) {
    const unsigned i = blockIdx.x * 256 + threadIdx.x; const int n = hsh(i * 2 + 1) % nrows, k = hsh(i * 2 + 2) % ldk;
    const float* s = src; int col = n;
    if (mode == 1) { const int tile = n / 256, w = n % 256; s = w < 128 ? src : src2; col = 128 * tile + (w & 127); }
    if (mode == 2) col = n < 3072 ? n : n + 16;
    if (mode == 3) col = 3072 + n;
    dbg_add(dbg, id, bf2f(WT[(size_t)n * ldk + k]), s[(size_t)k * ldw + col] * (gain ? gain[k] : 1.0f));
}
__global__ void chk_rms(const float* x, const float* gain, const bf16* xb, int nrows, float* dbg, int id) {
    const int r = hsh(77u + blockIdx.x) % nrows; float s = 0.f;
    for (int k = threadIdx.x; k < D; k += 256) { const float v = x[(size_t)r * D + k]; s += v * v; }
    const float rs = 1.0f / sqrtf(block_sum(s) * (1.0f / D) + EPS);
    for (int k = threadIdx.x; k < D; k += 256) dbg_add(dbg, id, bf2f(xb[(size_t)r * D + k]), x[(size_t)r * D + k] * rs * gain[k]);
}
__global__ void chk_act(const bf16* XBp, const float* wg, const float* wu, const float* gain, const float* ss, const bf16* ACTp, float* dbg, int id) {
    const int row = hsh(3u * blockIdx.x + 11u) % M, hid = hsh(3u * blockIdx.x + 12u) % DFF;
    float g = bdot(XBp + (size_t)row * D, wg + hid, DFF, D, gain), u = bdot(XBp + (size_t)row * D, wu + hid, DFF, D, gain);
    if (ss) { const float s = rsof(ss, row); g *= s; u *= s; }
    if (threadIdx.x == 0) dbg_add(dbg, id, bf2f(ACTp[(size_t)row * DFF + hid]), g / (1.0f + expf(-g)) * u);
}
__global__ void chk_kv(const bf16* MEMBp, const float* wkv, const bf16* KBp, const bf16* VTp, float* dbg, int idk, int idv) {
    const int row = hsh(5u * blockIdx.x + 1u) % MROWS, col = hsh(5u * blockIdx.x + 2u) % 2048;
    const float v = bdot(MEMBp + (size_t)row * D, wkv + col, D, D, nullptr);
    if (threadIdx.x == 0) { if (col < 1024) dbg_add(dbg, idk, bf2f(KBp[(size_t)row * 1024 + col]), v); else dbg_add(dbg, idv, bf2f(VTp[(size_t)(col - 1024) * 2048 + row]), v); }
}
__global__ void save_rows(const float* src, float* dst) { const int r = save_row(blockIdx.x); for (int k = threadIdx.x; k < D; k += 256) dst[(size_t)blockIdx.x * D + k] = src[(size_t)r * D + k]; }
__global__ void chk_res(const float* base, int base_saved, const bf16* a, int K, const float* w, float alpha, const float* outp, const bf16* xb, float* dbg, int id, int idb) {
    const int si = blockIdx.x % NSAVE, row = save_row(si), col = hsh(7u * blockIdx.x + 3u) % D;
    const float b = base_saved ? base[(size_t)si * D + col] : base[(size_t)row * D + col];
    const float v = b + alpha * bdot(a + (size_t)row * K, w + col, D, K, nullptr);
    if (threadIdx.x == 0) { dbg_add(dbg, id, outp[(size_t)row * D + col], v); if (xb) dbg_add(dbg, idb, bf2f(xb[(size_t)row * D + col]), v); }
}
__global__ void chk_ss(const float* outp, const float* ss, float* dbg, int id) {
    const int row = hsh(91u + blockIdx.x) % M; float s = 0.f;
    for (int k = threadIdx.x; k < D; k += 256) { const float v = outp[(size_t)row * D + k]; s += v * v; }
    s = block_sum(s); if (threadIdx.x == 0) dbg_add(dbg, id, ss[row], s);
}
__global__ void chk_proj(const bf16* XBp, const float* win, const float* mixn, const float* ss, const unsigned char* ws, float* dbg, int id, int idg) {
    const int row = hsh(9u * blockIdx.x + 1u) % M, j = hsh(9u * blockIdx.x + 2u) % (NPROJ + 16);
    const int srccol = j < 3072 ? j : (j < NPROJ ? j + 16 : 3072 + (j - NPROJ));
    float v = rsof(ss, row) * bdot(XBp + (size_t)row * D, win + srccol, INW, D, mixn);
    if (threadIdx.x != 0) return;
    if (j >= NPROJ) { dbg_add(dbg, idg, ((const float*)(ws + WS_GLR))[(size_t)row * 16 + (j - NPROJ)], v); return; }
    float got;
    if (j < 512) got = bf2f(((const bf16*)(ws + WS_Q))[(size_t)row * 512 + j]);
    else if (j < 1024) got = bf2f(((const bf16*)(ws + WS_K))[(size_t)row * 512 + j - 512]);
    else if (j < 2048) got = bf2f(((const bf16*)(ws + WS_V))[(size_t)row * 1024 + j - 1024]);
    else if (j < 3072) got = bf2f(((const bf16*)(ws + WS_R))[(size_t)row * 1024 + j - 2048]);
    else if (j < 4096) { got = bf2f(((const bf16*)(ws + WS_SU))[(size_t)row * 1024 + j - 3072]); v = geluf_(v); }
    else if (j < 5120) { got = bf2f(((const bf16*)(ws + WS_SV))[(size_t)row * 1024 + j - 4096]); v = geluf_(v); }
    else got = bf2f(((const bf16*)(ws + WS_XQ))[(size_t)row * 1024 + j - 5120]);
    dbg_add(dbg, id, got, v);
}
__global__ void chk_sg(const bf16* XBp, const float* win, const float* mixn, const float* ss, const bf16* SVp, const bf16* Ysg, const float* lng, const float* lnb, const float* wsp, const float* bsp, float* dbg, int id) {
    const int tok = hsh(13u * blockIdx.x + 1u) % M, g = hsh(13u * blockIdx.x + 2u) % 4, c = hsh(13u * blockIdx.x + 3u) % 256;
    const int t = tok % 128, tok0 = tok - t;
    const float su = geluf_(rsof(ss, tok) * bdot(XBp + (size_t)tok * D, win + 3088 + g * 256 + c, INW, D, mixn));
    float part = 0.f;
    if (threadIdx.x <= t && threadIdx.x < 128) { const int s = threadIdx.x; const bf16* p = SVp + (size_t)(tok0 + s) * 1024 + g * 256; float s1 = 0.f, s2 = 0.f;
        for (int k = 0; k < 256; ++k) { const float v = bf2f(p[k]); s1 += v; s2 += v * v; }
        const float mu = s1 / 256.0f, var = fmaxf(s2 / 256.0f - mu * mu, 0.f);
        const float vn = (bf2f(p[c]) - mu) / sqrtf(var + EPS) * lng[g * 256 + c] + lnb[g * 256 + c];
        part = wsp[((size_t)g * 128 + t) * 128 + s] * vn; }
    const float acc = block_sum(part);
    if (threadIdx.x == 0) dbg_add(dbg, id, bf2f(Ysg[(size_t)tok * 1024 + g * 256 + c]), su * (acc + bsp[g * 128 + t]));
}
__global__ void chk_xa(const bf16* XBp, const float* win, const float* mixn, const float* ss, const bf16* KBp, const bf16* VTp, const bf16* Yxa, float* dbg, int id) {
    __shared__ float qsh[256];
    const int tok = hsh(17u * blockIdx.x + 1u) % M, h = hsh(17u * blockIdx.x + 2u) % 4, e = hsh(17u * blockIdx.x + 3u) % 256, b = tok / SEQ;
    { const int d = threadIdx.x; float s = 0.f; const bf16* a = XBp + (size_t)tok * D; const float* w = win + 5136 + h * 256 + d;
      for (int k = 0; k < D; ++k) s += bf2f(a[k]) * w[(size_t)k * INW] * mixn[k];
      qsh[d] = s * rsof(ss, tok); }
    __syncthreads();
    const int m = threadIdx.x; float sc = 0.f; const bf16* kp = KBp + (size_t)(b * 256 + m) * 1024 + h * 256;
    for (int d = 0; d < 256; ++d) sc += qsh[d] * bf2f(kp[d]);
    sc *= 0.0625f;
    const float mx = block_max(sc), p = expf(sc - mx), sum = block_sum(p);
    const float o = block_sum(p * bf2f(VTp[(size_t)(h * 256 + e) * 2048 + b * 256 + m])) / sum;
    if (threadIdx.x == 0) dbg_add(dbg, id, bf2f(Yxa[(size_t)tok * 1024 + h * 256 + e]), o);
}
__global__ void gla_refA(const bf16* XBp, const float* win, const float* mixn, const float* ss, const float* GLRp, const float* wup, const float* gbias, int b, int h, float* qref, float* kref, float* vref, float* aref) {
    const int t = blockIdx.x, tok = b * SEQ + t; const bf16* a = XBp + (size_t)tok * D; const float rs = rsof(ss, tok);
    for (int o = threadIdx.x; o < 512; o += 256) {
        const int srccol = o < 128 ? h * 128 + o : (o < 256 ? 512 + h * 128 + (o - 128) : 1024 + h * 256 + (o - 256));
        float s = 0.f; const float* w = win + srccol; for (int k = 0; k < D; ++k) s += bf2f(a[k]) * w[(size_t)k * INW] * mixn[k];
        s *= rs; if (o < 128) qref[t * 128 + o] = s; else if (o < 256) kref[t * 128 + o - 128] = s; else vref[t * 256 + o - 256] = s;
    }
    if (threadIdx.x < 128) { const int d = threadIdx.x; float z = gbias[h * 128 + d]; for (int r = 0; r < 16; ++r) z += GLRp[(size_t)tok * 16 + r] * wup[r * 512 + h * 128 + d];
        const float ls = fminf(z, 0.f) - log1pf(expf(-fabsf(z))); aref[t * 128 + d] = expf(ls / 16.0f); }
}
__global__ void gla_refB(const float* qref, const float* kref, const float* vref, const float* aref, float* oref) {
    const int e = blockIdx.x, d = threadIdx.x & 127; const bool act = threadIdx.x < 128; float S = 0.f;
    for (int t = 0; t < SEQ; ++t) { float p = 0.f; if (act) { S = aref[t * 128 + d] * S + kref[t * 128 + d] * vref[t * 256 + e]; p = qref[t * 128 + d] * GLA_SCALE * S; }
        const float o = block_sum(p); if (threadIdx.x == 0) oref[t * 256 + e] = o; }
}
__global__ void gla_refC(const float* oref, const bf16* Rp, const bf16* Ygla, const float* onorm, int b, int h, float* dbg, int id) {
    const int t = blockIdx.x, e = threadIdx.x, tok = b * SEQ + t; const float o = oref[t * 256 + e];
    const float rs = 1.0f / sqrtf(block_sum(o * o) / 256.0f + EPS); const float r = bf2f(Rp[(size_t)tok * 1024 + h * 256 + e]);
    dbg_add(dbg, id, bf2f(Ygla[(size_t)tok * 1024 + h * 256 + e]), o * rs * onorm[h * 256 + e] * (r / (1.0f + expf(-r))));
}
__global__ void chk_gate(const bf16* XBp, const float* win, const float* mixn, const float* ss, const bf16* GTp, int i, float* dbg, int id) {
    const int row = hsh(19u * blockIdx.x + 1u) % M, col = hsh(19u * blockIdx.x + 2u) % D;
    const float v = rsof(ss, row) * bdot(XBp + (size_t)row * D, win + 6160 + i * D + col, INW, D, mixn);
    if (threadIdx.x == 0) dbg_add(dbg, id, bf2f(GTp[(size_t)row * D + col]), 1.0f / (1.0f + expf(-v)));
}
__global__ void chk_mrg(const bf16* XBp, const float* win, const float* mixn, const float* ss, const bf16* Y0, const bf16* Y1, const bf16* Y2, const float* wbr, const bf16* MRGp, float* dbg, int id) {
    const int row = hsh(23u * blockIdx.x + 1u) % M, col = hsh(23u * blockIdx.x + 2u) % D; float tot = 0.f;
    for (int i = 0; i < 3; ++i) { const float gp = rsof(ss, row) * bdot(XBp + (size_t)row * D, win + 6160 + i * D + col, INW, D, mixn);
        const bf16* Y = i == 0 ? Y0 : (i == 1 ? Y1 : Y2); const float z = bdot(Y + (size_t)row * 1024, wbr + (size_t)i * 1024 * D + col, D, 1024, nullptr);
        tot += z / (1.0f + expf(-gp)); }
    if (threadIdx.x == 0) dbg_add(dbg, id, bf2f(MRGp[(size_t)row * D + col]), tot);
}
__global__ void chk_final(const float* saved, const float* fn, const float* outp, float* dbg, int id) {
    const int si = blockIdx.x, row = save_row(si); float s = 0.f;
    for (int k = threadIdx.x; k < D; k += 256) { const float v = saved[(size_t)si * D + k]; s += v * v; }
    const float rs = 1.0f / sqrtf(block_sum(s) * (1.0f / D) + EPS);
    for (int k = threadIdx.x; k < D; k += 256) dbg_add(dbg, id, outp[(size_t)row * D + k], saved[(size_t)si * D + k] * rs * fn[k]);
}
__global__ void dbg_report(const float* dbg, float* outp, int nchk, int only) {
    int bad = -1;
    for (int k = 0; k < nchk; ++k) { const float num = dbg[2 * k], den = dbg[2 * k + 1]; if (num == 0.f && den == 0.f) continue; if (!(num < 1e-3f * den)) { bad = k; break; } }
    if (only >= 0) { const float num = dbg[2 * only], den = dbg[2 * only + 1]; bad = -1; if (!(num < 1e-3f * den)) bad = only; }
    if (bad < 0) return;
    const float c = (float)(bad + 2);
    for (size_t i = (size_t)blockIdx.x * 256 + threadIdx.x; i < (size_t)M * D; i += (size_t)gridDim.x * 256) outp[i] = c;
}
#endif

extern "C" void kernel_launch(void* const* d_in, const int* in_sizes, int n_in, void* d_out, int out_size, void* d_ws, size_t ws_size, hipStream_t stream) {
    static int grid = 0;
    if (grid == 0) {
        if (n_in != N_IN || in_sizes[0] != M * D || out_size != M * D || ws_size < WS_END) {
            fprintf(stderr, "kernel_launch: unexpected problem (n_in %d, in0 %d, out %d, ws %zu, need %zu); nothing launched\n", n_in, n_in > 0 ? in_sizes[0] : -1, out_size, ws_size, (size_t)WS_END); grid = -1; return; }
        int dev = 0, cus = 0, per_cu = 0;
        if (hipGetDevice(&dev) != hipSuccess || hipDeviceGetAttribute(&cus, hipDeviceAttributeMultiprocessorCount, dev) != hipSuccess) { grid = -1; return; }
        if (hipFuncSetAttribute((const void*)mk_fwd, hipFuncAttributeMaxDynamicSharedMemorySize, LDS_BYTES) != hipSuccess) { fprintf(stderr, "kernel_launch: hipFuncSetAttribute failed\n"); grid = -1; return; }
        if (hipOccupancyMaxActiveBlocksPerMultiprocessor(&per_cu, (const void*)mk_fwd, NTHREADS, LDS_BYTES) != hipSuccess || per_cu < 1)
            fprintf(stderr, "kernel_launch: note: occupancy query reports %d workgroups per CU\n", per_cu);
        (void)hipGetLastError();
        if (cus < 256) { fprintf(stderr, "kernel_launch: %d CUs; this kernel needs 256 resident workgroups (one per CU); nothing launched\n", cus); grid = -1; return; }
        grid = 256;
    }
    if (grid < 0) return;
    if (hipMemsetAsync((char*)d_ws + WS_CTL, 0, CTL_ZERO_BYTES, stream) != hipSuccess) return;
    Args a{};
    for (int i = 0; i < N_IN; ++i) a.in[i] = (const float*)d_in[i];
    a.out = (float*)d_out; a.ws = (unsigned char*)d_ws;
#if MK_PER_PHASE
    for (int p = 0; p < LAST_PHASE; ++p) { a.ph_lo = p; a.ph_hi = p + 1; hipLaunchKernelGGL(mk_fwd, dim3(grid), dim3(NTHREADS), LDS_BYTES, stream, a);
#if MK_DEBUG
        unsigned char* ws = (unsigned char*)d_ws; float* dbg = (float*)(ws + CTL_DBG); const float** in = (const float**)a.in; float* outp = (float*)d_out;
        const bf16* XBp = (const bf16*)(ws + WS_XB); const float* SS1p = (const float*)(ws + CTL_SS1); const float* SS2p = (const float*)(ws + CTL_SS2);
        float* sv1 = (float*)(ws + DBG_SAVE); float* sv2 = sv1 + NSAVE * D; float* sv3 = sv2 + NSAVE * D;
        if (p == 0) {
            chk_rms<<<64, 256, 0, stream>>>(in[I_X], in[I_F1N], XBp, M, dbg, 0);
            chk_wt<<<64, 256, 0, stream>>>((const bf16*)(ws + WS_WGU1), D, NGU, in[I_F1G], in[I_F1U], DFF, 1, nullptr, dbg, 1);
            chk_wt<<<64, 256, 0, stream>>>((const bf16*)(ws + WS_WIN), D, 12288, in[I_WIN], nullptr, INW, 2, in[I_MIXN], dbg, 2);
            chk_wt<<<64, 256, 0, stream>>>((const bf16*)(ws + WS_WD1), DFF, D, in[I_F1D], nullptr, D, 0, nullptr, dbg, 3);
            chk_wt<<<64, 256, 0, stream>>>((const bf16*)(ws + WS_WKV), D, D, in[I_WKV], nullptr, D, 0, nullptr, dbg, 4);
            for (int i = 0; i < 3; ++i) chk_wt<<<32, 256, 0, stream>>>((const bf16*)(ws + WS_WB) + (size_t)i * D * 1024, 1024, D, in[I_WBR] + (size_t)i * 1024 * D, nullptr, D, 0, nullptr, dbg, 5);
            chk_wt<<<64, 256, 0, stream>>>((const bf16*)(ws + WS_WO), D, D, in[I_WOUT], nullptr, D, 0, nullptr, dbg, 6);
            chk_wt<<<64, 256, 0, stream>>>((const bf16*)(ws + WS_WGU2), D, NGU, in[I_F2G], in[I_F2U], DFF, 1, in[I_F2N], dbg, 7);
            chk_wt<<<64, 256, 0, stream>>>((const bf16*)(ws + WS_WD2), DFF, D, in[I_F2D], nullptr, D, 0, nullptr, dbg, 8);
            chk_rms<<<64, 256, 0, stream>>>(in[I_MEM], in[I_MEMN], (const bf16*)(ws + WS_MEMB), MROWS, dbg, 9);
            chk_wt<<<16, 256, 0, stream>>>((const bf16*)(ws + WS_WGLR), D, 16, in[I_WIN], nullptr, INW, 3, in[I_MIXN], dbg, 10);
        }
        if (p == 1) { chk_act<<<512, 256, 0, stream>>>(XBp, in[I_F1G], in[I_F1U], nullptr, nullptr, (const bf16*)(ws + WS_ACT), dbg, 11);
            chk_kv<<<512, 256, 0, stream>>>((const bf16*)(ws + WS_MEMB), in[I_WKV], (const bf16*)(ws + WS_KB), (const bf16*)(ws + WS_VT), dbg, 12, 13); }
        if (p == 2) { chk_res<<<512, 256, 0, stream>>>(in[I_X], 0, (const bf16*)(ws + WS_ACT), DFF, in[I_F1D], 0.5f, outp, XBp, dbg, 14, 15);
            chk_ss<<<64, 256, 0, stream>>>(outp, SS1p, dbg, 16); save_rows<<<NSAVE, 256, 0, stream>>>(outp, sv1); }
        if (p == 3) chk_proj<<<1024, 256, 0, stream>>>(XBp, in[I_WIN], in[I_MIXN], SS1p, ws, dbg, 17, 18);
        if (p == 6) {
            chk_sg<<<256, 256, 0, stream>>>(XBp, in[I_WIN], in[I_MIXN], SS1p, (const bf16*)(ws + WS_SV), (const bf16*)(ws + WS_SU), in[I_LNG], in[I_LNB], in[I_WS], in[I_BS], dbg, 19);
            chk_xa<<<256, 256, 0, stream>>>(XBp, in[I_WIN], in[I_MIXN], SS1p, (const bf16*)(ws + WS_KB), (const bf16*)(ws + WS_VT), (const bf16*)(ws + WS_XQ), dbg, 20);
            const int gb = 3, gh = 2; float* qr = (float*)(ws + DBG_QREF); float* kr = (float*)(ws + DBG_KREF); float* vr = (float*)(ws + DBG_VREF); float* orf = (float*)(ws + DBG_OREF); float* ar = (float*)(ws + DBG_AREF);
            gla_refA<<<SEQ, 256, 0, stream>>>(XBp, in[I_WIN], in[I_MIXN], SS1p, (const float*)(ws + WS_GLR), in[I_GUP], in[I_GB], gb, gh, qr, kr, vr, ar);
            gla_refB<<<256, 256, 0, stream>>>(qr, kr, vr, ar, orf);
            gla_refC<<<SEQ, 256, 0, stream>>>(orf, (const bf16*)(ws + WS_R), (const bf16*)(ws + WS_V), in[I_GON], gb, gh, dbg, 21);
        }
        if (p == 7 || p == 9 || p == 11) chk_gate<<<256, 256, 0, stream>>>(XBp, in[I_WIN], in[I_MIXN], SS1p, (const bf16*)(ws + WS_G), (p - 7) / 2, dbg, 22 + (p - 7) / 2);
        if (p == 12) chk_mrg<<<256, 256, 0, stream>>>(XBp, in[I_WIN], in[I_MIXN], SS1p, (const bf16*)(ws + WS_V), (const bf16*)(ws + WS_SU), (const bf16*)(ws + WS_XQ), in[I_WBR], (const bf16*)(ws + WS_MRG), dbg, 25);
        if (p == 13) { chk_res<<<512, 256, 0, stream>>>(sv1, 1, (const bf16*)(ws + WS_MRG), D, in[I_WOUT], 1.0f, outp, XBp, dbg, 26, 27);
            chk_ss<<<64, 256, 0, stream>>>(outp, SS2p, dbg, 28); save_rows<<<NSAVE, 256, 0, stream>>>(outp, sv2); }
        if (p == 14) chk_act<<<512, 256, 0, stream>>>(XBp, in[I_F2G], in[I_F2U], in[I_F2N], SS2p, (const bf16*)(ws + WS_ACT), dbg, 29);
        if (p == 15) { chk_res<<<512, 256, 0, stream>>>(sv2, 1, (const bf16*)(ws + WS_ACT), DFF, in[I_F2D], 0.5f, outp, nullptr, dbg, 30, 30); save_rows<<<NSAVE, 256, 0, stream>>>(outp, sv3); }
        if (p == 16) { chk_final<<<NSAVE, 256, 0, stream>>>(sv3, in[I_FN], outp, dbg, 31); dbg_report<<<1024, 256, 0, stream>>>(dbg, outp, 32, MK_DEBUG_ONLY); }
#endif
    }
#else
    a.ph_lo = 0; a.ph_hi = LAST_PHASE;
    hipLaunchKernelGGL(mk_fwd, dim3(grid), dim3(NTHREADS), LDS_BYTES, stream, a);
#endif
}
```

```cpp
#include <hip/hip_runtime.h>
#include <cstdio>
#include <cstdint>

#ifndef MK_PER_PHASE
#define MK_PER_PHASE 0
#endif
#ifndef MK_DEBUG
#define MK_DEBUG 0
#endif
#ifndef MK_STAMP
#define MK_STAMP 0
#endif
#ifndef MK_STAMP_A
#define MK_STAMP_A 20
#endif
#ifndef MK_STAMP_B
#define MK_STAMP_B 0
#endif
#ifndef MK_ALIGN_T
#define MK_ALIGN_T false
#endif
#ifndef MK_DUP
#define MK_DUP (-1)
#endif
#ifndef MK_DEBUG_ONLY
#define MK_DEBUG_ONLY (-1)
#endif

#define GAS __attribute__((address_space(1)))
#define LAS __attribute__((address_space(3)))
typedef unsigned short bf16;
typedef unsigned v4u __attribute__((ext_vector_type(4)));
typedef unsigned v2u __attribute__((ext_vector_type(2)));
typedef float f32x4 __attribute__((ext_vector_type(4)));
typedef float f32x2 __attribute__((ext_vector_type(2)));
typedef float f32x16 __attribute__((ext_vector_type(16)));
typedef short bf16x8 __attribute__((ext_vector_type(8)));
typedef __bf16 bf16x2_t __attribute__((ext_vector_type(2)));

constexpr int D = 2048, BATCH = 8, SEQ = 2048, M = BATCH * SEQ, MEMLEN = 256, MROWS = BATCH * MEMLEN;
constexpr int DFF = 5632, NGU = 2 * DFF;
constexpr int INW = 12304;
constexpr int NPROJ = 6144;
constexpr float EPS = 1e-6f;
constexpr int NWAVES = 8, NTHREADS = 512;

constexpr size_t MiB = 1u << 20;
constexpr size_t WS_CTL = 0, CTL_ZERO_BYTES = 1 * MiB;
constexpr size_t WS_GLR = 1 * MiB;
constexpr size_t WS_ADEC = 2 * MiB;
constexpr size_t WS_WGLR = 2 * MiB + 512 * 1024;
constexpr size_t WS_KB = 3 * MiB;
constexpr size_t WS_VT = 7 * MiB;
constexpr size_t WS_MEMB = 11 * MiB;
constexpr size_t WS_WGU1 = 20 * MiB;
constexpr size_t WS_WD1 = 64 * MiB;
constexpr size_t WS_WIN = 86 * MiB;
constexpr size_t WS_WKV = 134 * MiB;
constexpr size_t WS_WB = 142 * MiB;
constexpr size_t WS_WO = 154 * MiB;
constexpr size_t WS_WGU2 = 162 * MiB;
constexpr size_t WS_WD2 = 206 * MiB;
constexpr size_t WS_XB = 228 * MiB;
constexpr size_t WS_C = 292 * MiB;
constexpr size_t WS_ACT = WS_C;
constexpr size_t WS_Q = WS_C;
constexpr size_t WS_K = WS_C + 16 * MiB;
constexpr size_t WS_V = WS_C + 32 * MiB;
constexpr size_t WS_SU = WS_C + 64 * MiB;
constexpr size_t WS_XQ = WS_C + 96 * MiB;
constexpr size_t WS_R = WS_C + 128 * MiB;
constexpr size_t WS_SV = WS_C + 160 * MiB;
constexpr size_t WS_MRG = WS_R;
constexpr size_t WS_G = WS_C + 192 * MiB;
constexpr size_t WS_END = WS_C + 256 * MiB;

constexpr int CW_TMO = 0;
constexpr int CW_BAR = 4096;
constexpr size_t CTL_SS1 = 128 * 1024, CTL_SS2 = 192 * 1024, CTL_SS0 = 320 * 1024, CTL_SS3 = 384 * 1024;
constexpr size_t CTL_DBG = 256 * 1024;

constexpr int RING_BYTES = 131072;
constexpr int MISC_OFF = RING_BYTES + 320;
constexpr int LDS_BYTES = 147456;

#define LDS_WAIT() asm volatile("s_waitcnt lgkmcnt(0)" ::: "memory")
#define VM_WAIT() asm volatile("s_waitcnt vmcnt(0)" ::: "memory")
__device__ __forceinline__ unsigned cvtpk(float lo, float hi) { f32x2 v = {lo, hi}; bf16x2_t b = __builtin_convertvector(v, bf16x2_t); return __builtin_bit_cast(unsigned, b); }
__device__ __forceinline__ float bflo(unsigned u) { return __builtin_bit_cast(float, u << 16); }
__device__ __forceinline__ float bfhi(unsigned u) { return __builtin_bit_cast(float, u & 0xffff0000u); }
__device__ __forceinline__ float bf2f(bf16 b) { return __builtin_bit_cast(float, (unsigned)b << 16); }
__device__ __forceinline__ bf16 f2bf(float f) { return (bf16)(cvtpk(f, 0.f) & 0xffffu); }
__device__ __forceinline__ float wave_sum(float v) {
#pragma unroll
    for (int o = 1; o < 64; o <<= 1) v += __shfl_xor(v, o);
    return v;
}
__device__ __forceinline__ float fast_exp(float x) { return __builtin_amdgcn_exp2f(x * 1.4426950408889634f); }
__device__ __forceinline__ float sigmoidf_(float x) { return __builtin_amdgcn_rcpf(1.0f + fast_exp(-x)); }

namespace pg8 {
constexpr int BM = 256, BK = 64, HALF = 128, HTB = HALF * BK * 2, STAGE_BYTES = 8 * HTB, NXCD = 8, WGM = 8;
__host__ __device__ __forceinline__ int lds_byte(int r, int c) { const int st = (r >> 4) * 2 + (c >> 5), rr = r & 15, cc = c & 31, ob = rr * 64 + cc * 2; return st * 1024 + (ob ^ (((ob >> 9) & 1) << 5)); }
__host__ __device__ __forceinline__ void stage_rc(int b, int& R, int& C) { const int st = b / 1024, sb = b % 1024, swz = sb ^ (((sb >> 9) & 1) << 5); R = (st >> 1) * 16 + swz / 64; C = (st & 1) * 32 + (swz % 64) / 2; }
__host__ __device__ __forceinline__ int perm32(int rho) { const int n = rho >> 4, i = rho & 15; return 8 * (i >> 2) + 4 * n + (i & 3); }

struct Unit { const char* A; const char* B; int pm, pn, kind, seq; };

__device__ __forceinline__ void tile_of(int L, int nM, int nN, int& pm, int& pn) {
    const int nwg = nM * nN;
    int wgid = L; { const int q = nwg / NXCD, r = nwg % NXCD, xcd = wgid % NXCD, off = wgid / NXCD; wgid = (xcd < r ? xcd * (q + 1) : r * (q + 1) + (xcd - r) * q) + off; }
    const int nig = WGM * nN, gid = wgid / nig, fm = gid * WGM, gsz = (nM - fm) < WGM ? (nM - fm) : WGM;
    pm = fm + ((wgid % nig) % gsz); pn = (wgid % nig) / gsz;
}

template <class Epi, class Sched, bool STAMP = false, bool ALIGN = true>
__device__ __forceinline__ void gemm_phase(LAS unsigned char* lds, const int K, const int lda, const int ldb, const Sched& S, const Epi& E, unsigned long long* st = nullptr) {
    unsigned long long kc = 0, ec = 0, t0 = 0; unsigned nun = 0;
    int tid = threadIdx.x; asm volatile("" : "+v"(tid));
    const int wid = __builtin_amdgcn_readfirstlane(tid >> 6), lane = tid & 63, wr = wid >> 2, wc = wid & 3, fr = lane & 15, fq = lane >> 4;
    const int nt = K / BK;
    unsigned voffA[2], voffB[2];
#pragma unroll
    for (int i = 0; i < 2; ++i) { int R, C; stage_rc(tid * 16 + i * 8192, R, C); const int Rb = (R & ~31) + perm32(R & 31);
        voffA[i] = (unsigned)(R * lda + C) * 2u; voffB[i] = (unsigned)(Rb * ldb + C) * 2u; }
    const size_t kstep = (size_t)(BK * 2);
    const size_t hstepA = (size_t)HALF * lda * 2, hstepB = (size_t)HALF * ldb * 2;
    const unsigned ldsw = (unsigned)wid * 1024u;
    const int aoff = lds_byte(wr * 64 + fr, fq * 8), boff = lds_byte(wc * 32 + fr, fq * 8);
#define PG8_SA(b, h) (((b) * 2 + (h)) * HTB)
#define PG8_SB(b, h) ((4 + (b) * 2 + (h)) * HTB)
#define PG8_STAGE(bufoff, gbase, voff) do { _Pragma("unroll") for (int _i = 0; _i < 2; ++_i) \
        __builtin_amdgcn_global_load_lds((const unsigned*)((const char*)(gbase) + (voff)[_i]), (LAS unsigned*)(lds + (bufoff) + ldsw + _i * 8192), 16, 0, 0); } while (0)
#define PG8_LDA(dst, b, h) do { _Pragma("unroll") for (int m = 0; m < 4; ++m) _Pragma("unroll") for (int k = 0; k < 2; ++k) dst[m][k] = *(const LAS bf16x8*)(lds + PG8_SA(b, h) + aoff + m * 2048 + k * 1024); } while (0)
#define PG8_LDB(dst, b, h) do { _Pragma("unroll") for (int n = 0; n < 2; ++n) _Pragma("unroll") for (int k = 0; k < 2; ++k) dst[n][k] = *(const LAS bf16x8*)(lds + PG8_SB(b, h) + boff + n * 2048 + k * 1024); } while (0)
#define PG8_MMA(ai, bj, At, Bt) do { __builtin_amdgcn_s_setprio(1); _Pragma("unroll") for (int m = 0; m < 4; ++m) _Pragma("unroll") for (int n = 0; n < 2; ++n) _Pragma("unroll") for (int k = 0; k < 2; ++k) \
        acc[ai][bj][m][n] = __builtin_amdgcn_mfma_f32_16x16x32_bf16(Bt[n][k], At[m][k], acc[ai][bj][m][n], 0, 0, 0); __builtin_amdgcn_s_setprio(0); } while (0)
#define PG8_WAIT_V(n) asm volatile("s_waitcnt vmcnt(" #n ")" ::: "memory")
#define PG8_WAIT_L(n) asm volatile("s_waitcnt lgkmcnt(" #n ")" ::: "memory")
#define PG8_BAR __builtin_amdgcn_s_barrier()
#define PG8_SCHED __builtin_amdgcn_sched_barrier(0)
    Unit cur, nxt; int ui = 0;
    if (!S.next(0, cur)) return;
    f32x4 acc[2][2][4][2];
#pragma unroll
    for (int a = 0; a < 2; ++a)
#pragma unroll
        for (int b = 0; b < 2; ++b)
#pragma unroll
            for (int m = 0; m < 4; ++m)
#pragma unroll
                for (int n = 0; n < 2; ++n) acc[a][b][m][n] = (f32x4){0.f, 0.f, 0.f, 0.f};
    bf16x8 At[4][2], B0[2][2], B1[2][2];
    const char* cA = cur.A; const char* cB = cur.B;
    PG8_STAGE(PG8_SB(0, 0), cB, voffB); PG8_STAGE(PG8_SB(0, 1), cB + hstepB, voffB); PG8_STAGE(PG8_SA(0, 0), cA, voffA); PG8_STAGE(PG8_SA(0, 1), cA + hstepA, voffA);
    if (wr == 1) PG8_BAR;
    PG8_WAIT_V(2); PG8_BAR;
    PG8_STAGE(PG8_SB(1, 0), cB + kstep, voffB); PG8_STAGE(PG8_SA(1, 0), cA + kstep, voffA); PG8_STAGE(PG8_SB(1, 1), cB + hstepB + kstep, voffB);
    PG8_WAIT_V(6); PG8_BAR;
    for (;;) {
        const bool has_next = S.next(ui + 1, nxt);
        const char* nA = has_next ? nxt.A : cA; const char* nB = has_next ? nxt.B : cB;
        if (STAMP) t0 = __builtin_amdgcn_s_memtime();
        for (int t = 0; t < nt; t += 2) {
            const bool last = (t == nt - 2);
            const char* a1 = cA + (size_t)(t + 1) * kstep;
            const char* a2 = last ? nA : cA + (size_t)(t + 2) * kstep; const char* b2 = last ? nB : cB + (size_t)(t + 2) * kstep;
            const char* a3 = a2 + kstep; const char* b3 = b2 + kstep;
            PG8_LDB(B0, 0, 0); PG8_LDB(B1, 0, 1); PG8_SCHED; PG8_LDA(At, 0, 0); PG8_STAGE(PG8_SA(1, 1), a1 + hstepA, voffA);
            PG8_WAIT_V(8); PG8_WAIT_L(0); PG8_BAR; PG8_MMA(0, 0, At, B0); PG8_MMA(0, 1, At, B1); PG8_BAR; PG8_SCHED;
            PG8_LDA(At, 0, 1); PG8_STAGE(PG8_SB(0, 0), b2, voffB); PG8_STAGE(PG8_SB(0, 1), b2 + hstepB, voffB); PG8_STAGE(PG8_SA(0, 0), a2, voffA);
            PG8_WAIT_V(8); PG8_WAIT_L(0); PG8_BAR; PG8_MMA(1, 0, At, B0); PG8_MMA(1, 1, At, B1); PG8_BAR; PG8_SCHED;
            PG8_LDB(B0, 1, 0); PG8_LDB(B1, 1, 1); PG8_SCHED; PG8_LDA(At, 1, 0); PG8_STAGE(PG8_SA(0, 1), a2 + hstepA, voffA);
            PG8_WAIT_V(8); PG8_WAIT_L(0); PG8_BAR; PG8_MMA(0, 0, At, B0); PG8_MMA(0, 1, At, B1); PG8_BAR; PG8_SCHED;
            PG8_LDA(At, 1, 1); PG8_STAGE(PG8_SB(1, 0), b3, voffB); PG8_STAGE(PG8_SB(1, 1), b3 + hstepB, voffB); PG8_STAGE(PG8_SA(1, 0), a3, voffA);
            PG8_WAIT_V(8); PG8_WAIT_L(0); PG8_BAR; PG8_MMA(1, 0, At, B0); PG8_MMA(1, 1, At, B1); PG8_BAR; PG8_SCHED;
        }
        if (STAMP) { const unsigned long long t1 = __builtin_amdgcn_s_memtime(); kc += t1 - t0; t0 = t1; }
        if (ALIGN) { if (wr == 0) PG8_BAR; }
        E(acc, cur, wr, wc, fr, fq);
        if (STAMP) { asm volatile("s_waitcnt vmcnt(0)" ::: "memory"); const unsigned long long t1 = __builtin_amdgcn_s_memtime(); ec += t1 - t0; ++nun; }
        if (!has_next) break;
#pragma unroll
        for (int a = 0; a < 2; ++a)
#pragma unroll
            for (int b = 0; b < 2; ++b)
#pragma unroll
                for (int m = 0; m < 4; ++m)
#pragma unroll
                    for (int n = 0; n < 2; ++n) acc[a][b][m][n] = (f32x4){0.f, 0.f, 0.f, 0.f};
        cur = nxt; cA = nA; cB = nB; ++ui;
        if (ALIGN) { if (wr == 1) PG8_BAR; }
    }
    PG8_WAIT_V(0);
    if (!ALIGN) { if (wr == 0) PG8_BAR; }
    PG8_BAR;
    if (STAMP && st && threadIdx.x == 0) { st[0] = kc; st[1] = ec; st[2] = nun; }
#undef PG8_SA
#undef PG8_SB
#undef PG8_STAGE
#undef PG8_LDA
#undef PG8_LDB
#undef PG8_MMA
#undef PG8_WAIT_V
#undef PG8_WAIT_L
#undef PG8_BAR
#undef PG8_SCHED
}

__device__ __forceinline__ float gelu1(float v) {
    const float av = __builtin_fabsf(v), d = av * 0.2316418882f + 1.0f;
    const float t = __builtin_amdgcn_rcpf(d);
    float q = t * 0.5307027145f + (-0.7265760135f); q = q * t + 0.7107068705f; q = q * t + (-0.142248368f); q = q * t + 0.127414796f; q = q * t;
    const float e = __builtin_amdgcn_exp2f((v * v) * (-0.72134752044f));
    const float mm = v * (q * e), r = v - mm;
    return v < 0.f ? mm : r;
}
__device__ __forceinline__ f32x2 gelu_pk(f32x2 v) {
    const f32x2 av = __builtin_elementwise_abs(v), d = av * 0.2316418882f + 1.0f;
    f32x2 t; t.x = __builtin_amdgcn_rcpf(d.x); t.y = __builtin_amdgcn_rcpf(d.y);
    f32x2 q = t * 0.5307027145f + (-0.7265760135f); q = q * t + 0.7107068705f; q = q * t + (-0.142248368f); q = q * t + 0.127414796f; q = q * t;
    const f32x2 s = (v * v) * (-0.72134752044f);
    f32x2 e; e.x = __builtin_amdgcn_exp2f(s.x); e.y = __builtin_amdgcn_exp2f(s.y);
    const f32x2 m = v * (q * e), r = v - m;
    f32x2 o; o.x = v.x < 0.f ? m.x : r.x; o.y = v.y < 0.f ? m.y : r.y; return o;
}
__device__ __forceinline__ f32x2 rcp1pexp2_pk(f32x2 t) {
    f32x2 e; e.x = __builtin_amdgcn_exp2f(t.x); e.y = __builtin_amdgcn_exp2f(t.y);
    const f32x2 d = e + 1.0f; f32x2 r; r.x = __builtin_amdgcn_rcpf(d.x); r.y = __builtin_amdgcn_rcpf(d.y); return r;
}
}

#define XB_TMO      128
#define XB_XCNT(j)  (256  + 64 * (j))
#define XB_XSUB(j)  (1280 + 64 * (j))
#define XB_XGEN(j)  (2304 + 64 * (j))
#define XB_TOP      3328
#define XB_TOPGEN   3392
#define XCD_BAR_WORDS 3456
#define XB_SPIN_CAP (1u << 18)
__device__ __forceinline__ unsigned xb_ld(unsigned* p)              { return __hip_atomic_load(p, __ATOMIC_RELAXED, __HIP_MEMORY_SCOPE_AGENT); }
__device__ __forceinline__ unsigned xb_add(unsigned* p, unsigned v) { return __hip_atomic_fetch_add(p, v, __ATOMIC_RELAXED, __HIP_MEMORY_SCOPE_AGENT); }
__device__ __forceinline__ unsigned xb_xcc_id() { return (unsigned)__builtin_amdgcn_s_getreg((3 << 11) | 20) & 0xFu; }
#define XB_SPIN(cond, bar) do { unsigned _sp = 0; while (cond) { __builtin_amdgcn_s_sleep(1); \
    if ((++_sp & 255u) == 0u) { if (xb_ld(&(bar)[XB_TMO])) break; if (_sp > XB_SPIN_CAP) { atomicAdd(&(bar)[XB_TMO], 1u); break; } } } } while (0)
struct XcdBarrier { unsigned* bar; unsigned x; volatile LAS unsigned* st; };
__device__ __forceinline__ XcdBarrier xcd_barrier_post(unsigned* bar, volatile LAS unsigned* st) {
    XcdBarrier b; b.bar = bar; b.x = xb_xcc_id(); b.st = st;
    if (threadIdx.x == 0) (void)xb_add(&bar[XB_XCNT(b.x)], 1u);
    return b;
}
__device__ __forceinline__ void xcd_barrier_complete(unsigned* bar, unsigned x, unsigned& nloc, unsigned& nx) {
    const unsigned G = gridDim.x * gridDim.y * gridDim.z;
    unsigned sum, cnt, mine, sp = 0u;
    for (;;) {
        sum = 0u; cnt = 0u; mine = 0u;
#pragma unroll
        for (unsigned j = 0; j < 16; ++j) { const unsigned c = xb_ld(&bar[XB_XCNT(j)]); sum += c; cnt += (c > 0u) ? 1u : 0u; mine = (j == x) ? c : mine; }
        if (sum == G) break;
        __builtin_amdgcn_s_sleep(1);
        if ((++sp & 255u) == 0u) { if (xb_ld(&bar[XB_TMO])) break; if (sp > XB_SPIN_CAP) { atomicAdd(&bar[XB_TMO], 1u); break; } }
    }
    nloc = mine > 0u ? mine : 1u; nx = cnt > 0u ? cnt : 1u;
}
__device__ __forceinline__ void xcd_barrier(const XcdBarrier& b) {
    asm volatile("s_waitcnt vmcnt(0)" ::: "memory");
    __syncthreads();
    if (threadIdx.x == 0) {
        unsigned* bar = b.bar;
        __builtin_amdgcn_s_waitcnt(0);
        unsigned nloc = b.st[0], nx = b.st[1];
        if (nloc == 0u) { xcd_barrier_complete(bar, b.x, nloc, nx); b.st[0] = nloc; b.st[1] = nx; }
        const unsigned old = xb_add(&bar[XB_XSUB(b.x)], 1u);
        const unsigned gen = old / nloc;
        if (old + 1u == (gen + 1u) * nloc) {
            __builtin_amdgcn_fence(__ATOMIC_RELEASE, "agent");
            asm volatile("s_waitcnt vmcnt(0)" ::: "memory");
            const unsigned og = xb_add(&bar[XB_TOP], 1u);
            const unsigned tg = og / nx;
            if (og + 1u == (tg + 1u) * nx) xb_add(&bar[XB_TOPGEN], 1u);
            else XB_SPIN(xb_ld(&bar[XB_TOPGEN]) == tg, bar);
            __builtin_amdgcn_fence(__ATOMIC_ACQUIRE, "agent");
            xb_add(&bar[XB_XGEN(b.x)], 1u);
            asm volatile("s_waitcnt vmcnt(0)" ::: "memory");
        } else {
            XB_SPIN(xb_ld(&bar[XB_XGEN(b.x)]) == gen, bar);
            __builtin_amdgcn_fence(__ATOMIC_ACQUIRE, "agent");
            asm volatile("s_waitcnt vmcnt(0)" ::: "memory");
        }
    }
    __syncthreads();
}

enum { I_X = 0, I_MEM, I_F1N, I_F1G, I_F1U, I_F1D, I_MIXN, I_MEMN, I_WIN, I_GUP, I_GB, I_GON, I_LNG, I_LNB, I_WS, I_BS, I_WKV, I_WBR, I_WOUT, I_F2N, I_F2G, I_F2U, I_F2D, I_FN, N_IN };
struct Args { const float* in[N_IN]; float* out; unsigned char* ws; int ph_lo, ph_hi; };
constexpr int N_PHASES = 20;

struct ConvCtx { const float* const* in; bf16 *WGU1, *WGU2, *WD1, *WD2, *WIN, *WKV, *WBR, *WO; };
struct ConvItem { const float* src; const float* gain; bf16* dst; int ldw, k0, src_col0, ldk, dst_row0; };
constexpr int CI_GU = 4 * 176, CI_DN = 11 * 32, CI_IN = 4 * 192, CI_KV = 4 * 32, CI_BR = 3 * 2 * 32, CI_WO = 4 * 32;
constexpr int CONV_EARLY = CI_GU + CI_KV;
constexpr int CONV_LATE = CI_DN + CI_IN + CI_BR + CI_WO + CI_GU + CI_DN;
constexpr int CONV_EPI = 1400;
__device__ __forceinline__ void conv_gu(const ConvCtx& c, int r, int second, int wave, ConvItem& o) {
    const int kb = (r / 176) * 8 + wave, nb = r % 176, tile = nb >> 2, w4 = nb & 3;
    o.src = c.in[second ? (w4 < 2 ? I_F2G : I_F2U) : (w4 < 2 ? I_F1G : I_F1U)]; o.gain = c.in[second ? I_F2N : I_F1N]; o.dst = second ? c.WGU2 : c.WGU1;
    o.ldw = DFF; o.k0 = 64 * kb; o.src_col0 = 128 * tile + 64 * (w4 & 1); o.ldk = D; o.dst_row0 = 64 * nb;
}
__device__ __forceinline__ void conv_plain(const float* src, bf16* dst, int r, int nbs, int ldw, int ldk, int wave, ConvItem& o) {
    const int kb = (r / nbs) * 8 + wave, nb = r % nbs; o.src = src; o.gain = nullptr; o.dst = dst; o.ldw = ldw; o.k0 = 64 * kb; o.src_col0 = 64 * nb; o.ldk = ldk; o.dst_row0 = 64 * nb;
}
__device__ __forceinline__ void conv_early(const ConvCtx& c, int r, int wave, ConvItem& o) {
    if (r < CI_GU) { conv_gu(c, r, 0, wave, o); return; }
    conv_plain(c.in[I_WKV], c.WKV, r - CI_GU, 32, D, D, wave, o);
}
__device__ __forceinline__ void conv_late(const ConvCtx& c, int r, int wave, ConvItem& o) {
    if (r < CI_DN) { conv_plain(c.in[I_F1D], c.WD1, r, 32, D, DFF, wave, o); return; } r -= CI_DN;
    if (r < CI_IN) { const int kb = (r / 192) * 8 + wave, nb = r % 192; o.src = c.in[I_WIN]; o.gain = c.in[I_MIXN]; o.dst = c.WIN; o.ldw = INW; o.k0 = 64 * kb; o.src_col0 = 64 * nb + (64 * nb >= 3072 ? 16 : 0); o.ldk = D; o.dst_row0 = 64 * nb; return; } r -= CI_IN;
    if (r < CI_BR) { const int i = r / 64; conv_plain(c.in[I_WBR] + (size_t)i * 1024 * D, c.WBR + (size_t)i * D * 1024, r % 64, 32, D, 1024, wave, o); return; } r -= CI_BR;
    if (r < CI_WO) { conv_plain(c.in[I_WOUT], c.WO, r, 32, D, D, wave, o); return; } r -= CI_WO;
    if (r < CI_GU) { conv_gu(c, r, 1, wave, o); return; } r -= CI_GU;
    conv_plain(c.in[I_F2D], c.WD2, r, 32, D, DFF, wave, o);
}
__device__ __forceinline__ void conv_issue(const ConvItem& it, f32x4 (&v)[16], int lane) {
    const float* p = it.src + (size_t)(it.k0 + 16 * (lane >> 4)) * it.ldw + it.src_col0 + (lane & 15) * 4;
#pragma unroll
    for (int i = 0; i < 16; ++i) v[i] = __builtin_nontemporal_load((const GAS f32x4*)(p + (size_t)i * it.ldw));
}
__device__ __forceinline__ void conv_finish(const ConvItem& it, f32x4 (&v)[16], int lane) {
    const int q = lane >> 4, c4 = (lane & 15) * 4;
    if (it.gain) {
#pragma unroll
        for (int i4 = 0; i4 < 4; ++i4) { const f32x4 g = *(const f32x4*)(it.gain + it.k0 + 16 * q + 4 * i4);
            v[4 * i4] *= g.x; v[4 * i4 + 1] *= g.y; v[4 * i4 + 2] *= g.z; v[4 * i4 + 3] *= g.w; }
    }
#pragma unroll
    for (int j = 0; j < 4; ++j) {
        bf16* o = it.dst + (size_t)(it.dst_row0 + c4 + j) * it.ldk + it.k0 + 16 * q;
        v4u w0, w1;
        w0.x = cvtpk(v[0][j], v[1][j]); w0.y = cvtpk(v[2][j], v[3][j]); w0.z = cvtpk(v[4][j], v[5][j]); w0.w = cvtpk(v[6][j], v[7][j]);
        w1.x = cvtpk(v[8][j], v[9][j]); w1.y = cvtpk(v[10][j], v[11][j]); w1.z = cvtpk(v[12][j], v[13][j]); w1.w = cvtpk(v[14][j], v[15][j]);
        *(GAS v4u*)o = w0; *(GAS v4u*)(o + 8) = w1;
    }
}

using pg8::Unit;
struct EpiGU {
    bf16* act; const float* ss; bf16* Kb; bf16* VT; const ConvCtx* cv; int cvbase, cvstride;
    __device__ __forceinline__ void operator()(const f32x4 (&acc)[2][2][4][2], const Unit& u, int wr, int wc, int fr, int fq) const {
        f32x4 cvv[16]; ConvItem cit; const int cvi = u.seq * (cvstride >> 1) + (cvbase >> 1); const bool docv = cv && u.seq < 11 && ((cvbase + u.seq) & 1) == 0 && cvi < CONV_EPI;
        if (docv) { conv_late(*cv, cvi, wr * 4 + wc, cit); conv_issue(cit, cvv, fq * 16 + fr); }
        epi(acc, u, wr, wc, fr, fq);
        if (docv) conv_finish(cit, cvv, fq * 16 + fr);
    }
    __device__ __forceinline__ void epi(const f32x4 (&acc)[2][2][4][2], const Unit& u, int wr, int wc, int fr, int fq) const {
        if (u.kind == 0) {
            const int row0 = u.pm * 256 + wr * 64 + fr, col0 = u.pn * 128 + wc * 32 + 8 * fq;
            const float* sp = ss + u.pm * 256 + wr * 64 + fq * 16 + fr; const float run0 = ss ? sp[0] : 0.f, run1 = ss ? sp[128] : 0.f;
#pragma unroll
            for (int ai = 0; ai < 2; ++ai)
#pragma unroll
                for (int m = 0; m < 4; ++m) {
                    const int r = row0 + ai * 128 + m * 16;
                    const float s = ss ? __builtin_amdgcn_rsqf(__shfl(ai ? run1 : run0, m * 16 + fr) * (1.0f / D) + EPS) : 1.0f;
                    const float c1 = -1.4426950408889634f * s, s2 = s * s;
                    f32x2 o[4];
#pragma unroll
                    for (int n = 0; n < 2; ++n)
#pragma unroll
                        for (int jp = 0; jp < 2; ++jp) { const f32x2 g = {acc[ai][0][m][n][2 * jp], acc[ai][0][m][n][2 * jp + 1]}, uu = {acc[ai][1][m][n][2 * jp], acc[ai][1][m][n][2 * jp + 1]};
                            o[n * 2 + jp] = (g * uu) * (pg8::rcp1pexp2_pk(g * c1) * s2); }
                    v4u w; w.x = cvtpk(o[0].x, o[0].y); w.y = cvtpk(o[1].x, o[1].y); w.z = cvtpk(o[2].x, o[2].y); w.w = cvtpk(o[3].x, o[3].y);
                    *(v4u*)(act + (size_t)r * DFF + col0) = w;
                }
        } else {
            bf16* base = u.kind == 1 ? Kb : VT; const int ldc = u.kind == 1 ? 1024 : 2048;
            const int row0 = u.pm * 256 + wr * 64 + fr, col0 = u.pn * 256 + wc * 32 + 8 * fq;
#pragma unroll
            for (int ai = 0; ai < 2; ++ai)
#pragma unroll
                for (int m = 0; m < 4; ++m) {
                    bf16* rowp = base + (size_t)(row0 + ai * 128 + m * 16) * ldc + col0;
#pragma unroll
                    for (int bj = 0; bj < 2; ++bj) { const f32x4 v0 = acc[ai][bj][m][0], v1 = acc[ai][bj][m][1];
                        v4u w; w.x = cvtpk(v0[0], v0[1]); w.y = cvtpk(v0[2], v0[3]); w.z = cvtpk(v1[0], v1[1]); w.w = cvtpk(v1[2], v1[3]);
                        *(v4u*)(rowp + bj * 128) = w; }
                }
        }
    }
};
struct EpiRes {
    bf16* xb; float* ss; float alpha;
    __device__ __forceinline__ void operator()(const f32x4 (&acc)[2][2][4][2], const Unit& u, int wr, int wc, int fr, int fq) const {
        const int row0 = u.pm * 256 + wr * 64 + fr, col0 = u.pn * 256 + wc * 32 + 8 * fq;
#pragma unroll
        for (int ai = 0; ai < 2; ++ai) {
            v4u old[4][2];
#pragma unroll
            for (int m = 0; m < 4; ++m)
#pragma unroll
                for (int bj = 0; bj < 2; ++bj) old[m][bj] = *(const v4u*)(xb + (size_t)(row0 + ai * 128 + m * 16) * D + col0 + bj * 128);
#pragma unroll
            for (int m = 0; m < 4; ++m) {
                const int r = row0 + ai * 128 + m * 16; const size_t off = (size_t)r * D + col0; float sq = 0.f;
#pragma unroll
                for (int bj = 0; bj < 2; ++bj) {
                    const v4u o = old[m][bj]; const f32x4 a0 = acc[ai][bj][m][0], a1 = acc[ai][bj][m][1];
                    float v[8];
                    v[0] = bflo(o.x) + alpha * a0[0]; v[1] = bfhi(o.x) + alpha * a0[1]; v[2] = bflo(o.y) + alpha * a0[2]; v[3] = bfhi(o.y) + alpha * a0[3];
                    v[4] = bflo(o.z) + alpha * a1[0]; v[5] = bfhi(o.z) + alpha * a1[1]; v[6] = bflo(o.w) + alpha * a1[2]; v[7] = bfhi(o.w) + alpha * a1[3];
                    v4u w; w.x = cvtpk(v[0], v[1]); w.y = cvtpk(v[2], v[3]); w.z = cvtpk(v[4], v[5]); w.w = cvtpk(v[6], v[7]);
                    *(v4u*)(xb + off + bj * 128) = w;
                    sq += (v[0] * v[0] + v[1] * v[1]) + (v[2] * v[2] + v[3] * v[3]) + (v[4] * v[4] + v[5] * v[5]) + (v[6] * v[6] + v[7] * v[7]);
                }
                if (ss) { sq += __shfl_xor(sq, 16); sq += __shfl_xor(sq, 32); if (fq == 0) atomicAdd(ss + r, sq); }
            }
            asm volatile("" ::: "memory");
        }
    }
};
struct EpiProj {
    const float* ss; bf16* q; bf16* k; bf16* v; bf16* r; bf16* su; bf16* sv; bf16* xq; bf16* g0;
    __device__ __forceinline__ void operator()(const f32x4 (&acc)[2][2][4][2], const Unit& u, int wr, int wc, int fr, int fq) const {
        bf16* base; int ldc, ct; bool act = false; const int pn = u.pn;
        if (pn < 2) { base = q; ldc = 512; ct = pn; } else if (pn < 4) { base = k; ldc = 512; ct = pn - 2; } else if (pn < 8) { base = v; ldc = 1024; ct = pn - 4; }
        else if (pn < 12) { base = r; ldc = 1024; ct = pn - 8; } else if (pn < 16) { base = su; ldc = 1024; ct = pn - 12; act = true; }
        else if (pn < 20) { base = sv; ldc = 1024; ct = pn - 16; act = true; } else if (pn < 24) { base = xq; ldc = 1024; ct = pn - 20; } else { base = g0; ldc = D; ct = pn - 24; }
        const bool gate = pn >= 24;
        const int row0 = u.pm * 256 + wr * 64 + fr, col0 = ct * 256 + wc * 32 + 8 * fq;
        const float* sp = ss + u.pm * 256 + wr * 64 + fq * 16 + fr; const float run0 = sp[0], run1 = sp[128];
#pragma unroll
        for (int ai = 0; ai < 2; ++ai)
#pragma unroll
            for (int m = 0; m < 4; ++m) {
                const int rr = row0 + ai * 128 + m * 16;
                const float s = __builtin_amdgcn_rsqf(__shfl(ai ? run1 : run0, m * 16 + fr) * (1.0f / D) + EPS);
                bf16* rowp = base + (size_t)rr * ldc + col0;
#pragma unroll
                for (int bj = 0; bj < 2; ++bj) { f32x4 v0 = acc[ai][bj][m][0] * s, v1 = acc[ai][bj][m][1] * s;
                    if (act) { const f32x2 a = pg8::gelu_pk((f32x2){v0[0], v0[1]}), b = pg8::gelu_pk((f32x2){v0[2], v0[3]}), c = pg8::gelu_pk((f32x2){v1[0], v1[1]}), d = pg8::gelu_pk((f32x2){v1[2], v1[3]});
                        v0 = (f32x4){a.x, a.y, b.x, b.y}; v1 = (f32x4){c.x, c.y, d.x, d.y}; }
                    if (gate) { const float c1 = -1.4426950408889634f; const f32x2 a = pg8::rcp1pexp2_pk((f32x2){v0[0], v0[1]} * c1), b = pg8::rcp1pexp2_pk((f32x2){v0[2], v0[3]} * c1), c = pg8::rcp1pexp2_pk((f32x2){v1[0], v1[1]} * c1), d = pg8::rcp1pexp2_pk((f32x2){v1[2], v1[3]} * c1);
                        v0 = (f32x4){a.x, a.y, b.x, b.y}; v1 = (f32x4){c.x, c.y, d.x, d.y}; }
                    v4u w; w.x = cvtpk(v0[0], v0[1]); w.y = cvtpk(v0[2], v0[3]); w.z = cvtpk(v1[0], v1[1]); w.w = cvtpk(v1[2], v1[3]);
                    *(v4u*)(rowp + bj * 128) = w; }
            }
    }
};
struct EpiGate {
    const float* ss; bf16* g;
    __device__ __forceinline__ void operator()(const f32x4 (&acc)[2][2][4][2], const Unit& u, int wr, int wc, int fr, int fq) const {
        const int row0 = u.pm * 256 + wr * 64 + fr, col0 = u.pn * 256 + wc * 32 + 8 * fq;
        const float* sp = ss + u.pm * 256 + wr * 64 + fq * 16 + fr; const float run0 = sp[0], run1 = sp[128];
#pragma unroll
        for (int ai = 0; ai < 2; ++ai)
#pragma unroll
            for (int m = 0; m < 4; ++m) {
                const int rr = row0 + ai * 128 + m * 16;
                const float s = __builtin_amdgcn_rsqf(__shfl(ai ? run1 : run0, m * 16 + fr) * (1.0f / D) + EPS);
                bf16* rowp = g + (size_t)rr * D + col0;
                const float c1 = -1.4426950408889634f * s;
#pragma unroll
                for (int bj = 0; bj < 2; ++bj) { const f32x4 a0 = acc[ai][bj][m][0], a1 = acc[ai][bj][m][1];
                    const f32x2 p = pg8::rcp1pexp2_pk((f32x2){a0[0], a0[1]} * c1), q = pg8::rcp1pexp2_pk((f32x2){a0[2], a0[3]} * c1), rr2 = pg8::rcp1pexp2_pk((f32x2){a1[0], a1[1]} * c1), t2 = pg8::rcp1pexp2_pk((f32x2){a1[2], a1[3]} * c1);
                    const f32x4 v0 = (f32x4){p.x, p.y, q.x, q.y}, v1 = (f32x4){rr2.x, rr2.y, t2.x, t2.y};
                    v4u w; w.x = cvtpk(v0[0], v0[1]); w.y = cvtpk(v0[2], v0[3]); w.z = cvtpk(v1[0], v1[1]); w.w = cvtpk(v1[2], v1[3]);
                    *(v4u*)(rowp + bj * 128) = w; }
            }
    }
};
struct EpiMerge {
    const bf16* g; bf16* mrg; int first;
    __device__ __forceinline__ void operator()(const f32x4 (&acc)[2][2][4][2], const Unit& u, int wr, int wc, int fr, int fq) const {
        const int row0 = u.pm * 256 + wr * 64 + fr, col0 = u.pn * 256 + wc * 32 + 8 * fq;
#pragma unroll
        for (int ai = 0; ai < 2; ++ai) {
            v4u gws[4][2], ows[4][2];
#pragma unroll
            for (int m = 0; m < 4; ++m)
#pragma unroll
                for (int bj = 0; bj < 2; ++bj) { const size_t off = (size_t)(row0 + ai * 128 + m * 16) * D + col0 + bj * 128;
                    gws[m][bj] = *(const v4u*)(g + off); ows[m][bj] = first ? (v4u){0u, 0u, 0u, 0u} : *(const v4u*)(mrg + off); }
#pragma unroll
            for (int m = 0; m < 4; ++m)
#pragma unroll
                for (int bj = 0; bj < 2; ++bj) {
                    const size_t off = (size_t)(row0 + ai * 128 + m * 16) * D + col0 + bj * 128;
                    const v4u gw = gws[m][bj], ow = ows[m][bj]; const f32x4 a0 = acc[ai][bj][m][0], a1 = acc[ai][bj][m][1];
                    float o[8];
                    o[0] = bflo(ow.x) + bflo(gw.x) * a0[0]; o[1] = bfhi(ow.x) + bfhi(gw.x) * a0[1]; o[2] = bflo(ow.y) + bflo(gw.y) * a0[2]; o[3] = bfhi(ow.y) + bfhi(gw.y) * a0[3];
                    o[4] = bflo(ow.z) + bflo(gw.z) * a1[0]; o[5] = bfhi(ow.z) + bfhi(gw.z) * a1[1]; o[6] = bflo(ow.w) + bflo(gw.w) * a1[2]; o[7] = bfhi(ow.w) + bfhi(gw.w) * a1[3];
                    v4u w; w.x = cvtpk(o[0], o[1]); w.y = cvtpk(o[2], o[3]); w.z = cvtpk(o[4], o[5]); w.w = cvtpk(o[6], o[7]);
                    *(v4u*)(mrg + off) = w;
                }
            asm volatile("" ::: "memory");
        }
    }
};

struct GridSched {
    const char* A; const char* B; size_t tA, tB; int nM, nN, G, c;
    __device__ __forceinline__ bool next(int i, Unit& u) const {
        const int L = i * G + c; if (L >= nM * nN) return false;
        pg8::tile_of(L, nM, nN, u.pm, u.pn); u.A = A + (size_t)u.pm * tA; u.B = B + (size_t)u.pn * tB; u.kind = 0; u.seq = i; return true;
    }
};
struct P1Sched {
    const char* h1b; const char* wgu; const char* memb; const char* wkv; int G, c;
    __device__ __forceinline__ bool next(int i, Unit& u) const {
        const int L = i * G + c; constexpr int NF = 64 * 44; const size_t T = (size_t)256 * D * 2; u.seq = i;
        if (L < NF) { pg8::tile_of(L, 64, 44, u.pm, u.pn); u.A = h1b + (size_t)u.pm * T; u.B = wgu + (size_t)u.pn * T; u.kind = 0; return true; }
        const int id = L - NF; if (id >= 64) return false;
        if (id < 32) { u.pm = id >> 2; u.pn = id & 3; u.A = memb + (size_t)u.pm * T; u.B = wkv + (size_t)u.pn * T; u.kind = 1; }
        else { const int j = id - 32; u.pm = j >> 3; u.pn = j & 7; u.A = wkv + (size_t)(4 + u.pm) * T; u.B = memb + (size_t)u.pn * T; u.kind = 2; }
        return true;
    }
};

__device__ __forceinline__ void transpose64(const float* W, int ldw, int k0, int src_col0, bf16* WT, int ldk, int dst_row0, const float* gain, LAS unsigned* T, int lane) {
    const int q = lane >> 4, c4 = (lane & 15) * 4;
    const float* p = W + (size_t)(k0 + 16 * q) * ldw + src_col0 + c4;
    f32x4 v[16];
#pragma unroll
    for (int i = 0; i < 16; ++i) v[i] = __builtin_nontemporal_load((const GAS f32x4*)(p + (size_t)i * ldw));
    if (gain) {
#pragma unroll
        for (int i4 = 0; i4 < 4; ++i4) { const f32x4 g = *(const f32x4*)(gain + k0 + 16 * q + 4 * i4);
            v[4 * i4] *= g.x; v[4 * i4 + 1] *= g.y; v[4 * i4 + 2] *= g.z; v[4 * i4 + 3] *= g.w; }
    }
#pragma unroll
    for (int j = 0; j < 4; ++j) {
        v4u w0, w1;
        w0.x = cvtpk(v[0][j], v[1][j]); w0.y = cvtpk(v[2][j], v[3][j]); w0.z = cvtpk(v[4][j], v[5][j]); w0.w = cvtpk(v[6][j], v[7][j]);
        w1.x = cvtpk(v[8][j], v[9][j]); w1.y = cvtpk(v[10][j], v[11][j]); w1.z = cvtpk(v[12][j], v[13][j]); w1.w = cvtpk(v[14][j], v[15][j]);
        LAS v4u* t = (LAS v4u*)(T + (c4 + j) * 36 + 8 * q); t[0] = w0; t[1] = w1;
    }
    LDS_WAIT(); asm volatile("" ::: "memory");
#pragma unroll
    for (int r = 0; r < 8; ++r) { const int n = 8 * r + (lane >> 3), ch = lane & 7;
        const v4u w = *(const LAS v4u*)(T + n * 36 + 4 * ch);
        *(GAS v4u*)(WT + (size_t)(dst_row0 + n) * ldk + k0 + 8 * ch) = w; }
    LDS_WAIT(); asm volatile("" ::: "memory");
}
__device__ __forceinline__ void row_to_bf16_ss(const float* xrow, bf16* orow, float* ssp, int lane) {
    const GAS f32x4* xr = (const GAS f32x4*)xrow + lane;
    f32x4 v[8]; float s = 0.f;
#pragma unroll
    for (int j = 0; j < 8; ++j) { v[j] = xr[64 * j]; s += (v[j].x * v[j].x + v[j].y * v[j].y) + (v[j].z * v[j].z + v[j].w * v[j].w); }
    s = wave_sum(s); if (lane == 0) *ssp = s;
    GAS v2u* o8 = (GAS v2u*)orow + lane;
#pragma unroll
    for (int j = 0; j < 8; ++j) { v2u w; w.x = cvtpk(v[j].x, v[j].y); w.y = cvtpk(v[j].z, v[j].w); o8[64 * j] = w; }
}
__device__ __forceinline__ void rms_row_to_bf16(const float* xrow, const float* gain, bf16* orow, int lane) {
    const GAS f32x4* xr = (const GAS f32x4*)xrow + lane; const GAS f32x4* gr = (const GAS f32x4*)gain + lane;
    f32x4 v[8]; float s = 0.f;
#pragma unroll
    for (int j = 0; j < 8; ++j) { v[j] = xr[64 * j]; s += (v[j].x * v[j].x + v[j].y * v[j].y) + (v[j].z * v[j].z + v[j].w * v[j].w); }
    const float rs = 1.0f / sqrtf(wave_sum(s) * (1.0f / D) + EPS);
    GAS v2u* o8 = (GAS v2u*)orow + lane;
#pragma unroll
    for (int j = 0; j < 8; ++j) { const f32x4 g = gr[64 * j]; v2u w; w.x = cvtpk(v[j].x * rs * g.x, v[j].y * rs * g.y); w.y = cvtpk(v[j].z * rs * g.z, v[j].w * rs * g.w); o8[64 * j] = w; }
}

__device__ __forceinline__ int tau32(int r) { return (r & ~12) | ((r & 4) << 1) | ((r & 8) >> 1); }
#define MFMA32(a, b, c) __builtin_amdgcn_mfma_f32_32x32x16_bf16((a), (b), (c), 0, 0, 0)
__device__ __forceinline__ bf16x8 pack8(const f32x16& x, int s) {
    v4u p; p.x = cvtpk(x[8 * s], x[8 * s + 1]); p.y = cvtpk(x[8 * s + 2], x[8 * s + 3]); p.z = cvtpk(x[8 * s + 4], x[8 * s + 5]); p.w = cvtpk(x[8 * s + 6], x[8 * s + 7]);
    return __builtin_bit_cast(bf16x8, p);
}
__device__ __forceinline__ f32x16 zero16() { f32x16 z;
#pragma unroll
    for (int i = 0; i < 16; ++i) z[i] = 0.f; return z; }

constexpr float GLA_SCALE = 0.08838834764831845f;
constexpr int VT_P = 72, KL_P = 72, QS_P = 136;

__device__ __forceinline__ void load_vT(const bf16* V, int tok0, int h, LAS bf16* VT, int wave, int lane) {
    const bf16* src = V + (size_t)(tok0 + lane) * 1024 + h * 256 + 32 * wave;
#pragma unroll
    for (int p = 0; p < 4; ++p) { const v4u raw = *(const v4u*)(src + 8 * p); const int c0 = 32 * wave + 8 * p;
        VT[(c0 + 0) * VT_P + lane] = (bf16)(raw.x & 0xffff); VT[(c0 + 1) * VT_P + lane] = (bf16)(raw.x >> 16);
        VT[(c0 + 2) * VT_P + lane] = (bf16)(raw.y & 0xffff); VT[(c0 + 3) * VT_P + lane] = (bf16)(raw.y >> 16);
        VT[(c0 + 4) * VT_P + lane] = (bf16)(raw.z & 0xffff); VT[(c0 + 5) * VT_P + lane] = (bf16)(raw.z >> 16);
        VT[(c0 + 6) * VT_P + lane] = (bf16)(raw.w & 0xffff); VT[(c0 + 7) * VT_P + lane] = (bf16)(raw.w >> 16); }
}

__device__ __forceinline__ void gla_step1(LAS unsigned char* lds, int unit, bf16* Q, bf16* Kt, const bf16* V, const float* GLR, const float* wup, const float* gbias, float* ADEC, bf16* US, int wave, int lane) {
    const int b = unit >> 7, h = (unit >> 5) & 3, n = unit & 31, tok0 = b * SEQ + n * 64, tid = wave * 64 + lane;
    LAS float* WUP = (LAS float*)lds;
    LAS float* BIAS = (LAS float*)(lds + 8192);
    LAS bf16* KLT = (LAS bf16*)(lds + 9216);
    LAS bf16* VTl = (LAS bf16*)(lds + 9216 + 128 * KL_P * 2);
    for (int i = tid; i < 16 * 128; i += NTHREADS) WUP[i] = wup[(i >> 7) * 512 + h * 128 + (i & 127)];
    if (tid < 128) BIAS[tid] = gbias[h * 128 + tid];
    load_vT(V, tok0, h, VTl, wave, lane);
    const int token = tok0 + lane;
    float gl[16];
    { const f32x4* gp = (const f32x4*)(GLR + (size_t)token * 16);
#pragma unroll
      for (int i = 0; i < 4; ++i) { const f32x4 t = gp[i]; gl[4 * i] = t.x; gl[4 * i + 1] = t.y; gl[4 * i + 2] = t.z; gl[4 * i + 3] = t.w; } }
    __syncthreads();
    float la[16];
#pragma unroll
    for (int j = 0; j < 16; ++j) {
        float z = BIAS[16 * wave + j];
#pragma unroll
        for (int r = 0; r < 16; ++r) z += gl[r] * WUP[r * 128 + 16 * wave + j];
        const float ls = fminf(z, 0.f) - __logf(1.0f + __expf(-fabsf(z)));
        float v = ls * (1.0f / 16.0f);
#pragma unroll
        for (int o = 1; o < 64; o <<= 1) { const float t = __shfl_up(v, o); if (lane >= o) v += t; }
        la[j] = v;
    }
    unsigned qraw[8], kraw[8];
    { const v4u* qp = (const v4u*)(Q + (size_t)token * 512 + h * 128 + 16 * wave); const v4u* kp = (const v4u*)(Kt + (size_t)token * 512 + h * 128 + 16 * wave);
      const v4u q0 = qp[0], q1 = qp[1], k0 = kp[0], k1 = kp[1];
      qraw[0] = q0.x; qraw[1] = q0.y; qraw[2] = q0.z; qraw[3] = q0.w; qraw[4] = q1.x; qraw[5] = q1.y; qraw[6] = q1.z; qraw[7] = q1.w;
      kraw[0] = k0.x; kraw[1] = k0.y; kraw[2] = k0.z; kraw[3] = k0.w; kraw[4] = k1.x; kraw[5] = k1.y; kraw[6] = k1.z; kraw[7] = k1.w; }
    unsigned qo[8], ko[8];
#pragma unroll
    for (int jj = 0; jj < 8; ++jj) {
        float qs2[2], ks2[2];
#pragma unroll
        for (int e = 0; e < 2; ++e) { const int j = 2 * jj + e;
            const float bb = la[j], bl = __shfl(bb, 63), a = __expf(bl), e1 = __expf(bb), e2 = __expf(-bb);
            const float qv = e ? bfhi(qraw[jj]) : bflo(qraw[jj]), kv = e ? bfhi(kraw[jj]) : bflo(kraw[jj]);
            qs2[e] = qv * (GLA_SCALE * e1); ks2[e] = kv * e2;
            KLT[(16 * wave + j) * KL_P + lane] = f2bf(kv * (e2 * a));
            if (lane == 63) ADEC[(size_t)unit * 128 + 16 * wave + j] = a; }
        qo[jj] = cvtpk(qs2[0], qs2[1]); ko[jj] = cvtpk(ks2[0], ks2[1]);
    }
    { v4u* qp = (v4u*)(Q + (size_t)token * 512 + h * 128 + 16 * wave); v4u* kp = (v4u*)(Kt + (size_t)token * 512 + h * 128 + 16 * wave);
      qp[0] = (v4u){qo[0], qo[1], qo[2], qo[3]}; qp[1] = (v4u){qo[4], qo[5], qo[6], qo[7]};
      kp[0] = (v4u){ko[0], ko[1], ko[2], ko[3]}; kp[1] = (v4u){ko[4], ko[5], ko[6], ko[7]}; }
    __syncthreads();
    const int r32 = lane & 31, hh = lane >> 5;
    f32x16 acc[4];
#pragma unroll
    for (int dt = 0; dt < 4; ++dt) acc[dt] = zero16();
#pragma unroll
    for (int kk = 0; kk < 4; ++kk) {
        const bf16x8 Bf = *(const LAS bf16x8*)(VTl + (32 * wave + r32) * VT_P + 16 * kk + 8 * hh);
#pragma unroll
        for (int dt = 0; dt < 4; ++dt) { const bf16x8 Af = *(const LAS bf16x8*)(KLT + (32 * dt + r32) * KL_P + 16 * kk + 8 * hh); acc[dt] = MFMA32(Af, Bf, acc[dt]); }
    }
    bf16* up = US + ((size_t)unit * 256 + 32 * wave + r32) * 128;
#pragma unroll
    for (int dt = 0; dt < 4; ++dt)
#pragma unroll
        for (int g4 = 0; g4 < 4; ++g4) { v2u w; w.x = cvtpk(acc[dt][4 * g4], acc[dt][4 * g4 + 1]); w.y = cvtpk(acc[dt][4 * g4 + 2], acc[dt][4 * g4 + 3]);
            *(v2u*)(up + 32 * dt + 8 * g4 + 4 * hh) = w; }
    __syncthreads();
}

__device__ __forceinline__ void gla_scan(bf16* US, const float* ADEC, int gid) {
    const int bh = gid >> 12, e = gid & 4095, dv = e >> 4, dk0 = (e & 15) * 8;
    float S[8];
#pragma unroll
    for (int i = 0; i < 8; ++i) S[i] = 0.f;
#pragma unroll 4
    for (int n = 0; n < 32; ++n) {
        const int unit = bh * 32 + n;
        v4u* p = (v4u*)(US + ((size_t)unit * 256 + dv) * 128 + dk0);
        const v4u uu = *p; const f32x4 a0 = *(const f32x4*)(ADEC + (size_t)unit * 128 + dk0), a1 = *(const f32x4*)(ADEC + (size_t)unit * 128 + dk0 + 4);
        v4u w; w.x = cvtpk(S[0], S[1]); w.y = cvtpk(S[2], S[3]); w.z = cvtpk(S[4], S[5]); w.w = cvtpk(S[6], S[7]);
        *p = w;
        S[0] = a0.x * S[0] + bflo(uu.x); S[1] = a0.y * S[1] + bfhi(uu.x); S[2] = a0.z * S[2] + bflo(uu.y); S[3] = a0.w * S[3] + bfhi(uu.y);
        S[4] = a1.x * S[4] + bflo(uu.z); S[5] = a1.y * S[5] + bfhi(uu.z); S[6] = a1.z * S[6] + bflo(uu.w); S[7] = a1.w * S[7] + bfhi(uu.w);
    }
}

__device__ __forceinline__ void gla_step3(LAS unsigned char* lds, int unit, const bf16* Q, const bf16* Kt, bf16* V, const bf16* R, const bf16* US, const float* onorm, int wave, int lane) {
    const int b = unit >> 7, h = (unit >> 5) & 3, n = unit & 31, tok0 = b * SEQ + n * 64, tid = wave * 64 + lane;
    LAS bf16* QS = (LAS bf16*)lds;
    LAS bf16* KS = (LAS bf16*)(lds + 64 * QS_P * 2);
    LAS bf16* VTl = (LAS bf16*)(lds + 2 * 64 * QS_P * 2);
    LAS float* RED = (LAS float*)(lds + 2 * 64 * QS_P * 2 + 256 * VT_P * 2);
#pragma unroll
    for (int i = 0; i < 2; ++i) { const int pc = tid + i * NTHREADS, row = pc >> 4, c8 = (pc & 15) * 8;
        *(LAS v4u*)(QS + row * QS_P + c8) = *(const v4u*)(Q + (size_t)(tok0 + row) * 512 + h * 128 + c8);
        *(LAS v4u*)(KS + row * QS_P + c8) = *(const v4u*)(Kt + (size_t)(tok0 + row) * 512 + h * 128 + c8); }
    load_vT(V, tok0, h, VTl, wave, lane);
    __syncthreads();
    const int r32 = lane & 31, hh = lane >> 5;
    f32x16 sc0 = zero16(), sc1 = zero16(), sc2 = zero16();
#pragma unroll
    for (int kk = 0; kk < 8; ++kk) {
        const bf16x8 A0 = *(const LAS bf16x8*)(KS + tau32(r32) * QS_P + 16 * kk + 8 * hh), A1 = *(const LAS bf16x8*)(KS + (32 + tau32(r32)) * QS_P + 16 * kk + 8 * hh);
        const bf16x8 B0 = *(const LAS bf16x8*)(QS + r32 * QS_P + 16 * kk + 8 * hh), B1 = *(const LAS bf16x8*)(QS + (32 + r32) * QS_P + 16 * kk + 8 * hh);
        sc0 = MFMA32(A0, B0, sc0); sc1 = MFMA32(A0, B1, sc1); sc2 = MFMA32(A1, B1, sc2);
    }
#pragma unroll
    for (int rg = 0; rg < 16; ++rg) { const int s = (rg & 3) + 4 * ((rg >> 2) & 1) + 8 * hh + 16 * (rg >> 3); if (s > r32) { sc0[rg] = 0.f; sc2[rg] = 0.f; } }
    f32x16 o0 = zero16(), o1 = zero16();
    const LAS bf16* vrow = VTl + (32 * wave + r32) * VT_P + 8 * hh;
#pragma unroll
    for (int s = 0; s < 2; ++s) {
        const bf16x8 Av0 = *(const LAS bf16x8*)(vrow + 16 * s), Av1 = *(const LAS bf16x8*)(vrow + 32 + 16 * s);
        o0 = MFMA32(Av0, pack8(sc0, s), o0); o1 = MFMA32(Av0, pack8(sc1, s), o1); o1 = MFMA32(Av1, pack8(sc2, s), o1);
    }
    const bf16* sp = US + ((size_t)unit * 256 + 32 * wave + r32) * 128 + 8 * hh;
#pragma unroll
    for (int kk = 0; kk < 8; ++kk) {
        const bf16x8 As = __builtin_bit_cast(bf16x8, *(const v4u*)(sp + 16 * kk));
        const bf16x8 B0 = *(const LAS bf16x8*)(QS + r32 * QS_P + 16 * kk + 8 * hh), B1 = *(const LAS bf16x8*)(QS + (32 + r32) * QS_P + 16 * kk + 8 * hh);
        o0 = MFMA32(As, B0, o0); o1 = MFMA32(As, B1, o1);
    }
    float q0 = 0.f, q1 = 0.f;
#pragma unroll
    for (int rg = 0; rg < 16; ++rg) { q0 += o0[rg] * o0[rg]; q1 += o1[rg] * o1[rg]; }
    q0 += __shfl_xor(q0, 32); q1 += __shfl_xor(q1, 32);
    if (hh == 0) { RED[wave * 64 + r32] = q0; RED[wave * 64 + 32 + r32] = q1; }
    __syncthreads();
    float t0 = 0.f, t1 = 0.f;
#pragma unroll
    for (int w = 0; w < 8; ++w) { t0 += RED[w * 64 + r32]; t1 += RED[w * 64 + 32 + r32]; }
    const float rs0 = 1.0f / sqrtf(t0 * (1.0f / 256.0f) + EPS), rs1 = 1.0f / sqrtf(t1 * (1.0f / 256.0f) + EPS);
#pragma unroll
    for (int tt = 0; tt < 2; ++tt) {
        const size_t rowoff = (size_t)(tok0 + 32 * tt + r32) * 1024 + h * 256 + 32 * wave + 4 * hh;
        const float rs = tt ? rs1 : rs0;
#pragma unroll
        for (int g4 = 0; g4 < 4; ++g4) {
            const v2u rw = *(const v2u*)(R + rowoff + 8 * g4); const f32x4 gn = *(const f32x4*)(onorm + h * 256 + 32 * wave + 8 * g4 + 4 * hh);
            float y[4];
#pragma unroll
            for (int j = 0; j < 4; ++j) { const float ov = tt ? o1[4 * g4 + j] : o0[4 * g4 + j]; const unsigned rr = j < 2 ? rw.x : rw.y; const float rv = (j & 1) ? bfhi(rr) : bflo(rr);
                y[j] = ov * rs * gn[j] * (rv * sigmoidf_(rv)); }
            v2u w; w.x = cvtpk(y[0], y[1]); w.y = cvtpk(y[2], y[3]); *(v2u*)(V + rowoff + 8 * g4) = w;
        }
    }
    __syncthreads();
}

__device__ __forceinline__ void sg_unit(LAS unsigned char* lds, int unit, bf16* SU, const bf16* SV, const float* lng, const float* lnb, const float* ws, const float* bs, int wave, int lane) {
    const int b = unit >> 6, n = (unit >> 2) & 15, g = unit & 3, tok0 = b * SEQ + n * 128, tid = wave * 64 + lane;
    LAS bf16* VNT = (LAS bf16*)lds;
    LAS bf16* WB = (LAS bf16*)(lds + 256 * QS_P * 2);
    LAS f32x2* RED = (LAS f32x2*)(lds + 256 * QS_P * 2 + 128 * QS_P * 2);
    { const int t = tid >> 2, s0 = (tid & 3) * 32; const float* wp = ws + ((size_t)g * 128 + t) * 128 + s0;
#pragma unroll
      for (int i = 0; i < 4; ++i) { const f32x4 a = *(const f32x4*)(wp + 8 * i), c = *(const f32x4*)(wp + 8 * i + 4); const int s = s0 + 8 * i;
          v4u w; w.x = cvtpk(s + 0 <= t ? a.x : 0.f, s + 1 <= t ? a.y : 0.f); w.y = cvtpk(s + 2 <= t ? a.z : 0.f, s + 3 <= t ? a.w : 0.f);
          w.z = cvtpk(s + 4 <= t ? c.x : 0.f, s + 5 <= t ? c.y : 0.f); w.w = cvtpk(s + 6 <= t ? c.z : 0.f, s + 7 <= t ? c.w : 0.f);
          *(LAS v4u*)(WB + t * QS_P + s) = w; } }
    const int tok = lane + 64 * (wave & 1), cq = wave >> 1;
    unsigned raw[32]; float s1 = 0.f, s2 = 0.f;
    { const v4u* p = (const v4u*)(SV + (size_t)(tok0 + tok) * 1024 + g * 256 + 64 * cq);
#pragma unroll
      for (int i = 0; i < 8; ++i) { const v4u t = p[i]; raw[4 * i] = t.x; raw[4 * i + 1] = t.y; raw[4 * i + 2] = t.z; raw[4 * i + 3] = t.w; } }
#pragma unroll
    for (int i = 0; i < 32; ++i) { const float a = bflo(raw[i]), c = bfhi(raw[i]); s1 += a + c; s2 += a * a + c * c; }
    RED[tok * 4 + cq] = (f32x2){s1, s2};
    __syncthreads();
    { const f32x2 p0 = RED[tok * 4], p1 = RED[tok * 4 + 1], p2 = RED[tok * 4 + 2], p3 = RED[tok * 4 + 3];
      const float mu = ((p0.x + p1.x) + (p2.x + p3.x)) * (1.0f / 256.0f); const float var = fmaxf(((p0.y + p1.y) + (p2.y + p3.y)) * (1.0f / 256.0f) - mu * mu, 0.f);
      const float rstd = 1.0f / sqrtf(var + EPS);
      const float* gp = lng + g * 256 + 64 * cq; const float* bp = lnb + g * 256 + 64 * cq;
#pragma unroll
      for (int i = 0; i < 32; ++i) { const int c = 64 * cq + 2 * i;
          VNT[c * QS_P + tok] = f2bf((bflo(raw[i]) - mu) * rstd * gp[2 * i] + bp[2 * i]);
          VNT[(c + 1) * QS_P + tok] = f2bf((bfhi(raw[i]) - mu) * rstd * gp[2 * i + 1] + bp[2 * i + 1]); } }
    __syncthreads();
    const int r32 = lane & 31, hh = lane >> 5;
    f32x16 acc[4];
#pragma unroll
    for (int j = 0; j < 4; ++j) {
        acc[j] = zero16();
#pragma unroll
        for (int kk = 0; kk < 2 * (j + 1); ++kk) {
            const bf16x8 Af = *(const LAS bf16x8*)(VNT + (32 * wave + r32) * QS_P + 16 * kk + 8 * hh), Bf = *(const LAS bf16x8*)(WB + (32 * j + r32) * QS_P + 16 * kk + 8 * hh);
            acc[j] = MFMA32(Af, Bf, acc[j]);
        }
    }
#pragma unroll
    for (int j = 0; j < 4; ++j) {
        const int t = 32 * j + r32; const float bias = bs[g * 128 + t];
        bf16* up = SU + (size_t)(tok0 + t) * 1024 + g * 256 + 32 * wave + 4 * hh;
#pragma unroll
        for (int g4 = 0; g4 < 4; ++g4) { const v2u uw = *(const v2u*)(up + 8 * g4);
            v2u w; w.x = cvtpk(bflo(uw.x) * (acc[j][4 * g4] + bias), bfhi(uw.x) * (acc[j][4 * g4 + 1] + bias)); w.y = cvtpk(bflo(uw.y) * (acc[j][4 * g4 + 2] + bias), bfhi(uw.y) * (acc[j][4 * g4 + 3] + bias));
            *(v2u*)(up + 8 * g4) = w; }
    }
    __syncthreads();
}

__device__ __forceinline__ void xa_task(int task, bf16* XQ, const bf16* Kb, const bf16* VTg, int lane) {
    const int qblk = task & 63, h = (task >> 6) & 3, b = task >> 8;
    const int r32 = lane & 31, hh = lane >> 5; const size_t token = (size_t)b * SEQ + 32 * qblk + r32;
    bf16x8 qf[16];
    { const bf16* qp = XQ + token * 1024 + h * 256 + 8 * hh;
#pragma unroll
      for (int kk = 0; kk < 16; ++kk) qf[kk] = __builtin_bit_cast(bf16x8, *(const v4u*)(qp + 16 * kk)); }
    f32x16 s[8];
#pragma unroll
    for (int kt = 0; kt < 8; ++kt) {
        s[kt] = zero16();
        const bf16* kp = Kb + (size_t)(b * 256 + 32 * kt + tau32(r32)) * 1024 + h * 256 + 8 * hh;
#pragma unroll
        for (int kk = 0; kk < 16; ++kk) { const bf16x8 Af = __builtin_bit_cast(bf16x8, *(const v4u*)(kp + 16 * kk)); s[kt] = MFMA32(Af, qf[kk], s[kt]); }
    }
    float mx = -3.0e38f;
#pragma unroll
    for (int kt = 0; kt < 8; ++kt)
#pragma unroll
        for (int rg = 0; rg < 16; ++rg) mx = fmaxf(mx, s[kt][rg]);
    mx = fmaxf(mx, __shfl_xor(mx, 32));
    float sum = 0.f; constexpr float C2 = 0.0625f * 1.4426950408889634f;
#pragma unroll
    for (int kt = 0; kt < 8; ++kt)
#pragma unroll
        for (int rg = 0; rg < 16; ++rg) { const float p = __builtin_amdgcn_exp2f((s[kt][rg] - mx) * C2); s[kt][rg] = p; sum += p; }
    sum += __shfl_xor(sum, 32);
    const float inv = 1.0f / sum;
    bf16x8 pf[8][2];
#pragma unroll
    for (int kt = 0; kt < 8; ++kt) { pf[kt][0] = pack8(s[kt], 0); pf[kt][1] = pack8(s[kt], 1); }
    bf16* yp = XQ + token * 1024 + h * 256 + 4 * hh;
#pragma unroll 1
    for (int dt = 0; dt < 8; ++dt) {
        f32x16 o = zero16();
        const bf16* vp = VTg + (size_t)(h * 256 + 32 * dt + r32) * 2048 + b * 256 + 8 * hh;
#pragma unroll
        for (int kt = 0; kt < 8; ++kt)
#pragma unroll
            for (int s2 = 0; s2 < 2; ++s2) { const bf16x8 Af = __builtin_bit_cast(bf16x8, *(const v4u*)(vp + 32 * kt + 16 * s2)); o = MFMA32(Af, pf[kt][s2], o); }
#pragma unroll
        for (int g4 = 0; g4 < 4; ++g4) { v2u w; w.x = cvtpk(o[4 * g4] * inv, o[4 * g4 + 1] * inv); w.y = cvtpk(o[4 * g4 + 2] * inv, o[4 * g4 + 3] * inv);
            *(v2u*)(yp + 32 * dt + 8 * g4) = w; }
    }
}

__device__ __forceinline__ void glr_tile(int tile, const bf16* XB, const bf16* Wg, const float* ss, float* GLR, int lane) {
    const int r16 = lane & 15, q4 = lane >> 4;
    const bf16* ap = XB + (size_t)(16 * tile + r16) * D + 8 * q4; const bf16* bp = Wg + (size_t)r16 * D + 8 * q4;
    f32x4 acc = (f32x4){0.f, 0.f, 0.f, 0.f};
#pragma unroll 8
    for (int kk = 0; kk < 64; ++kk) {
        const bf16x8 Af = __builtin_bit_cast(bf16x8, *(const v4u*)(ap + 32 * kk)), Bf = __builtin_bit_cast(bf16x8, *(const v4u*)(bp + 32 * kk));
        acc = __builtin_amdgcn_mfma_f32_16x16x32_bf16(Af, Bf, acc, 0, 0, 0);
    }
#pragma unroll
    for (int j = 0; j < 4; ++j) { const int token = 16 * tile + 4 * q4 + j; const float s = 1.0f / sqrtf(ss[token] * (1.0f / D) + EPS); GLR[(size_t)token * 16 + r16] = acc[j] * s; }
}

__global__ void __launch_bounds__(NTHREADS, 2) mk_fwd(Args args) {
    extern __shared__ __attribute__((aligned(16))) unsigned char lds_raw[];
    LAS unsigned char* lds = (LAS unsigned char*)lds_raw;
    const int tid = threadIdx.x, lane = tid & 63, wave = __builtin_amdgcn_readfirstlane(tid >> 6);
    const int G = gridDim.x, bx = blockIdx.x;
    unsigned char* ws = args.ws;
    unsigned* ctl = (unsigned*)(ws + WS_CTL);
    volatile LAS unsigned* MISC = (volatile LAS unsigned*)(lds + MISC_OFF);
    for (int u = tid; u < (LDS_BYTES - RING_BYTES) / 4; u += NTHREADS) ((LAS unsigned*)(lds + RING_BYTES))[u] = 0u;
    __syncthreads();
#if MK_PER_PHASE
#define GRID_BAR() do {} while (0)
#else
    XcdBarrier bar = xcd_barrier_post(ctl + CW_BAR, MISC + 8);
#define GRID_BAR() xcd_barrier(bar)
#endif
    const int lo = args.ph_lo, hi = args.ph_hi;
#if MK_STAMP
    if (bx == 0 && tid == 0) ((unsigned long long*)(ws + CTL_DBG))[32 + 20] = __builtin_amdgcn_s_memrealtime();
#endif
#define IN(k) (lo <= (k) && (k) < hi)
#if MK_STAMP
#define SEAM(k) do { if (IN((k) + 1)) GRID_BAR(); if (bx == 0 && tid == 0) ((unsigned long long*)(ws + CTL_DBG))[32 + (k)] = __builtin_amdgcn_s_memrealtime(); } while (0)
#else
#define SEAM(k) do { if (IN((k) + 1)) GRID_BAR(); } while (0)
#endif

    const float* x = args.in[I_X]; float* out = args.out;
    float* SS1 = (float*)(ws + CTL_SS1); float* SS2 = (float*)(ws + CTL_SS2); float* SS0 = (float*)(ws + CTL_SS0); float* SS3 = (float*)(ws + CTL_SS3);
    float* GLR = (float*)(ws + WS_GLR); float* ADEC = (float*)(ws + WS_ADEC);
    bf16* WGLR = (bf16*)(ws + WS_WGLR); bf16* KB = (bf16*)(ws + WS_KB); bf16* VTG = (bf16*)(ws + WS_VT); bf16* MEMB = (bf16*)(ws + WS_MEMB);
    bf16* WGU1 = (bf16*)(ws + WS_WGU1); bf16* WD1 = (bf16*)(ws + WS_WD1); bf16* WIN = (bf16*)(ws + WS_WIN); bf16* WKV = (bf16*)(ws + WS_WKV);
    bf16* WBR = (bf16*)(ws + WS_WB); bf16* WO = (bf16*)(ws + WS_WO); bf16* WGU2 = (bf16*)(ws + WS_WGU2); bf16* WD2 = (bf16*)(ws + WS_WD2);
    bf16* XB = (bf16*)(ws + WS_XB); bf16* ACT = (bf16*)(ws + WS_ACT);
    bf16* Qb = (bf16*)(ws + WS_Q); bf16* Kt = (bf16*)(ws + WS_K); bf16* Vb = (bf16*)(ws + WS_V); bf16* Rb = (bf16*)(ws + WS_R);
    bf16* SUb = (bf16*)(ws + WS_SU); bf16* SVb = (bf16*)(ws + WS_SV); bf16* XQb = (bf16*)(ws + WS_XQ);
    bf16* MRG = (bf16*)(ws + WS_MRG); bf16* GA = (bf16*)(ws + WS_WGU1); bf16* GB = (bf16*)(ws + WS_G); bf16* US = (bf16*)(ws + WS_G);
    const int gw = bx * NWAVES + wave, NGW = G * NWAVES;
    const ConvCtx cvx{args.in, WGU1, WGU2, WD1, WD2, WIN, WKV, WBR, WO};

    if (IN(0)) {
      for (int rep = 0; rep < (MK_DUP == 0 ? 2 : 1); ++rep) {
        for (int it = bx; it < CONV_EARLY; it += G) { ConvItem ci; f32x4 v[16]; conv_early(cvx, it, wave, ci); conv_issue(ci, v, lane); conv_finish(ci, v, lane); }
        for (int i = bx * NTHREADS + tid; i < 16 * D; i += G * NTHREADS) { const int r = i / D, k = i % D; WGLR[i] = f2bf(args.in[I_WIN][(size_t)k * INW + 3072 + r] * args.in[I_MIXN][k]); }
        for (int m = gw; m < M; m += NGW) row_to_bf16_ss(x + (size_t)m * D, XB + (size_t)m * D, SS0 + m, lane);
        for (int m = gw; m < MROWS; m += NGW) rms_row_to_bf16(args.in[I_MEM] + (size_t)m * D, args.in[I_MEMN], MEMB + (size_t)m * D, lane);
        __syncthreads();
      }
        SEAM(0);
    }
    if (IN(1)) {
        P1Sched S{(const char*)XB, (const char*)WGU1, (const char*)MEMB, (const char*)WKV, G, bx};
        EpiGU E{ACT, SS0, KB, VTG, &cvx, bx, G};
        pg8::gemm_phase<EpiGU, P1Sched, false, MK_ALIGN_T>(lds, D, D, D, S, E);
        if (bx >= 64) { for (int it = CONV_EPI + (bx - 64); it < CONV_LATE; it += G - 64) { ConvItem ci; f32x4 v[16]; conv_late(cvx, it, wave, ci); conv_issue(ci, v, lane); conv_finish(ci, v, lane); } }
        if (MK_DUP == 1) pg8::gemm_phase(lds, D, D, D, S, E);
        SEAM(1);
    }
    if (IN(2)) {
        GridSched S{(const char*)ACT, (const char*)WD1, (size_t)256 * DFF * 2, (size_t)256 * DFF * 2, 64, 8, G, bx};
        EpiRes E{XB, SS1, 0.5f};
        pg8::gemm_phase(lds, DFF, DFF, DFF, S, E);
        SEAM(2);
    }
    if (IN(3)) {
        GridSched S{(const char*)XB, (const char*)WIN, (size_t)256 * D * 2, (size_t)256 * D * 2, 64, 32, G, bx};
        EpiProj E{SS1, Qb, Kt, Vb, Rb, SUb, SVb, XQb, GA};
        pg8::gemm_phase<EpiProj, GridSched, false, MK_ALIGN_T>(lds, D, D, D, S, E);
        if (MK_DUP == 3) pg8::gemm_phase(lds, D, D, D, S, E);
        if (wave < 4) glr_tile(bx * 4 + wave, XB, WGLR, SS1, GLR, lane);
        SEAM(3);
    }
    if (IN(4)) {
        for (int i = 0; i < 4; ++i) gla_step1(lds, bx * 4 + i, Qb, Kt, Vb, GLR, args.in[I_GUP], args.in[I_GB], ADEC, US, wave, lane);
        for (int i = 0; i < 2; ++i) sg_unit(lds, bx * 2 + i, SUb, SVb, args.in[I_LNG], args.in[I_LNB], args.in[I_WS], args.in[I_BS], wave, lane);
        SEAM(4);
    }
    if (IN(5)) {
        gla_scan(US, ADEC, bx * NTHREADS + tid);
        xa_task(bx * 8 + wave, XQb, KB, VTG, lane);
        SEAM(5);
    }
    if (IN(6)) {
        for (int i = 0; i < 4; ++i) gla_step3(lds, bx * 4 + i, Qb, Kt, Vb, Rb, US, args.in[I_GON], wave, lane);
        SEAM(6);
    }
#pragma unroll
    for (int i = 0; i < 3; ++i) {
        if (IN(7 + i)) {
            bf16* Gcur = (i & 1) ? GB : GA; bf16* Gnxt = (i & 1) ? GA : GB;
            { const bf16* Y = i == 0 ? Vb : (i == 1 ? SUb : XQb);
              GridSched S{(const char*)Y, (const char*)(WBR + (size_t)i * D * 1024), (size_t)256 * 1024 * 2, (size_t)256 * 1024 * 2, 64, 8, G, bx};
              EpiMerge E{Gcur, MRG, i == 0};
              pg8::gemm_phase(lds, 1024, 1024, 1024, S, E); }
            if (i < 2) {
              GridSched S{(const char*)XB, (const char*)(WIN + (size_t)(NPROJ + (i + 1) * D) * D), (size_t)256 * D * 2, (size_t)256 * D * 2, 64, 8, G, bx};
              EpiGate E{SS1, Gnxt};
              pg8::gemm_phase<EpiGate, GridSched, false, MK_ALIGN_T>(lds, D, D, D, S, E); }
            SEAM(7 + i);
        }
    }
    if (IN(10)) {
        GridSched S{(const char*)MRG, (const char*)WO, (size_t)256 * D * 2, (size_t)256 * D * 2, 64, 8, G, bx};
        EpiRes E{XB, SS2, 1.0f};
        pg8::gemm_phase(lds, D, D, D, S, E);
        SEAM(10);
    }
    if (IN(11)) {
        GridSched S{(const char*)XB, (const char*)WGU2, (size_t)256 * D * 2, (size_t)256 * D * 2, 64, 44, G, bx};
        EpiGU E{ACT, SS2, nullptr, nullptr, nullptr, 0, 0};
#if MK_STAMP
        unsigned long long* stp = (unsigned long long*)(ws + CTL_DBG) + (bx == 37 ? 0 : 8);
        const unsigned long long c0 = __builtin_amdgcn_s_memtime(), r0 = __builtin_amdgcn_s_memrealtime();
        pg8::gemm_phase<EpiGU, GridSched, true>(lds, D, D, D, S, E, stp);
        const unsigned long long c1 = __builtin_amdgcn_s_memtime(), r1 = __builtin_amdgcn_s_memrealtime();
        if (tid == 0) { stp[3] = c1 - c0; stp[4] = r1 - r0; }
#else
        pg8::gemm_phase<EpiGU, GridSched, false, MK_ALIGN_T>(lds, D, D, D, S, E);
#endif
        if (MK_DUP == 14) pg8::gemm_phase(lds, D, D, D, S, E);
        SEAM(11);
    }
    if (IN(12)) {
        GridSched S{(const char*)ACT, (const char*)WD2, (size_t)256 * DFF * 2, (size_t)256 * DFF * 2, 64, 8, G, bx};
        EpiRes E{XB, SS3, 0.5f};
        pg8::gemm_phase(lds, DFF, DFF, DFF, S, E);
        SEAM(12);
    }
    if (IN(13)) {
        const float* fg = args.in[I_FN];
        for (int m = gw; m < M; m += NGW) {
            const GAS v4u* xr = (const GAS v4u*)(XB + (size_t)m * D) + lane; GAS f32x4* orow = (GAS f32x4*)(out + (size_t)m * D); const GAS f32x4* gr = (const GAS f32x4*)fg;
            const float rs = 1.0f / sqrtf(SS3[m] * (1.0f / D) + EPS);
#pragma unroll
            for (int j = 0; j < 4; ++j) { const v4u w = xr[64 * j]; const int c = (64 * j + lane) * 2; const f32x4 g0 = gr[c], g1 = gr[c + 1];
                orow[c] = (f32x4){bflo(w.x) * rs * g0.x, bfhi(w.x) * rs * g0.y, bflo(w.y) * rs * g0.z, bfhi(w.y) * rs * g0.w};
                orow[c + 1] = (f32x4){bflo(w.z) * rs * g1.x, bfhi(w.z) * rs * g1.y, bflo(w.w) * rs * g1.z, bfhi(w.w) * rs * g1.w}; }
        }
#if MK_STAMP
        { const unsigned long long* stp = (const unsigned long long*)(ws + CTL_DBG);
          const float kc = (float)stp[0], ec = (float)stp[1], nun = (float)stp[2], cyc = (float)stp[3], rt = (float)stp[4];
          float c = 0.f;
          if (MK_STAMP == 1) c = floorf(4.0f * log2f(cyc / rt * 100.0f)) - 36.0f;
          if (MK_STAMP == 2) c = floorf(12.0f * log2f(kc / (nun * 32.0f))) - 120.0f;
          if (MK_STAMP == 3) c = floorf(8.0f * log2f(ec / nun)) - 90.0f;
          if (MK_STAMP == 4) c = floorf(12.0f * log2f(cyc / nun)) - 180.0f;
          if (MK_STAMP == 5) { const float us = (float)(stp[32 + MK_STAMP_B] - stp[32 + MK_STAMP_A]) * 0.01f; c = floorf(12.0f * log2f(us)) - 50.0f; }
          __syncthreads();
          for (int m = gw; m < M; m += NGW) { GAS f32x4* xr = (GAS f32x4*)(out + (size_t)m * D) + lane;
#pragma unroll
              for (int j = 0; j < 8; ++j) xr[64 * j] = (f32x4){c, c, c, c}; } }
#endif
    }
#undef IN
#undef SEAM
}
constexpr int LAST_PHASE = 14;


#if MK_DEBUG
constexpr size_t WS_DBG = 548 * MiB;
constexpr size_t DBG_SAVE = WS_DBG;
constexpr size_t DBG_QREF = WS_DBG + 2 * MiB, DBG_KREF = WS_DBG + 3 * MiB, DBG_VREF = WS_DBG + 4 * MiB, DBG_OREF = WS_DBG + 6 * MiB, DBG_AREF = WS_DBG + 8 * MiB;
constexpr int NSAVE = 64;
__device__ __forceinline__ unsigned hsh(unsigned a) { a ^= a >> 16; a *= 0x7feb352dU; a ^= a >> 15; a *= 0x846ca68bU; a ^= a >> 16; return a; }
__device__ __forceinline__ int save_row(int i) { return (int)(hsh(1000u + i) % M); }
__device__ __forceinline__ float block_sum(float v) {
    __shared__ float red[4]; __shared__ float tot;
    v = wave_sum(v); __syncthreads(); if ((threadIdx.x & 63) == 0) red[threadIdx.x >> 6] = v; __syncthreads();
    if (threadIdx.x == 0) tot = (red[0] + red[1]) + (red[2] + red[3]); __syncthreads(); return tot;
}
__device__ __forceinline__ float block_max(float v) {
    __shared__ float redm[4]; __shared__ float totm;
#pragma unroll
    for (int o = 1; o < 64; o <<= 1) v = fmaxf(v, __shfl_xor(v, o));
    __syncthreads(); if ((threadIdx.x & 63) == 0) redm[threadIdx.x >> 6] = v; __syncthreads();
    if (threadIdx.x == 0) totm = fmaxf(fmaxf(redm[0], redm[1]), fmaxf(redm[2], redm[3])); __syncthreads(); return totm;
}
__device__ __forceinline__ void dbg_add(float* dbg, int id, float got, float exp) { const float d = got - exp; atomicAdd(dbg + 2 * id, d * d); atomicAdd(dbg + 2 * id + 1, exp * exp); }
__device__ __forceinline__ float bdot(const bf16* a, const float* w, int ldw, int K, const float* gain) {
    float s = 0.f; for (int k = threadIdx.x; k < K; k += 256) s += bf2f(a[k]) * w[(size_t)k * ldw] * (gain ? gain[k] : 1.0f); return block_sum(s);
}
__device__ __forceinline__ float geluf_(float v) { return 0.5f * v * (1.0f + erff(v * 0.70710678f)); }
__device__ __forceinline__ float rsof(const float* ss, int r) { return 1.0f / sqrtf(ss[r] * (1.0f / D) + EPS); }

__global__ void chk_wt(const bf16* WT, int ldk, int nrows, const float* src, const float* src2, int ldw, int mode, const float* gain, float* dbg, int id) {
    const unsigned i = blockIdx.x * 256 + threadIdx.x; const int n = hsh(i * 2 + 1) % nrows, k = hsh(i * 2 + 2) % ldk;
    const float* s = src; int col = n;
    if (mode == 1) { const int tile = n / 256, w = n % 256; s = w < 128 ? src : src2; col = 128 * tile + (w & 127); }
    if (mode == 2) col = n < 3072 ? n : n + 16;
    if (mode == 3) col = 3072 + n;
    dbg_add(dbg, id, bf2f(WT[(size_t)n * ldk + k]), s[(size_t)k * ldw + col] * (gain ? gain[k] : 1.0f));
}
__global__ void chk_rms(const float* x, const float* gain, const bf16* xb, int nrows, float* dbg, int id) {
    const int r = hsh(77u + blockIdx.x) % nrows; float s = 0.f;
    for (int k = threadIdx.x; k < D; k += 256) { const float v = x[(size_t)r * D + k]; s += v * v; }
    const float rs = 1.0f / sqrtf(block_sum(s) * (1.0f / D) + EPS);
    for (int k = threadIdx.x; k < D; k += 256) dbg_add(dbg, id, bf2f(xb[(size_t)r * D + k]), x[(size_t)r * D + k] * rs * gain[k]);
}
__global__ void chk_act(const bf16* XBp, const float* wg, const float* wu, const float* gain, const float* ss, const bf16* ACTp, float* dbg, int id) {
    const int row = hsh(3u * blockIdx.x + 11u) % M, hid = hsh(3u * blockIdx.x + 12u) % DFF;
    float g = bdot(XBp + (size_t)row * D, wg + hid, DFF, D, gain), u = bdot(XBp + (size_t)row * D, wu + hid, DFF, D, gain);
    if (ss) { const float s = rsof(ss, row); g *= s; u *= s; }
    if (threadIdx.x == 0) dbg_add(dbg, id, bf2f(ACTp[(size_t)row * DFF + hid]), g / (1.0f + expf(-g)) * u);
}
__global__ void chk_kv(const bf16* MEMBp, const float* wkv, const bf16* KBp, const bf16* VTp, float* dbg, int idk, int idv) {
    const int row = hsh(5u * blockIdx.x + 1u) % MROWS, col = hsh(5u * blockIdx.x + 2u) % 2048;
    const float v = bdot(MEMBp + (size_t)row * D, wkv + col, D, D, nullptr);
    if (threadIdx.x == 0) { if (col < 1024) dbg_add(dbg, idk, bf2f(KBp[(size_t)row * 1024 + col]), v); else dbg_add(dbg, idv, bf2f(VTp[(size_t)(col - 1024) * 2048 + row]), v); }
}
__global__ void save_rows(const float* src, float* dst) { const int r = save_row(blockIdx.x); for (int k = threadIdx.x; k < D; k += 256) dst[(size_t)blockIdx.x * D + k] = src[(size_t)r * D + k]; }
__global__ void chk_res(const float* base, int base_saved, const bf16* a, int K, const float* w, float alpha, const float* outp, const bf16* xb, float* dbg, int id, int idb) {
    const int si = blockIdx.x % NSAVE, row = save_row(si), col = hsh(7u * blockIdx.x + 3u) % D;
    const float b = base_saved ? base[(size_t)si * D + col] : base[(size_t)row * D + col];
    const float v = b + alpha * bdot(a + (size_t)row * K, w + col, D, K, nullptr);
    if (threadIdx.x == 0) { dbg_add(dbg, id, outp[(size_t)row * D + col], v); if (xb) dbg_add(dbg, idb, bf2f(xb[(size_t)row * D + col]), v); }
}
__global__ void chk_ss(const float* outp, const float* ss, float* dbg, int id) {
    const int row = hsh(91u + blockIdx.x) % M; float s = 0.f;
    for (int k = threadIdx.x; k < D; k += 256) { const float v = outp[(size_t)row * D + k]; s += v * v; }
    s = block_sum(s); if (threadIdx.x == 0) dbg_add(dbg, id, ss[row], s);
}
__global__ void chk_proj(const bf16* XBp, const float* win, const float* mixn, const float* ss, const unsigned char* ws, float* dbg, int id, int idg) {
    const int row = hsh(9u * blockIdx.x + 1u) % M, j = hsh(9u * blockIdx.x + 2u) % (NPROJ + 16);
    const int srccol = j < 3072 ? j : (j < NPROJ ? j + 16 : 3072 + (j - NPROJ));
    float v = rsof(ss, row) * bdot(XBp + (size_t)row * D, win + srccol, INW, D, mixn);
    if (threadIdx.x != 0) return;
    if (j >= NPROJ) { dbg_add(dbg, idg, ((const float*)(ws + WS_GLR))[(size_t)row * 16 + (j - NPROJ)], v); return; }
    float got;
    if (j < 512) got = bf2f(((const bf16*)(ws + WS_Q))[(size_t)row * 512 + j]);
    else if (j < 1024) got = bf2f(((const bf16*)(ws + WS_K))[(size_t)row * 512 + j - 512]);
    else if (j < 2048) got = bf2f(((const bf16*)(ws + WS_V))[(size_t)row * 1024 + j - 1024]);
    else if (j < 3072) got = bf2f(((const bf16*)(ws + WS_R))[(size_t)row * 1024 + j - 2048]);
    else if (j < 4096) { got = bf2f(((const bf16*)(ws + WS_SU))[(size_t)row * 1024 + j - 3072]); v = geluf_(v); }
    else if (j < 5120) { got = bf2f(((const bf16*)(ws + WS_SV))[(size_t)row * 1024 + j - 4096]); v = geluf_(v); }
    else got = bf2f(((const bf16*)(ws + WS_XQ))[(size_t)row * 1024 + j - 5120]);
    dbg_add(dbg, id, got, v);
}
__global__ void chk_sg(const bf16* XBp, const float* win, const float* mixn, const float* ss, const bf16* SVp, const bf16* Ysg, const float* lng, const float* lnb, const float* wsp, const float* bsp, float* dbg, int id) {
    const int tok = hsh(13u * blockIdx.x + 1u) % M, g = hsh(13u * blockIdx.x + 2u) % 4, c = hsh(13u * blockIdx.x + 3u) % 256;
    const int t = tok % 128, tok0 = tok - t;
    const float su = geluf_(rsof(ss, tok) * bdot(XBp + (size_t)tok * D, win + 3088 + g * 256 + c, INW, D, mixn));
    float part = 0.f;
    if (threadIdx.x <= t && threadIdx.x < 128) { const int s = threadIdx.x; const bf16* p = SVp + (size_t)(tok0 + s) * 1024 + g * 256; float s1 = 0.f, s2 = 0.f;
        for (int k = 0; k < 256; ++k) { const float v = bf2f(p[k]); s1 += v; s2 += v * v; }
        const float mu = s1 / 256.0f, var = fmaxf(s2 / 256.0f - mu * mu, 0.f);
        const float vn = (bf2f(p[c]) - mu) / sqrtf(var + EPS) * lng[g * 256 + c] + lnb[g * 256 + c];
        part = wsp[((size_t)g * 128 + t) * 128 + s] * vn; }
    const float acc = block_sum(part);
    if (threadIdx.x == 0) dbg_add(dbg, id, bf2f(Ysg[(size_t)tok * 1024 + g * 256 + c]), su * (acc + bsp[g * 128 + t]));
}
__global__ void chk_xa(const bf16* XBp, const float* win, const float* mixn, const float* ss, const bf16* KBp, const bf16* VTp, const bf16* Yxa, float* dbg, int id) {
    __shared__ float qsh[256];
    const int tok = hsh(17u * blockIdx.x + 1u) % M, h = hsh(17u * blockIdx.x + 2u) % 4, e = hsh(17u * blockIdx.x + 3u) % 256, b = tok / SEQ;
    { const int d = threadIdx.x; float s = 0.f; const bf16* a = XBp + (size_t)tok * D; const float* w = win + 5136 + h * 256 + d;
      for (int k = 0; k < D; ++k) s += bf2f(a[k]) * w[(size_t)k * INW] * mixn[k];
      qsh[d] = s * rsof(ss, tok); }
    __syncthreads();
    const int m = threadIdx.x; float sc = 0.f; const bf16* kp = KBp + (size_t)(b * 256 + m) * 1024 + h * 256;
    for (int d = 0; d < 256; ++d) sc += qsh[d] * bf2f(kp[d]);
    sc *= 0.0625f;
    const float mx = block_max(sc), p = expf(sc - mx), sum = block_sum(p);
    const float o = block_sum(p * bf2f(VTp[(size_t)(h * 256 + e) * 2048 + b * 256 + m])) / sum;
    if (threadIdx.x == 0) dbg_add(dbg, id, bf2f(Yxa[(size_t)tok * 1024 + h * 256 + e]), o);
}
__global__ void gla_refA(const bf16* XBp, const float* win, const float* mixn, const float* ss, const float* GLRp, const float* wup, const float* gbias, int b, int h, float* qref, float* kref, float* vref, float* aref) {
    const int t = blockIdx.x, tok = b * SEQ + t; const bf16* a = XBp + (size_t)tok * D; const float rs = rsof(ss, tok);
    for (int o = threadIdx.x; o < 512; o += 256) {
        const int srccol = o < 128 ? h * 128 + o : (o < 256 ? 512 + h * 128 + (o - 128) : 1024 + h * 256 + (o - 256));
        float s = 0.f; const float* w = win + srccol; for (int k = 0; k < D; ++k) s += bf2f(a[k]) * w[(size_t)k * INW] * mixn[k];
        s *= rs; if (o < 128) qref[t * 128 + o] = s; else if (o < 256) kref[t * 128 + o - 128] = s; else vref[t * 256 + o - 256] = s;
    }
    if (threadIdx.x < 128) { const int d = threadIdx.x; float z = gbias[h * 128 + d]; for (int r = 0; r < 16; ++r) z += GLRp[(size_t)tok * 16 + r] * wup[r * 512 + h * 128 + d];
        const float ls = fminf(z, 0.f) - log1pf(expf(-fabsf(z))); aref[t * 128 + d] = expf(ls / 16.0f); }
}
__global__ void gla_refB(const float* qref, const float* kref, const float* vref, const float* aref, float* oref) {
    const int e = blockIdx.x, d = threadIdx.x & 127; const bool act = threadIdx.x < 128; float S = 0.f;
    for (int t = 0; t < SEQ; ++t) { float p = 0.f; if (act) { S = aref[t * 128 + d] * S + kref[t * 128 + d] * vref[t * 256 + e]; p = qref[t * 128 + d] * GLA_SCALE * S; }
        const float o = block_sum(p); if (threadIdx.x == 0) oref[t * 256 + e] = o; }
}
__global__ void gla_refC(const float* oref, const bf16* Rp, const bf16* Ygla, const float* onorm, int b, int h, float* dbg, int id) {
    const int t = blockIdx.x, e = threadIdx.x, tok = b * SEQ + t; const float o = oref[t * 256 + e];
    const float rs = 1.0f / sqrtf(block_sum(o * o) / 256.0f + EPS); const float r = bf2f(Rp[(size_t)tok * 1024 + h * 256 + e]);
    dbg_add(dbg, id, bf2f(Ygla[(size_t)tok * 1024 + h * 256 + e]), o * rs * onorm[h * 256 + e] * (r / (1.0f + expf(-r))));
}
__global__ void chk_gate(const bf16* XBp, const float* win, const float* mixn, const float* ss, const bf16* GTp, int i, float* dbg, int id) {
    const int row = hsh(19u * blockIdx.x + 1u) % M, col = hsh(19u * blockIdx.x + 2u) % D;
    const float v = rsof(ss, row) * bdot(XBp + (size_t)row * D, win + 6160 + i * D + col, INW, D, mixn);
    if (threadIdx.x == 0) dbg_add(dbg, id, bf2f(GTp[(size_t)row * D + col]), 1.0f / (1.0f + expf(-v)));
}
__global__ void chk_mrg(const bf16* XBp, const float* win, const float* mixn, const float* ss, const bf16* Y0, const bf16* Y1, const bf16* Y2, const float* wbr, const bf16* MRGp, float* dbg, int id) {
    const int row = hsh(23u * blockIdx.x + 1u) % M, col = hsh(23u * blockIdx.x + 2u) % D; float tot = 0.f;
    for (int i = 0; i < 3; ++i) { const float gp = rsof(ss, row) * bdot(XBp + (size_t)row * D, win + 6160 + i * D + col, INW, D, mixn);
        const bf16* Y = i == 0 ? Y0 : (i == 1 ? Y1 : Y2); const float z = bdot(Y + (size_t)row * 1024, wbr + (size_t)i * 1024 * D + col, D, 1024, nullptr);
        tot += z / (1.0f + expf(-gp)); }
    if (threadIdx.x == 0) dbg_add(dbg, id, bf2f(MRGp[(size_t)row * D + col]), tot);
}
__global__ void chk_final(const float* saved, const float* fn, const float* outp, float* dbg, int id) {
    const int si = blockIdx.x, row = save_row(si); float s = 0.f;
    for (int k = threadIdx.x; k < D; k += 256) { const float v = saved[(size_t)si * D + k]; s += v * v; }
    const float rs = 1.0f / sqrtf(block_sum(s) * (1.0f / D) + EPS);
    for (int k = threadIdx.x; k < D; k += 256) dbg_add(dbg, id, outp[(size_t)row * D + k], saved[(size_t)si * D + k] * rs * fn[k]);
}
__global__ void dbg_report(const float* dbg, float* outp, int nchk, int only) {
    int bad = -1;
    for (int k = 0; k < nchk; ++k) { const float num = dbg[2 * k], den = dbg[2 * k + 1]; if (num == 0.f && den == 0.f) continue; if (!(num < 1e-3f * den)) { bad = k; break; } }
    if (only >= 0) { const float num = dbg[2 * only], den = dbg[2 * only + 1]; bad = -1; if (!(num < 1e-3f * den)) bad = only; }
    if (bad < 0) return;
    const float c = (float)(bad + 2);
    for (size_t i = (size_t)blockIdx.x * 256 + threadIdx.x; i < (size_t)M * D; i += (size_t)gridDim.x * 256) outp[i] = c;
}
#endif

extern "C" void kernel_launch(void* const* d_in, const int* in_sizes, int n_in, void* d_out, int out_size, void* d_ws, size_t ws_size, hipStream_t stream) {
    static int grid = 0;
    if (grid == 0) {
        if (n_in != N_IN || in_sizes[0] != M * D || out_size != M * D || ws_size < WS_END) {
            fprintf(stderr, "kernel_launch: unexpected problem (n_in %d, in0 %d, out %d, ws %zu, need %zu); nothing launched\n", n_in, n_in > 0 ? in_sizes[0] : -1, out_size, ws_size, (size_t)WS_END); grid = -1; return; }
        int dev = 0, cus = 0, per_cu = 0;
        if (hipGetDevice(&dev) != hipSuccess || hipDeviceGetAttribute(&cus, hipDeviceAttributeMultiprocessorCount, dev) != hipSuccess) { grid = -1; return; }
        if (hipFuncSetAttribute((const void*)mk_fwd, hipFuncAttributeMaxDynamicSharedMemorySize, LDS_BYTES) != hipSuccess) { fprintf(stderr, "kernel_launch: hipFuncSetAttribute failed\n"); grid = -1; return; }
        if (hipOccupancyMaxActiveBlocksPerMultiprocessor(&per_cu, (const void*)mk_fwd, NTHREADS, LDS_BYTES) != hipSuccess || per_cu < 1)
            fprintf(stderr, "kernel_launch: note: occupancy query reports %d workgroups per CU\n", per_cu);
        (void)hipGetLastError();
        if (cus < 256) { fprintf(stderr, "kernel_launch: %d CUs; this kernel needs 256 resident workgroups (one per CU); nothing launched\n", cus); grid = -1; return; }
        grid = 256;
    }
    if (grid < 0) return;
    if (hipMemsetAsync((char*)d_ws + WS_CTL, 0, CTL_ZERO_BYTES, stream) != hipSuccess) return;
    Args a{};
    for (int i = 0; i < N_IN; ++i) a.in[i] = (const float*)d_in[i];
    a.out = (float*)d_out; a.ws = (unsigned char*)d_ws;
#if MK_PER_PHASE
    for (int p = 0; p < LAST_PHASE; ++p) { a.ph_lo = p; a.ph_hi = p + 1; hipLaunchKernelGGL(mk_fwd, dim3(grid), dim3(NTHREADS), LDS_BYTES, stream, a);
#if MK_DEBUG
        unsigned char* ws = (unsigned char*)d_ws; float* dbg = (float*)(ws + CTL_DBG); const float** in = (const float**)a.in; float* outp = (float*)d_out;
        const bf16* XBp = (const bf16*)(ws + WS_XB); const float* SS1p = (const float*)(ws + CTL_SS1); const float* SS2p = (const float*)(ws + CTL_SS2);
        float* sv1 = (float*)(ws + DBG_SAVE); float* sv2 = sv1 + NSAVE * D; float* sv3 = sv2 + NSAVE * D;
        if (p == 0) {
            chk_rms<<<64, 256, 0, stream>>>(in[I_X], in[I_F1N], XBp, M, dbg, 0);
            chk_wt<<<64, 256, 0, stream>>>((const bf16*)(ws + WS_WGU1), D, NGU, in[I_F1G], in[I_F1U], DFF, 1, nullptr, dbg, 1);
            chk_wt<<<64, 256, 0, stream>>>((const bf16*)(ws + WS_WIN), D, 12288, in[I_WIN], nullptr, INW, 2, in[I_MIXN], dbg, 2);
            chk_wt<<<64, 256, 0, stream>>>((const bf16*)(ws + WS_WD1), DFF, D, in[I_F1D], nullptr, D, 0, nullptr, dbg, 3);
            chk_wt<<<64, 256, 0, stream>>>((const bf16*)(ws + WS_WKV), D, D, in[I_WKV], nullptr, D, 0, nullptr, dbg, 4);
            for (int i = 0; i < 3; ++i) chk_wt<<<32, 256, 0, stream>>>((const bf16*)(ws + WS_WB) + (size_t)i * D * 1024, 1024, D, in[I_WBR] + (size_t)i * 1024 * D, nullptr, D, 0, nullptr, dbg, 5);
            chk_wt<<<64, 256, 0, stream>>>((const bf16*)(ws + WS_WO), D, D, in[I_WOUT], nullptr, D, 0, nullptr, dbg, 6);
            chk_wt<<<64, 256, 0, stream>>>((const bf16*)(ws + WS_WGU2), D, NGU, in[I_F2G], in[I_F2U], DFF, 1, in[I_F2N], dbg, 7);
            chk_wt<<<64, 256, 0, stream>>>((const bf16*)(ws + WS_WD2), DFF, D, in[I_F2D], nullptr, D, 0, nullptr, dbg, 8);
            chk_rms<<<64, 256, 0, stream>>>(in[I_MEM], in[I_MEMN], (const bf16*)(ws + WS_MEMB), MROWS, dbg, 9);
            chk_wt<<<16, 256, 0, stream>>>((const bf16*)(ws + WS_WGLR), D, 16, in[I_WIN], nullptr, INW, 3, in[I_MIXN], dbg, 10);
        }
        if (p == 1) { chk_act<<<512, 256, 0, stream>>>(XBp, in[I_F1G], in[I_F1U], nullptr, nullptr, (const bf16*)(ws + WS_ACT), dbg, 11);
            chk_kv<<<512, 256, 0, stream>>>((const bf16*)(ws + WS_MEMB), in[I_WKV], (const bf16*)(ws + WS_KB), (const bf16*)(ws + WS_VT), dbg, 12, 13); }
        if (p == 2) { chk_res<<<512, 256, 0, stream>>>(in[I_X], 0, (const bf16*)(ws + WS_ACT), DFF, in[I_F1D], 0.5f, outp, XBp, dbg, 14, 15);
            chk_ss<<<64, 256, 0, stream>>>(outp, SS1p, dbg, 16); save_rows<<<NSAVE, 256, 0, stream>>>(outp, sv1); }
        if (p == 3) chk_proj<<<1024, 256, 0, stream>>>(XBp, in[I_WIN], in[I_MIXN], SS1p, ws, dbg, 17, 18);
        if (p == 6) {
            chk_sg<<<256, 256, 0, stream>>>(XBp, in[I_WIN], in[I_MIXN], SS1p, (const bf16*)(ws + WS_SV), (const bf16*)(ws + WS_SU), in[I_LNG], in[I_LNB], in[I_WS], in[I_BS], dbg, 19);
            chk_xa<<<256, 256, 0, stream>>>(XBp, in[I_WIN], in[I_MIXN], SS1p, (const bf16*)(ws + WS_KB), (const bf16*)(ws + WS_VT), (const bf16*)(ws + WS_XQ), dbg, 20);
            const int gb = 3, gh = 2; float* qr = (float*)(ws + DBG_QREF); float* kr = (float*)(ws + DBG_KREF); float* vr = (float*)(ws + DBG_VREF); float* orf = (float*)(ws + DBG_OREF); float* ar = (float*)(ws + DBG_AREF);
            gla_refA<<<SEQ, 256, 0, stream>>>(XBp, in[I_WIN], in[I_MIXN], SS1p, (const float*)(ws + WS_GLR), in[I_GUP], in[I_GB], gb, gh, qr, kr, vr, ar);
            gla_refB<<<256, 256, 0, stream>>>(qr, kr, vr, ar, orf);
            gla_refC<<<SEQ, 256, 0, stream>>>(orf, (const bf16*)(ws + WS_R), (const bf16*)(ws + WS_V), in[I_GON], gb, gh, dbg, 21);
        }
        if (p == 7 || p == 9 || p == 11) chk_gate<<<256, 256, 0, stream>>>(XBp, in[I_WIN], in[I_MIXN], SS1p, (const bf16*)(ws + WS_G), (p - 7) / 2, dbg, 22 + (p - 7) / 2);
        if (p == 12) chk_mrg<<<256, 256, 0, stream>>>(XBp, in[I_WIN], in[I_MIXN], SS1p, (const bf16*)(ws + WS_V), (const bf16*)(ws + WS_SU), (const bf16*)(ws + WS_XQ), in[I_WBR], (const bf16*)(ws + WS_MRG), dbg, 25);
        if (p == 13) { chk_res<<<512, 256, 0, stream>>>(sv1, 1, (const bf16*)(ws + WS_MRG), D, in[I_WOUT], 1.0f, outp, XBp, dbg, 26, 27);
            chk_ss<<<64, 256, 0, stream>>>(outp, SS2p, dbg, 28); save_rows<<<NSAVE, 256, 0, stream>>>(outp, sv2); }
        if (p == 14) chk_act<<<512, 256, 0, stream>>>(XBp, in[I_F2G], in[I_F2U], in[I_F2N], SS2p, (const bf16*)(ws + WS_ACT), dbg, 29);
        if (p == 15) { chk_res<<<512, 256, 0, stream>>>(sv2, 1, (const bf16*)(ws + WS_ACT), DFF, in[I_F2D], 0.5f, outp, nullptr, dbg, 30, 30); save_rows<<<NSAVE, 256, 0, stream>>>(outp, sv3); }
        if (p == 16) { chk_final<<<NSAVE, 256, 0, stream>>>(sv3, in[I_FN], outp, dbg, 31); dbg_report<<<1024, 256, 0, stream>>>(dbg, outp, 32, MK_DEBUG_ONLY); }
#endif
    }
#else
    a.ph_lo = 0; a.ph_hi = LAST_PHASE;
    hipLaunchKernelGGL(mk_fwd, dim3(grid), dim3(NTHREADS), LDS_BYTES, stream, a);
#endif
}
```

```cpp
#include <hip/hip_runtime.h>
#include <cstdio>
#include <cstdint>

#ifndef MK_PER_PHASE
#define MK_PER_PHASE 0
#endif
#ifndef MK_DEBUG
#define MK_DEBUG 0
#endif
#ifndef MK_STAMP
#define MK_STAMP 0
#endif
#ifndef MK_STAMP_A
#define MK_STAMP_A 20
#endif
#ifndef MK_STAMP_B
#define MK_STAMP_B 0
#endif
#ifndef MK_DUP
#define MK_DUP (-1)
#endif
#ifndef MK_DEBUG_ONLY
#define MK_DEBUG_ONLY (-1)
#endif

#define GAS __attribute__((address_space(1)))
#define LAS __attribute__((address_space(3)))
typedef unsigned short bf16;
typedef unsigned v4u __attribute__((ext_vector_type(4)));
typedef unsigned v2u __attribute__((ext_vector_type(2)));
typedef float f32x4 __attribute__((ext_vector_type(4)));
typedef float f32x2 __attribute__((ext_vector_type(2)));
typedef float f32x16 __attribute__((ext_vector_type(16)));
typedef short bf16x8 __attribute__((ext_vector_type(8)));
typedef __bf16 bf16x2_t __attribute__((ext_vector_type(2)));
typedef int v8i __attribute__((ext_vector_type(8)));
typedef int v4i __attribute__((ext_vector_type(4)));

constexpr int D = 2048, BATCH = 8, SEQ = 2048, M = BATCH * SEQ, MEMLEN = 256, MROWS = BATCH * MEMLEN;
constexpr int DFF = 5632, NGU = 2 * DFF;
constexpr int INW = 12304;
constexpr int NPROJ = 6144;
constexpr float EPS = 1e-6f;
constexpr int NWAVES = 8, NTHREADS = 512;

constexpr size_t MiB = 1u << 20;
constexpr size_t WS_CTL = 0, CTL_ZERO_BYTES = 1 * MiB;
constexpr size_t WS_GLR = 1 * MiB;
constexpr size_t WS_ADEC = 2 * MiB;
constexpr size_t WS_WGLR = 2 * MiB + 512 * 1024;
constexpr size_t WS_KB = 3 * MiB;
constexpr size_t WS_VT = 7 * MiB;
constexpr size_t WS_MEMB = 11 * MiB;
constexpr size_t WS_WGU1 = 20 * MiB;
constexpr size_t WS_WD1 = 64 * MiB;
constexpr size_t WS_WIN = 86 * MiB;
constexpr size_t WS_WKV = 134 * MiB;
constexpr size_t WS_WB = 142 * MiB;
constexpr size_t WS_WO = 154 * MiB;
constexpr size_t WS_WGU2 = 162 * MiB;
constexpr size_t WS_WD2 = 206 * MiB;
constexpr size_t WS_XB = 228 * MiB;
constexpr size_t WS_C = 292 * MiB;
constexpr size_t WS_ACT = WS_C;
constexpr size_t WS_Q = WS_C;
constexpr size_t WS_K = WS_C + 16 * MiB;
constexpr size_t WS_V = WS_C + 32 * MiB;
constexpr size_t WS_SU = WS_C + 64 * MiB;
constexpr size_t WS_XQ = WS_C + 96 * MiB;
constexpr size_t WS_R = WS_C + 128 * MiB;
constexpr size_t WS_SV = WS_C + 160 * MiB;
constexpr size_t WS_MRG = WS_R;
constexpr size_t WS_G = WS_C + 192 * MiB;
constexpr size_t WS_END = WS_C + 256 * MiB;

constexpr int CW_TMO = 0;
constexpr int CW_BAR = 4096;
constexpr size_t CTL_SS1 = 128 * 1024, CTL_SS2 = 192 * 1024, CTL_SS0 = 320 * 1024, CTL_SS3 = 384 * 1024;
constexpr size_t CTL_DBG = 256 * 1024;

constexpr int RING_BYTES = 131072;
constexpr int MISC_OFF = RING_BYTES + 320;
constexpr int LDS_BYTES = 147456;

#define LDS_WAIT() asm volatile("s_waitcnt lgkmcnt(0)" ::: "memory")
#define VM_WAIT() asm volatile("s_waitcnt vmcnt(0)" ::: "memory")
__device__ __forceinline__ unsigned cvtpk(float lo, float hi) { f32x2 v = {lo, hi}; bf16x2_t b = __builtin_convertvector(v, bf16x2_t); return __builtin_bit_cast(unsigned, b); }
__device__ __forceinline__ int lane_now() { int l; asm volatile("v_mbcnt_lo_u32_b32 %0, -1, 0\n\tv_mbcnt_hi_u32_b32 %0, -1, %0" : "=v"(l)); return l; }
__device__ __forceinline__ unsigned cvt4_fp8(float a, float b, float c, float d) { int w = 0; w = __builtin_amdgcn_cvt_pk_fp8_f32(a, b, w, false); w = __builtin_amdgcn_cvt_pk_fp8_f32(c, d, w, true); return (unsigned)w; }
__device__ __forceinline__ float bflo(unsigned u) { return __builtin_bit_cast(float, u << 16); }
__device__ __forceinline__ float bfhi(unsigned u) { return __builtin_bit_cast(float, u & 0xffff0000u); }
__device__ __forceinline__ float bf2f(bf16 b) { return __builtin_bit_cast(float, (unsigned)b << 16); }
__device__ __forceinline__ bf16 f2bf(float f) { return (bf16)(cvtpk(f, 0.f) & 0xffffu); }
__device__ __forceinline__ float wave_sum(float v) {
#pragma unroll
    for (int o = 1; o < 64; o <<= 1) v += __shfl_xor(v, o);
    return v;
}
__device__ __forceinline__ float fast_exp(float x) { return __builtin_amdgcn_exp2f(x * 1.4426950408889634f); }
__device__ __forceinline__ float sigmoidf_(float x) { return __builtin_amdgcn_rcpf(1.0f + fast_exp(-x)); }

namespace pg8 {
constexpr int BM = 256, BK = 64, HALF = 128, HTB = HALF * BK * 2, STAGE_BYTES = 8 * HTB, NXCD = 8, WGM = 8;
__host__ __device__ __forceinline__ int lds_byte(int r, int c) { const int st = (r >> 4) * 2 + (c >> 5), rr = r & 15, cc = c & 31, ob = rr * 64 + cc * 2; return st * 1024 + (ob ^ (((ob >> 9) & 1) << 5)); }
__host__ __device__ __forceinline__ void stage_rc(int b, int& R, int& C) { const int st = b / 1024, sb = b % 1024, swz = sb ^ (((sb >> 9) & 1) << 5); R = (st >> 1) * 16 + swz / 64; C = (st & 1) * 32 + (swz % 64) / 2; }
__host__ __device__ __forceinline__ int perm32(int rho) { const int n = rho >> 4, i = rho & 15; return 8 * (i >> 2) + 4 * n + (i & 3); }

struct Unit { unsigned A, B; int pm, pn, kind, seq; };

__device__ __forceinline__ void tile_of(int L, int nM, int nN, int& pm, int& pn) {
    const int nwg = nM * nN;
    int wgid = L; { const int q = nwg / NXCD, r = nwg % NXCD, xcd = wgid % NXCD, off = wgid / NXCD; wgid = (xcd < r ? xcd * (q + 1) : r * (q + 1) + (xcd - r) * q) + off; }
    const int nig = WGM * nN, gid = wgid / nig, fm = gid * WGM, gsz = (nM - fm) < WGM ? (nM - fm) : WGM;
    pm = fm + ((wgid % nig) % gsz); pn = (wgid % nig) / gsz;
}

template <class Epi, class Sched, bool STAMP = false, bool FP8 = false>
__device__ __forceinline__ void gemm_phase(LAS unsigned char* lds, const void* base, const int wid, const int K, const int lda, const int ldb, const Sched& S, const Epi& E, unsigned long long* st = nullptr) {
    const __amdgpu_buffer_rsrc_t rsrc = __builtin_amdgcn_make_buffer_rsrc((void*)base, 0, 0x7fffffff, 0x00020000);
    unsigned long long kc = 0, ec = 0, t0 = 0; unsigned nun = 0;
    int tid = wid * 64 + lane_now();
    const int lane = tid & 63, wr = wid >> 2, wc = wid & 3, fr = lane & 15, fq = lane >> 4;
    const int nt = K / BK;
    unsigned voffA[2], voffB[2];
#pragma unroll
    for (int i = 0; i < 2; ++i) { int R, C; stage_rc(tid * 16 + i * 8192, R, C); const int Rb = (R & ~31) + perm32(R & 31);
        voffA[i] = (unsigned)(R * lda + C) * 2u; voffB[i] = (unsigned)(Rb * ldb + C) * 2u; }
    const unsigned kstep = (unsigned)(BK * 2);
    const unsigned hstepA = (unsigned)HALF * lda * 2u, hstepB = (unsigned)HALF * ldb * 2u;
    const unsigned ldsw = (unsigned)wid * 1024u;
    const int aoff = lds_byte(wr * 64 + fr, fq * 8), boff = lds_byte(wc * 32 + fr, fq * 8);
#define PG8_SA(b, h) (((b) * 2 + (h)) * HTB)
#define PG8_SB(b, h) ((4 + (b) * 2 + (h)) * HTB)
#define PG8_STAGE(bufoff, soff, voff) do { _Pragma("unroll") for (int _i = 0; _i < 2; ++_i) \
        __builtin_amdgcn_raw_ptr_buffer_load_lds(rsrc, (LAS void*)(lds + (bufoff) + ldsw + _i * 8192), 16, (int)(voff)[_i], (int)(soff), 0, 0); } while (0)
#define PG8_LDA(dst, b, h) do { _Pragma("unroll") for (int m = 0; m < 4; ++m) _Pragma("unroll") for (int k = 0; k < 2; ++k) dst[m][k] = *(const LAS bf16x8*)(lds + PG8_SA(b, h) + aoff + m * 2048 + k * 1024); } while (0)
#define PG8_LDB(dst, b, h) do { _Pragma("unroll") for (int n = 0; n < 2; ++n) _Pragma("unroll") for (int k = 0; k < 2; ++k) dst[n][k] = *(const LAS bf16x8*)(lds + PG8_SB(b, h) + boff + n * 2048 + k * 1024); } while (0)
#define PG8_MMA(ai, bj, At, Bt) do { __builtin_amdgcn_s_setprio(1); _Pragma("unroll") for (int m = 0; m < 4; ++m) _Pragma("unroll") for (int n = 0; n < 2; ++n) { \
        if constexpr (FP8) { const v8i fb = __builtin_shufflevector(__builtin_bit_cast(v4i, Bt[n][0]), __builtin_bit_cast(v4i, Bt[n][1]), 0, 1, 2, 3, 4, 5, 6, 7), \
                                      fa = __builtin_shufflevector(__builtin_bit_cast(v4i, At[m][0]), __builtin_bit_cast(v4i, At[m][1]), 0, 1, 2, 3, 4, 5, 6, 7); \
            acc[ai][bj][m][n] = __builtin_amdgcn_mfma_scale_f32_16x16x128_f8f6f4(fb, fa, acc[ai][bj][m][n], 0, 0, 0, 0, 0, 0); }     \
        else { _Pragma("unroll") for (int k = 0; k < 2; ++k) acc[ai][bj][m][n] = __builtin_amdgcn_mfma_f32_16x16x32_bf16(Bt[n][k], At[m][k], acc[ai][bj][m][n], 0, 0, 0); } } \
        __builtin_amdgcn_s_setprio(0); } while (0)
#define PG8_WAIT_V(n) asm volatile("s_waitcnt vmcnt(" #n ")" ::: "memory")
#define PG8_WAIT_L(n) asm volatile("s_waitcnt lgkmcnt(" #n ")" ::: "memory")
#define PG8_BAR __builtin_amdgcn_s_barrier()
#define PG8_SCHED __builtin_amdgcn_sched_barrier(0)
    Unit cur, nxt; int ui = 0;
    if (!S.next(0, cur)) return;
    f32x4 acc[2][2][4][2];
#pragma unroll
    for (int a = 0; a < 2; ++a)
#pragma unroll
        for (int b = 0; b < 2; ++b)
#pragma unroll
            for (int m = 0; m < 4; ++m)
#pragma unroll
                for (int n = 0; n < 2; ++n) acc[a][b][m][n] = (f32x4){0.f, 0.f, 0.f, 0.f};
    bf16x8 At[4][2], B0[2][2], B1[2][2];
    unsigned cA = cur.A, cB = cur.B;
    PG8_STAGE(PG8_SB(0, 0), cB, voffB); PG8_STAGE(PG8_SB(0, 1), cB + hstepB, voffB); PG8_STAGE(PG8_SA(0, 0), cA, voffA); PG8_STAGE(PG8_SA(0, 1), cA + hstepA, voffA);
    if (wr == 1) PG8_BAR;
    PG8_WAIT_V(2); PG8_BAR;
    PG8_STAGE(PG8_SB(1, 0), cB + kstep, voffB); PG8_STAGE(PG8_SA(1, 0), cA + kstep, voffA); PG8_STAGE(PG8_SB(1, 1), cB + hstepB + kstep, voffB);
    PG8_WAIT_V(6); PG8_BAR;
    for (;;) {
        const bool has_next = S.next(ui + 1, nxt);
        const unsigned nA = has_next ? nxt.A : cA, nB = has_next ? nxt.B : cB;
        if (STAMP) t0 = __builtin_amdgcn_s_memtime();
        for (int t = 0; t < nt; t += 2) {
            const bool last = (t == nt - 2);
            const unsigned a1 = cA + (unsigned)(t + 1) * kstep;
            const unsigned a2 = last ? nA : cA + (unsigned)(t + 2) * kstep, b2 = last ? nB : cB + (unsigned)(t + 2) * kstep;
            const unsigned a3 = a2 + kstep, b3 = b2 + kstep;
            PG8_LDB(B0, 0, 0); PG8_LDB(B1, 0, 1); PG8_SCHED; PG8_LDA(At, 0, 0); PG8_STAGE(PG8_SA(1, 1), a1 + hstepA, voffA);
            PG8_WAIT_V(8); PG8_WAIT_L(0); PG8_BAR; PG8_MMA(0, 0, At, B0); PG8_MMA(0, 1, At, B1); PG8_BAR; PG8_SCHED;
            PG8_LDA(At, 0, 1); PG8_STAGE(PG8_SB(0, 0), b2, voffB); PG8_STAGE(PG8_SB(0, 1), b2 + hstepB, voffB); PG8_STAGE(PG8_SA(0, 0), a2, voffA);
            PG8_WAIT_V(8); PG8_WAIT_L(0); PG8_BAR; PG8_MMA(1, 0, At, B0); PG8_MMA(1, 1, At, B1); PG8_BAR; PG8_SCHED;
            PG8_LDB(B0, 1, 0); PG8_LDB(B1, 1, 1); PG8_SCHED; PG8_LDA(At, 1, 0); PG8_STAGE(PG8_SA(0, 1), a2 + hstepA, voffA);
            PG8_WAIT_V(8); PG8_WAIT_L(0); PG8_BAR; PG8_MMA(0, 0, At, B0); PG8_MMA(0, 1, At, B1); PG8_BAR; PG8_SCHED;
            PG8_LDA(At, 1, 1); PG8_STAGE(PG8_SB(1, 0), b3, voffB); PG8_STAGE(PG8_SB(1, 1), b3 + hstepB, voffB); PG8_STAGE(PG8_SA(1, 0), a3, voffA);
            PG8_WAIT_V(8); PG8_WAIT_L(0); PG8_BAR; PG8_MMA(1, 0, At, B0); PG8_MMA(1, 1, At, B1); PG8_BAR; PG8_SCHED;
        }
        if (STAMP) { const unsigned long long t1 = __builtin_amdgcn_s_memtime(); kc += t1 - t0; t0 = t1; }
        if (wr == 0) PG8_BAR;
        { int efr = fr, efq = fq; asm volatile("" : "+v"(efr), "+v"(efq));
          E(acc, cur, wr, wc, efr, efq); }
        if (STAMP) { asm volatile("s_waitcnt vmcnt(0)" ::: "memory"); const unsigned long long t1 = __builtin_amdgcn_s_memtime(); ec += t1 - t0; ++nun; }
        if (!has_next) break;
#pragma unroll
        for (int a = 0; a < 2; ++a)
#pragma unroll
            for (int b = 0; b < 2; ++b)
#pragma unroll
                for (int m = 0; m < 4; ++m)
#pragma unroll
                    for (int n = 0; n < 2; ++n) acc[a][b][m][n] = (f32x4){0.f, 0.f, 0.f, 0.f};
        cur = nxt; cA = nA; cB = nB; ++ui;
        if (wr == 1) PG8_BAR;
    }
    PG8_WAIT_V(0);
    PG8_BAR;
    if (STAMP && st && tid == 0) { st[0] = kc; st[1] = ec; st[2] = nun; }
#undef PG8_SA
#undef PG8_SB
#undef PG8_STAGE
#undef PG8_LDA
#undef PG8_LDB
#undef PG8_MMA
#undef PG8_WAIT_V
#undef PG8_WAIT_L
#undef PG8_BAR
#undef PG8_SCHED
}

__device__ __forceinline__ float gelu1(float v) {
    const float av = __builtin_fabsf(v), d = av * 0.2316418882f + 1.0f;
    const float t = __builtin_amdgcn_rcpf(d);
    float q = t * 0.5307027145f + (-0.7265760135f); q = q * t + 0.7107068705f; q = q * t + (-0.142248368f); q = q * t + 0.127414796f; q = q * t;
    const float e = __builtin_amdgcn_exp2f((v * v) * (-0.72134752044f));
    const float mm = v * (q * e), r = v - mm;
    return v < 0.f ? mm : r;
}
__device__ __forceinline__ f32x2 gelu_pk(f32x2 v) {
    const f32x2 av = __builtin_elementwise_abs(v), d = av * 0.2316418882f + 1.0f;
    f32x2 t; t.x = __builtin_amdgcn_rcpf(d.x); t.y = __builtin_amdgcn_rcpf(d.y);
    f32x2 q = t * 0.5307027145f + (-0.7265760135f); q = q * t + 0.7107068705f; q = q * t + (-0.142248368f); q = q * t + 0.127414796f; q = q * t;
    const f32x2 s = (v * v) * (-0.72134752044f);
    f32x2 e; e.x = __builtin_amdgcn_exp2f(s.x); e.y = __builtin_amdgcn_exp2f(s.y);
    const f32x2 m = v * (q * e), r = v - m;
    f32x2 o; o.x = v.x < 0.f ? m.x : r.x; o.y = v.y < 0.f ? m.y : r.y; return o;
}
__device__ __forceinline__ f32x2 rcp1pexp2_pk(f32x2 t) {
    f32x2 e; e.x = __builtin_amdgcn_exp2f(t.x); e.y = __builtin_amdgcn_exp2f(t.y);
    const f32x2 d = e + 1.0f; f32x2 r; r.x = __builtin_amdgcn_rcpf(d.x); r.y = __builtin_amdgcn_rcpf(d.y); return r;
}
}

#define XB_TMO      128
#define XB_XCNT(j)  (256  + 64 * (j))
#define XB_XSUB(j)  (1280 + 64 * (j))
#define XB_XGEN(j)  (2304 + 64 * (j))
#define XB_TOP      3328
#define XB_TOPGEN   3392
#define XCD_BAR_WORDS 3456
#define XB_SPIN_CAP (1u << 18)
__device__ __forceinline__ unsigned xb_ld(unsigned* p)              { return __hip_atomic_load(p, __ATOMIC_RELAXED, __HIP_MEMORY_SCOPE_AGENT); }
__device__ __forceinline__ unsigned xb_add(unsigned* p, unsigned v) { return __hip_atomic_fetch_add(p, v, __ATOMIC_RELAXED, __HIP_MEMORY_SCOPE_AGENT); }
__device__ __forceinline__ unsigned xb_xcc_id() { return (unsigned)__builtin_amdgcn_s_getreg((3 << 11) | 20) & 0xFu; }
#define XB_SPIN(cond, bar) do { unsigned _sp = 0; while (cond) { __builtin_amdgcn_s_sleep(1); \
    if ((++_sp & 255u) == 0u) { if (xb_ld(&(bar)[XB_TMO])) break; if (_sp > XB_SPIN_CAP) { atomicAdd(&(bar)[XB_TMO], 1u); break; } } } } while (0)
struct XcdBarrier { unsigned* bar; unsigned x; volatile LAS unsigned* st; };
__device__ __forceinline__ XcdBarrier xcd_barrier_post(unsigned* bar, volatile LAS unsigned* st, bool leader) {
    XcdBarrier b; b.bar = bar; b.x = xb_xcc_id(); b.st = st;
    if (leader) (void)xb_add(&bar[XB_XCNT(b.x)], 1u);
    return b;
}
__device__ __forceinline__ void xcd_barrier_complete(unsigned* bar, unsigned x, unsigned& nloc, unsigned& nx) {
    const unsigned G = gridDim.x * gridDim.y * gridDim.z;
    unsigned sum, cnt, mine, sp = 0u;
    for (;;) {
        sum = 0u; cnt = 0u; mine = 0u;
#pragma unroll
        for (unsigned j = 0; j < 16; ++j) { const unsigned c = xb_ld(&bar[XB_XCNT(j)]); sum += c; cnt += (c > 0u) ? 1u : 0u; mine = (j == x) ? c : mine; }
        if (sum == G) break;
        __builtin_amdgcn_s_sleep(1);
        if ((++sp & 255u) == 0u) { if (xb_ld(&bar[XB_TMO])) break; if (sp > XB_SPIN_CAP) { atomicAdd(&bar[XB_TMO], 1u); break; } }
    }
    nloc = mine > 0u ? mine : 1u; nx = cnt > 0u ? cnt : 1u;
}
__device__ __forceinline__ void xcd_barrier(const XcdBarrier& b, bool leader) {
    asm volatile("s_waitcnt vmcnt(0)" ::: "memory");
    __syncthreads();
    if (leader) {
        unsigned* bar = b.bar;
        __builtin_amdgcn_s_waitcnt(0);
        unsigned nloc = b.st[0], nx = b.st[1];
        if (nloc == 0u) { xcd_barrier_complete(bar, b.x, nloc, nx); b.st[0] = nloc; b.st[1] = nx; }
        const unsigned old = xb_add(&bar[XB_XSUB(b.x)], 1u);
        const unsigned gen = old / nloc;
        if (old + 1u == (gen + 1u) * nloc) {
            __builtin_amdgcn_fence(__ATOMIC_RELEASE, "agent");
            asm volatile("s_waitcnt vmcnt(0)" ::: "memory");
            const unsigned og = xb_add(&bar[XB_TOP], 1u);
            const unsigned tg = og / nx;
            if (og + 1u == (tg + 1u) * nx) xb_add(&bar[XB_TOPGEN], 1u);
            else XB_SPIN(xb_ld(&bar[XB_TOPGEN]) == tg, bar);
            __builtin_amdgcn_fence(__ATOMIC_ACQUIRE, "agent");
            xb_add(&bar[XB_XGEN(b.x)], 1u);
            asm volatile("s_waitcnt vmcnt(0)" ::: "memory");
        } else {
            XB_SPIN(xb_ld(&bar[XB_XGEN(b.x)]) == gen, bar);
            __builtin_amdgcn_fence(__ATOMIC_ACQUIRE, "agent");
            asm volatile("s_waitcnt vmcnt(0)" ::: "memory");
        }
    }
    __syncthreads();
}

enum { I_X = 0, I_MEM, I_F1N, I_F1G, I_F1U, I_F1D, I_MIXN, I_MEMN, I_WIN, I_GUP, I_GB, I_GON, I_LNG, I_LNB, I_WS, I_BS, I_WKV, I_WBR, I_WOUT, I_F2N, I_F2G, I_F2U, I_F2D, I_FN, N_IN };
struct Args { const float* in[N_IN]; float* out; unsigned char* ws; int ph_lo, ph_hi; };
constexpr int N_PHASES = 20;

struct ConvCtx { const float* const* in; unsigned char* ws; unsigned char* WG8; };
struct ConvItem { const float* src; const float* gain; bf16* dst; int ldw, k0, src_col0, ldk, dst_row0; unsigned char* dst8; };
constexpr float WG8_SCALE = 32.0f;
constexpr int CI_GU = 4 * 176, CI_DN = 11 * 32, CI_IN = 4 * 192, CI_KV = 4 * 32, CI_BR = 3 * 2 * 32, CI_WO = 4 * 32;
constexpr int CONV_EARLY = CI_GU + CI_KV;
constexpr int CONV_LATE = CI_DN + CI_IN + CI_BR + CI_WO + CI_GU + CI_DN;
constexpr int CONV_EPI = 1400;
__device__ __forceinline__ void conv_gu(const ConvCtx& c, int r, int second, int wave, ConvItem& o) {
    const int kb = (r / 176) * 8 + wave, nb = r % 176, tile = nb >> 2, w4 = nb & 3;
    o.src = c.in[second ? (w4 < 2 ? I_F2G : I_F2U) : (w4 < 2 ? I_F1G : I_F1U)]; o.gain = c.in[second ? I_F2N : I_F1N]; o.dst = (bf16*)(c.ws + (second ? WS_WGU2 : WS_WGU1));
    o.ldw = DFF; o.k0 = 64 * kb; o.src_col0 = 128 * tile + 64 * (w4 & 1); o.ldk = D; o.dst_row0 = 64 * nb; o.dst8 = nullptr;
}
__device__ __forceinline__ void conv_plain(const float* src, bf16* dst, int r, int nbs, int ldw, int ldk, int wave, ConvItem& o) {
    const int kb = (r / nbs) * 8 + wave, nb = r % nbs; o.src = src; o.gain = nullptr; o.dst = dst; o.ldw = ldw; o.k0 = 64 * kb; o.src_col0 = 64 * nb; o.ldk = ldk; o.dst_row0 = 64 * nb; o.dst8 = nullptr;
}
__device__ __forceinline__ void conv_early(const ConvCtx& c, int r, int wave, ConvItem& o) {
    if (r < CI_GU) { conv_gu(c, r, 0, wave, o); return; }
    conv_plain(c.in[I_WKV], (bf16*)(c.ws + WS_WKV), r - CI_GU, 32, D, D, wave, o);
}
__device__ __forceinline__ void conv_late(const ConvCtx& c, int r, int wave, ConvItem& o) {
    if (r < CI_DN) { conv_plain(c.in[I_F1D], (bf16*)(c.ws + WS_WD1), r, 32, D, DFF, wave, o); return; } r -= CI_DN;
    if (r < CI_IN) { const int kb = (r / 192) * 8 + wave, nb = r % 192; o.src = c.in[I_WIN]; o.gain = c.in[I_MIXN]; o.dst = (bf16*)(c.ws + WS_WIN); o.ldw = INW; o.k0 = 64 * kb; o.src_col0 = 64 * nb + (64 * nb >= 3072 ? 16 : 0); o.ldk = D; o.dst_row0 = 64 * nb;
        o.dst8 = nullptr; if (nb >= 96) { o.dst8 = c.WG8; o.dst_row0 = 64 * (nb - 96); } return; } r -= CI_IN;
    if (r < CI_BR) { const int i = r / 64; conv_plain(c.in[I_WBR] + (size_t)i * 1024 * D, (bf16*)(c.ws + WS_WB) + (size_t)i * D * 1024, r % 64, 32, D, 1024, wave, o); return; } r -= CI_BR;
    if (r < CI_WO) { conv_plain(c.in[I_WOUT], (bf16*)(c.ws + WS_WO), r, 32, D, D, wave, o); return; } r -= CI_WO;
    if (r < CI_GU) { conv_gu(c, r, 1, wave, o); return; } r -= CI_GU;
    conv_plain(c.in[I_F2D], (bf16*)(c.ws + WS_WD2), r, 32, D, DFF, wave, o);
}
__device__ __forceinline__ void conv_issue(const ConvItem& it, f32x4 (&v)[16], int lane) {
    const float* p = it.src + (size_t)(it.k0 + 16 * (lane >> 4)) * it.ldw + it.src_col0 + (lane & 15) * 4;
#pragma unroll
    for (int i = 0; i < 16; ++i) v[i] = __builtin_nontemporal_load((const GAS f32x4*)(p + (size_t)i * it.ldw));
}
__device__ __forceinline__ void conv_finish(const ConvItem& it, f32x4 (&v)[16], int lane) {
    const int q = lane >> 4, c4 = (lane & 15) * 4;
    if (it.gain) {
#pragma unroll
        for (int i4 = 0; i4 < 4; ++i4) { const f32x4 g = *(const f32x4*)(it.gain + it.k0 + 16 * q + 4 * i4);
            v[4 * i4] *= g.x; v[4 * i4 + 1] *= g.y; v[4 * i4 + 2] *= g.z; v[4 * i4 + 3] *= g.w; }
    }
    if (it.dst8) {
#pragma unroll
        for (int j = 0; j < 4; ++j) { v4u w;
            w.x = cvt4_fp8(v[0][j] * WG8_SCALE, v[1][j] * WG8_SCALE, v[2][j] * WG8_SCALE, v[3][j] * WG8_SCALE); w.y = cvt4_fp8(v[4][j] * WG8_SCALE, v[5][j] * WG8_SCALE, v[6][j] * WG8_SCALE, v[7][j] * WG8_SCALE);
            w.z = cvt4_fp8(v[8][j] * WG8_SCALE, v[9][j] * WG8_SCALE, v[10][j] * WG8_SCALE, v[11][j] * WG8_SCALE); w.w = cvt4_fp8(v[12][j] * WG8_SCALE, v[13][j] * WG8_SCALE, v[14][j] * WG8_SCALE, v[15][j] * WG8_SCALE);
            *(GAS v4u*)(it.dst8 + (size_t)(it.dst_row0 + c4 + j) * it.ldk + it.k0 + 16 * q) = w; }
        return;
    }
#pragma unroll
    for (int j = 0; j < 4; ++j) {
        bf16* o = it.dst + (size_t)(it.dst_row0 + c4 + j) * it.ldk + it.k0 + 16 * q;
        v4u w0, w1;
        w0.x = cvtpk(v[0][j], v[1][j]); w0.y = cvtpk(v[2][j], v[3][j]); w0.z = cvtpk(v[4][j], v[5][j]); w0.w = cvtpk(v[6][j], v[7][j]);
        w1.x = cvtpk(v[8][j], v[9][j]); w1.y = cvtpk(v[10][j], v[11][j]); w1.z = cvtpk(v[12][j], v[13][j]); w1.w = cvtpk(v[14][j], v[15][j]);
        *(GAS v4u*)o = w0; *(GAS v4u*)(o + 8) = w1;
    }
}

using pg8::Unit;
struct EpiGU {
    unsigned char* ws; const float* ss; const ConvCtx* cv; int cvbase, cvstride;
    __device__ __forceinline__ void operator()(const f32x4 (&acc)[2][2][4][2], const Unit& u, int wr, int wc, int fr, int fq) const {
        f32x4 cvv[16]; ConvItem cit; const int cvi = u.seq * (cvstride >> 1) + (cvbase >> 1); const bool docv = cv && u.seq < 11 && ((cvbase + u.seq) & 1) == 0 && cvi < CONV_EPI;
        if (docv) { conv_late(*cv, cvi, wr * 4 + wc, cit); conv_issue(cit, cvv, fq * 16 + fr); }
        epi(acc, u, wr, wc, fr, fq);
        if (docv) conv_finish(cit, cvv, fq * 16 + fr);
    }
    __device__ __forceinline__ void epi(const f32x4 (&acc)[2][2][4][2], const Unit& u, int wr, int wc, int fr, int fq) const {
        if (u.kind == 0) {
            const int row0 = u.pm * 256 + wr * 64 + fr, col0 = u.pn * 128 + wc * 32 + 8 * fq;
            const float* sp = ss + u.pm * 256 + wr * 64 + fq * 16 + fr; const float run0 = ss ? sp[0] : 0.f, run1 = ss ? sp[128] : 0.f;
#pragma unroll
            for (int ai = 0; ai < 2; ++ai)
#pragma unroll
                for (int m = 0; m < 4; ++m) {
                    const int r = row0 + ai * 128 + m * 16;
                    const float s = ss ? __builtin_amdgcn_rsqf(__shfl(ai ? run1 : run0, m * 16 + fr) * (1.0f / D) + EPS) : 1.0f;
                    const float c1 = -1.4426950408889634f * s, s2 = s * s;
                    f32x2 o[4];
#pragma unroll
                    for (int n = 0; n < 2; ++n)
#pragma unroll
                        for (int jp = 0; jp < 2; ++jp) { const f32x2 g = {acc[ai][0][m][n][2 * jp], acc[ai][0][m][n][2 * jp + 1]}, uu = {acc[ai][1][m][n][2 * jp], acc[ai][1][m][n][2 * jp + 1]};
                            o[n * 2 + jp] = (g * uu) * (pg8::rcp1pexp2_pk(g * c1) * s2); }
                    v4u w; w.x = cvtpk(o[0].x, o[0].y); w.y = cvtpk(o[1].x, o[1].y); w.z = cvtpk(o[2].x, o[2].y); w.w = cvtpk(o[3].x, o[3].y);
                    *(v4u*)((bf16*)(ws + WS_ACT) + (size_t)r * DFF + col0) = w;
                }
        } else {
            bf16* base = (bf16*)(ws + (u.kind == 1 ? WS_KB : WS_VT)); const int ldc = u.kind == 1 ? 1024 : 2048;
            const int row0 = u.pm * 256 + wr * 64 + fr, col0 = u.pn * 256 + wc * 32 + 8 * fq;
#pragma unroll
            for (int ai = 0; ai < 2; ++ai)
#pragma unroll
                for (int m = 0; m < 4; ++m) {
                    bf16* rowp = base + (size_t)(row0 + ai * 128 + m * 16) * ldc + col0;
#pragma unroll
                    for (int bj = 0; bj < 2; ++bj) { const f32x4 v0 = acc[ai][bj][m][0], v1 = acc[ai][bj][m][1];
                        v4u w; w.x = cvtpk(v0[0], v0[1]); w.y = cvtpk(v0[2], v0[3]); w.z = cvtpk(v1[0], v1[1]); w.w = cvtpk(v1[2], v1[3]);
                        *(v4u*)(rowp + bj * 128) = w; }
                }
        }
    }
};
struct EpiRes {
    bf16* xb; float* ss; float alpha; unsigned char* x8;
    __device__ __forceinline__ void operator()(const f32x4 (&acc)[2][2][4][2], const Unit& u, int wr, int wc, int fr, int fq) const {
        const int row0 = u.pm * 256 + wr * 64 + fr, col0 = u.pn * 256 + wc * 32 + 8 * fq;
#pragma unroll
        for (int ai = 0; ai < 2; ++ai) {
            v4u old[4][2];
#pragma unroll
            for (int m = 0; m < 4; ++m)
#pragma unroll
                for (int bj = 0; bj < 2; ++bj) old[m][bj] = *(const v4u*)(xb + (size_t)(row0 + ai * 128 + m * 16) * D + col0 + bj * 128);
#pragma unroll
            for (int m = 0; m < 4; ++m) {
                const int r = row0 + ai * 128 + m * 16; const size_t off = (size_t)r * D + col0; float sq = 0.f;
#pragma unroll
                for (int bj = 0; bj < 2; ++bj) {
                    const v4u o = old[m][bj]; const f32x4 a0 = acc[ai][bj][m][0], a1 = acc[ai][bj][m][1];
                    float v[8];
                    v[0] = bflo(o.x) + alpha * a0[0]; v[1] = bfhi(o.x) + alpha * a0[1]; v[2] = bflo(o.y) + alpha * a0[2]; v[3] = bfhi(o.y) + alpha * a0[3];
                    v[4] = bflo(o.z) + alpha * a1[0]; v[5] = bfhi(o.z) + alpha * a1[1]; v[6] = bflo(o.w) + alpha * a1[2]; v[7] = bfhi(o.w) + alpha * a1[3];
                    v4u w; w.x = cvtpk(v[0], v[1]); w.y = cvtpk(v[2], v[3]); w.z = cvtpk(v[4], v[5]); w.w = cvtpk(v[6], v[7]);
                    *(v4u*)(xb + off + bj * 128) = w;
                    if (x8) { v2u w8; w8.x = cvt4_fp8(v[0], v[1], v[2], v[3]); w8.y = cvt4_fp8(v[4], v[5], v[6], v[7]); *(v2u*)(x8 + off + bj * 128) = w8; }
                    sq += (v[0] * v[0] + v[1] * v[1]) + (v[2] * v[2] + v[3] * v[3]) + (v[4] * v[4] + v[5] * v[5]) + (v[6] * v[6] + v[7] * v[7]);
                }
                if (ss) { sq += __shfl_xor(sq, 16); sq += __shfl_xor(sq, 32); if (fq == 0) atomicAdd(ss + r, sq); }
            }
            asm volatile("" ::: "memory");
        }
    }
};
struct EpiProj {
    const float* ss; unsigned char* ws;
    __device__ __forceinline__ void operator()(const f32x4 (&acc)[2][2][4][2], const Unit& u, int wr, int wc, int fr, int fq) const {
        size_t boff; int ldc, ct; bool act = false; const int pn = u.pn;
        if (pn < 2) { boff = WS_Q; ldc = 512; ct = pn; } else if (pn < 4) { boff = WS_K; ldc = 512; ct = pn - 2; } else if (pn < 8) { boff = WS_V; ldc = 1024; ct = pn - 4; }
        else if (pn < 12) { boff = WS_R; ldc = 1024; ct = pn - 8; } else if (pn < 16) { boff = WS_SU; ldc = 1024; ct = pn - 12; act = true; }
        else if (pn < 20) { boff = WS_SV; ldc = 1024; ct = pn - 16; act = true; } else { boff = WS_XQ; ldc = 1024; ct = pn - 20; }
        bf16* base = (bf16*)(ws + boff);
        const int row0 = u.pm * 256 + wr * 64 + fr, col0 = ct * 256 + wc * 32 + 8 * fq;
        const float* sp = ss + u.pm * 256 + wr * 64 + fq * 16 + fr; const float run0 = sp[0], run1 = sp[128];
#pragma unroll
        for (int ai = 0; ai < 2; ++ai)
#pragma unroll
            for (int m = 0; m < 4; ++m) {
                const int rr = row0 + ai * 128 + m * 16;
                const float s = __builtin_amdgcn_rsqf(__shfl(ai ? run1 : run0, m * 16 + fr) * (1.0f / D) + EPS);
                bf16* rowp = base + (size_t)rr * ldc + col0;
#pragma unroll
                for (int bj = 0; bj < 2; ++bj) { f32x4 v0 = acc[ai][bj][m][0] * s, v1 = acc[ai][bj][m][1] * s;
                    if (act) { const f32x2 a = pg8::gelu_pk((f32x2){v0[0], v0[1]}), b = pg8::gelu_pk((f32x2){v0[2], v0[3]}), c = pg8::gelu_pk((f32x2){v1[0], v1[1]}), d = pg8::gelu_pk((f32x2){v1[2], v1[3]});
                        v0 = (f32x4){a.x, a.y, b.x, b.y}; v1 = (f32x4){c.x, c.y, d.x, d.y}; }
                    v4u w; w.x = cvtpk(v0[0], v0[1]); w.y = cvtpk(v0[2], v0[3]); w.z = cvtpk(v1[0], v1[1]); w.w = cvtpk(v1[2], v1[3]);
                    *(v4u*)(rowp + bj * 128) = w; }
            }
    }
};
struct EpiGate {
    const float* ss; bf16* g; float pre;
    __device__ __forceinline__ void operator()(const f32x4 (&acc)[2][2][4][2], const Unit& u, int wr, int wc, int fr, int fq) const {
        const int row0 = u.pm * 256 + wr * 64 + fr, col0 = u.pn * 256 + wc * 32 + 8 * fq;
        const float* sp = ss + u.pm * 256 + wr * 64 + fq * 16 + fr; const float run0 = sp[0], run1 = sp[128];
#pragma unroll
        for (int ai = 0; ai < 2; ++ai)
#pragma unroll
            for (int m = 0; m < 4; ++m) {
                const int rr = row0 + ai * 128 + m * 16;
                const float s = pre * __builtin_amdgcn_rsqf(__shfl(ai ? run1 : run0, m * 16 + fr) * (1.0f / D) + EPS);
                bf16* rowp = g + (size_t)rr * D + col0;
                const float c1 = -1.4426950408889634f * s;
#pragma unroll
                for (int bj = 0; bj < 2; ++bj) { const f32x4 a0 = acc[ai][bj][m][0], a1 = acc[ai][bj][m][1];
                    const f32x2 p = pg8::rcp1pexp2_pk((f32x2){a0[0], a0[1]} * c1), q = pg8::rcp1pexp2_pk((f32x2){a0[2], a0[3]} * c1), rr2 = pg8::rcp1pexp2_pk((f32x2){a1[0], a1[1]} * c1), t2 = pg8::rcp1pexp2_pk((f32x2){a1[2], a1[3]} * c1);
                    const f32x4 v0 = (f32x4){p.x, p.y, q.x, q.y}, v1 = (f32x4){rr2.x, rr2.y, t2.x, t2.y};
                    v4u w; w.x = cvtpk(v0[0], v0[1]); w.y = cvtpk(v0[2], v0[3]); w.z = cvtpk(v1[0], v1[1]); w.w = cvtpk(v1[2], v1[3]);
                    *(v4u*)(rowp + bj * 128) = w; }
            }
    }
};
struct EpiMerge {
    const bf16* g; bf16* mrg; int first;
    __device__ __forceinline__ void operator()(const f32x4 (&acc)[2][2][4][2], const Unit& u, int wr, int wc, int fr, int fq) const {
        const int row0 = u.pm * 256 + wr * 64 + fr, col0 = u.pn * 256 + wc * 32 + 8 * fq;
#pragma unroll
        for (int ai = 0; ai < 2; ++ai) {
            v4u gws[4][2], ows[4][2];
#pragma unroll
            for (int m = 0; m < 4; ++m)
#pragma unroll
                for (int bj = 0; bj < 2; ++bj) { const size_t off = (size_t)(row0 + ai * 128 + m * 16) * D + col0 + bj * 128;
                    gws[m][bj] = *(const v4u*)(g + off); ows[m][bj] = first ? (v4u){0u, 0u, 0u, 0u} : *(const v4u*)(mrg + off); }
#pragma unroll
            for (int m = 0; m < 4; ++m)
#pragma unroll
                for (int bj = 0; bj < 2; ++bj) {
                    const size_t off = (size_t)(row0 + ai * 128 + m * 16) * D + col0 + bj * 128;
                    const v4u gw = gws[m][bj], ow = ows[m][bj]; const f32x4 a0 = acc[ai][bj][m][0], a1 = acc[ai][bj][m][1];
                    float o[8];
                    o[0] = bflo(ow.x) + bflo(gw.x) * a0[0]; o[1] = bfhi(ow.x) + bfhi(gw.x) * a0[1]; o[2] = bflo(ow.y) + bflo(gw.y) * a0[2]; o[3] = bfhi(ow.y) + bfhi(gw.y) * a0[3];
                    o[4] = bflo(ow.z) + bflo(gw.z) * a1[0]; o[5] = bfhi(ow.z) + bfhi(gw.z) * a1[1]; o[6] = bflo(ow.w) + bflo(gw.w) * a1[2]; o[7] = bfhi(ow.w) + bfhi(gw.w) * a1[3];
                    v4u w; w.x = cvtpk(o[0], o[1]); w.y = cvtpk(o[2], o[3]); w.z = cvtpk(o[4], o[5]); w.w = cvtpk(o[6], o[7]);
                    *(v4u*)(mrg + off) = w;
                }
            asm volatile("" ::: "memory");
        }
    }
};

struct GridSched {
    unsigned A, B, tA, tB; int nM, nN, G, c;
    __device__ __forceinline__ bool next(int i, Unit& u) const {
        const int L = i * G + c; if (L >= nM * nN) return false;
        pg8::tile_of(L, nM, nN, u.pm, u.pn); u.A = A + (unsigned)u.pm * tA; u.B = B + (unsigned)u.pn * tB; u.kind = 0; u.seq = i; return true;
    }
};
struct P1Sched {
    unsigned h1b, wgu, memb, wkv; int G, c;
    __device__ __forceinline__ bool next(int i, Unit& u) const {
        const int L = i * G + c; constexpr int NF = 64 * 44; constexpr unsigned T = 256u * D * 2u; u.seq = i;
        if (L < NF) { pg8::tile_of(L, 64, 44, u.pm, u.pn); u.A = h1b + (unsigned)u.pm * T; u.B = wgu + (unsigned)u.pn * T; u.kind = 0; return true; }
        const int id = L - NF; if (id >= 64) return false;
        if (id < 32) { u.pm = id >> 2; u.pn = id & 3; u.A = memb + (unsigned)u.pm * T; u.B = wkv + (unsigned)u.pn * T; u.kind = 1; }
        else { const int j = id - 32; u.pm = j >> 3; u.pn = j & 7; u.A = wkv + (unsigned)(4 + u.pm) * T; u.B = memb + (unsigned)u.pn * T; u.kind = 2; }
        return true;
    }
};

__device__ __forceinline__ void transpose64(const float* W, int ldw, int k0, int src_col0, bf16* WT, int ldk, int dst_row0, const float* gain, LAS unsigned* T, int lane) {
    const int q = lane >> 4, c4 = (lane & 15) * 4;
    const float* p = W + (size_t)(k0 + 16 * q) * ldw + src_col0 + c4;
    f32x4 v[16];
#pragma unroll
    for (int i = 0; i < 16; ++i) v[i] = __builtin_nontemporal_load((const GAS f32x4*)(p + (size_t)i * ldw));
    if (gain) {
#pragma unroll
        for (int i4 = 0; i4 < 4; ++i4) { const f32x4 g = *(const f32x4*)(gain + k0 + 16 * q + 4 * i4);
            v[4 * i4] *= g.x; v[4 * i4 + 1] *= g.y; v[4 * i4 + 2] *= g.z; v[4 * i4 + 3] *= g.w; }
    }
#pragma unroll
    for (int j = 0; j < 4; ++j) {
        v4u w0, w1;
        w0.x = cvtpk(v[0][j], v[1][j]); w0.y = cvtpk(v[2][j], v[3][j]); w0.z = cvtpk(v[4][j], v[5][j]); w0.w = cvtpk(v[6][j], v[7][j]);
        w1.x = cvtpk(v[8][j], v[9][j]); w1.y = cvtpk(v[10][j], v[11][j]); w1.z = cvtpk(v[12][j], v[13][j]); w1.w = cvtpk(v[14][j], v[15][j]);
        LAS v4u* t = (LAS v4u*)(T + (c4 + j) * 36 + 8 * q); t[0] = w0; t[1] = w1;
    }
    LDS_WAIT(); asm volatile("" ::: "memory");
#pragma unroll
    for (int r = 0; r < 8; ++r) { const int n = 8 * r + (lane >> 3), ch = lane & 7;
        const v4u w = *(const LAS v4u*)(T + n * 36 + 4 * ch);
        *(GAS v4u*)(WT + (size_t)(dst_row0 + n) * ldk + k0 + 8 * ch) = w; }
    LDS_WAIT(); asm volatile("" ::: "memory");
}
__device__ __forceinline__ void row_to_bf16_ss(const float* xrow, bf16* orow, float* ssp, int lane) {
    const GAS f32x4* xr = (const GAS f32x4*)xrow + lane;
    f32x4 v[8]; float s = 0.f;
#pragma unroll
    for (int j = 0; j < 8; ++j) { v[j] = xr[64 * j]; s += (v[j].x * v[j].x + v[j].y * v[j].y) + (v[j].z * v[j].z + v[j].w * v[j].w); }
    s = wave_sum(s); if (lane == 0) *ssp = s;
    GAS v2u* o8 = (GAS v2u*)orow + lane;
#pragma unroll
    for (int j = 0; j < 8; ++j) { v2u w; w.x = cvtpk(v[j].x, v[j].y); w.y = cvtpk(v[j].z, v[j].w); o8[64 * j] = w; }
}
__device__ __forceinline__ void rms_row_to_bf16(const float* xrow, const float* gain, bf16* orow, int lane) {
    const GAS f32x4* xr = (const GAS f32x4*)xrow + lane; const GAS f32x4* gr = (const GAS f32x4*)gain + lane;
    f32x4 v[8]; float s = 0.f;
#pragma unroll
    for (int j = 0; j < 8; ++j) { v[j] = xr[64 * j]; s += (v[j].x * v[j].x + v[j].y * v[j].y) + (v[j].z * v[j].z + v[j].w * v[j].w); }
    const float rs = 1.0f / sqrtf(wave_sum(s) * (1.0f / D) + EPS);
    GAS v2u* o8 = (GAS v2u*)orow + lane;
#pragma unroll
    for (int j = 0; j < 8; ++j) { const f32x4 g = gr[64 * j]; v2u w; w.x = cvtpk(v[j].x * rs * g.x, v[j].y * rs * g.y); w.y = cvtpk(v[j].z * rs * g.z, v[j].w * rs * g.w); o8[64 * j] = w; }
}

__device__ __forceinline__ int tau32(int r) { return (r & ~12) | ((r & 4) << 1) | ((r & 8) >> 1); }
#define MFMA32(a, b, c) __builtin_amdgcn_mfma_f32_32x32x16_bf16((a), (b), (c), 0, 0, 0)
__device__ __forceinline__ bf16x8 pack8(const f32x16& x, int s) {
    v4u p; p.x = cvtpk(x[8 * s], x[8 * s + 1]); p.y = cvtpk(x[8 * s + 2], x[8 * s + 3]); p.z = cvtpk(x[8 * s + 4], x[8 * s + 5]); p.w = cvtpk(x[8 * s + 6], x[8 * s + 7]);
    return __builtin_bit_cast(bf16x8, p);
}
__device__ __forceinline__ f32x16 zero16() { f32x16 z;
#pragma unroll
    for (int i = 0; i < 16; ++i) z[i] = 0.f; return z; }

constexpr float GLA_SCALE = 0.08838834764831845f;
constexpr int VT_P = 72, KL_P = 72, QS_P = 136;

__device__ __forceinline__ void load_vT(const bf16* V, int tok0, int h, LAS bf16* VT, int wave, int lane) {
    const bf16* src = V + (size_t)(tok0 + lane) * 1024 + h * 256 + 32 * wave;
#pragma unroll
    for (int p = 0; p < 4; ++p) { const v4u raw = *(const v4u*)(src + 8 * p); const int c0 = 32 * wave + 8 * p;
        VT[(c0 + 0) * VT_P + lane] = (bf16)(raw.x & 0xffff); VT[(c0 + 1) * VT_P + lane] = (bf16)(raw.x >> 16);
        VT[(c0 + 2) * VT_P + lane] = (bf16)(raw.y & 0xffff); VT[(c0 + 3) * VT_P + lane] = (bf16)(raw.y >> 16);
        VT[(c0 + 4) * VT_P + lane] = (bf16)(raw.z & 0xffff); VT[(c0 + 5) * VT_P + lane] = (bf16)(raw.z >> 16);
        VT[(c0 + 6) * VT_P + lane] = (bf16)(raw.w & 0xffff); VT[(c0 + 7) * VT_P + lane] = (bf16)(raw.w >> 16); }
}

__device__ __forceinline__ void gla_step1(LAS unsigned char* lds, int unit, bf16* Q, bf16* Kt, const bf16* V, const float* GLR, const float* wup, const float* gbias, float* ADEC, bf16* US, int wave, int lane) {
    const int b = unit >> 7, h = (unit >> 5) & 3, n = unit & 31, tok0 = b * SEQ + n * 64, tid = wave * 64 + lane;
    LAS float* WUP = (LAS float*)lds;
    LAS float* BIAS = (LAS float*)(lds + 8192);
    LAS bf16* KLT = (LAS bf16*)(lds + 9216);
    LAS bf16* VTl = (LAS bf16*)(lds + 9216 + 128 * KL_P * 2);
    for (int i = tid; i < 16 * 128; i += NTHREADS) WUP[i] = wup[(i >> 7) * 512 + h * 128 + (i & 127)];
    if (tid < 128) BIAS[tid] = gbias[h * 128 + tid];
    load_vT(V, tok0, h, VTl, wave, lane);
    const int token = tok0 + lane;
    float gl[16];
    { const f32x4* gp = (const f32x4*)(GLR + (size_t)token * 16);
#pragma unroll
      for (int i = 0; i < 4; ++i) { const f32x4 t = gp[i]; gl[4 * i] = t.x; gl[4 * i + 1] = t.y; gl[4 * i + 2] = t.z; gl[4 * i + 3] = t.w; } }
    __syncthreads();
    float la[16];
#pragma unroll
    for (int j = 0; j < 16; ++j) {
        float z = BIAS[16 * wave + j];
#pragma unroll
        for (int r = 0; r < 16; ++r) z += gl[r] * WUP[r * 128 + 16 * wave + j];
        const float ls = fminf(z, 0.f) - __logf(1.0f + __expf(-fabsf(z)));
        float v = ls * (1.0f / 16.0f);
#pragma unroll
        for (int o = 1; o < 64; o <<= 1) { const float t = __shfl_up(v, o); if (lane >= o) v += t; }
        la[j] = v;
    }
    unsigned qraw[8], kraw[8];
    { const v4u* qp = (const v4u*)(Q + (size_t)token * 512 + h * 128 + 16 * wave); const v4u* kp = (const v4u*)(Kt + (size_t)token * 512 + h * 128 + 16 * wave);
      const v4u q0 = qp[0], q1 = qp[1], k0 = kp[0], k1 = kp[1];
      qraw[0] = q0.x; qraw[1] = q0.y; qraw[2] = q0.z; qraw[3] = q0.w; qraw[4] = q1.x; qraw[5] = q1.y; qraw[6] = q1.z; qraw[7] = q1.w;
      kraw[0] = k0.x; kraw[1] = k0.y; kraw[2] = k0.z; kraw[3] = k0.w; kraw[4] = k1.x; kraw[5] = k1.y; kraw[6] = k1.z; kraw[7] = k1.w; }
    unsigned qo[8], ko[8];
#pragma unroll
    for (int jj = 0; jj < 8; ++jj) {
        float qs2[2], ks2[2];
#pragma unroll
        for (int e = 0; e < 2; ++e) { const int j = 2 * jj + e;
            const float bb = la[j], bl = __shfl(bb, 63), a = __expf(bl), e1 = __expf(bb), e2 = __expf(-bb);
            const float qv = e ? bfhi(qraw[jj]) : bflo(qraw[jj]), kv = e ? bfhi(kraw[jj]) : bflo(kraw[jj]);
            qs2[e] = qv * (GLA_SCALE * e1); ks2[e] = kv * e2;
            KLT[(16 * wave + j) * KL_P + lane] = f2bf(kv * (e2 * a));
            if (lane == 63) ADEC[(size_t)unit * 128 + 16 * wave + j] = a; }
        qo[jj] = cvtpk(qs2[0], qs2[1]); ko[jj] = cvtpk(ks2[0], ks2[1]);
    }
    { v4u* qp = (v4u*)(Q + (size_t)token * 512 + h * 128 + 16 * wave); v4u* kp = (v4u*)(Kt + (size_t)token * 512 + h * 128 + 16 * wave);
      qp[0] = (v4u){qo[0], qo[1], qo[2], qo[3]}; qp[1] = (v4u){qo[4], qo[5], qo[6], qo[7]};
      kp[0] = (v4u){ko[0], ko[1], ko[2], ko[3]}; kp[1] = (v4u){ko[4], ko[5], ko[6], ko[7]}; }
    __syncthreads();
    const int r32 = lane & 31, hh = lane >> 5;
    f32x16 acc[4];
#pragma unroll
    for (int dt = 0; dt < 4; ++dt) acc[dt] = zero16();
#pragma unroll
    for (int kk = 0; kk < 4; ++kk) {
        const bf16x8 Bf = *(const LAS bf16x8*)(VTl + (32 * wave + r32) * VT_P + 16 * kk + 8 * hh);
#pragma unroll
        for (int dt = 0; dt < 4; ++dt) { const bf16x8 Af = *(const LAS bf16x8*)(KLT + (32 * dt + r32) * KL_P + 16 * kk + 8 * hh); acc[dt] = MFMA32(Af, Bf, acc[dt]); }
    }
    bf16* up = US + ((size_t)unit * 256 + 32 * wave + r32) * 128;
#pragma unroll
    for (int dt = 0; dt < 4; ++dt)
#pragma unroll
        for (int g4 = 0; g4 < 4; ++g4) { v2u w; w.x = cvtpk(acc[dt][4 * g4], acc[dt][4 * g4 + 1]); w.y = cvtpk(acc[dt][4 * g4 + 2], acc[dt][4 * g4 + 3]);
            *(v2u*)(up + 32 * dt + 8 * g4 + 4 * hh) = w; }
    __syncthreads();
}

__device__ __forceinline__ void gla_scan(bf16* US, const float* ADEC, int gid) {
    const int bh = gid >> 12, e = gid & 4095, dv = e >> 4, dk0 = (e & 15) * 8;
    float S[8];
#pragma unroll
    for (int i = 0; i < 8; ++i) S[i] = 0.f;
#pragma unroll 4
    for (int n = 0; n < 32; ++n) {
        const int unit = bh * 32 + n;
        v4u* p = (v4u*)(US + ((size_t)unit * 256 + dv) * 128 + dk0);
        const v4u uu = *p; const f32x4 a0 = *(const f32x4*)(ADEC + (size_t)unit * 128 + dk0), a1 = *(const f32x4*)(ADEC + (size_t)unit * 128 + dk0 + 4);
        v4u w; w.x = cvtpk(S[0], S[1]); w.y = cvtpk(S[2], S[3]); w.z = cvtpk(S[4], S[5]); w.w = cvtpk(S[6], S[7]);
        *p = w;
        S[0] = a0.x * S[0] + bflo(uu.x); S[1] = a0.y * S[1] + bfhi(uu.x); S[2] = a0.z * S[2] + bflo(uu.y); S[3] = a0.w * S[3] + bfhi(uu.y);
        S[4] = a1.x * S[4] + bflo(uu.z); S[5] = a1.y * S[5] + bfhi(uu.z); S[6] = a1.z * S[6] + bflo(uu.w); S[7] = a1.w * S[7] + bfhi(uu.w);
    }
}

__device__ __forceinline__ void gla_step3(LAS unsigned char* lds, int unit, const bf16* Q, const bf16* Kt, bf16* V, const bf16* R, const bf16* US, const float* onorm, int wave, int lane) {
    const int b = unit >> 7, h = (unit >> 5) & 3, n = unit & 31, tok0 = b * SEQ + n * 64, tid = wave * 64 + lane;
    LAS bf16* QS = (LAS bf16*)lds;
    LAS bf16* KS = (LAS bf16*)(lds + 64 * QS_P * 2);
    LAS bf16* VTl = (LAS bf16*)(lds + 2 * 64 * QS_P * 2);
    LAS float* RED = (LAS float*)(lds + 2 * 64 * QS_P * 2 + 256 * VT_P * 2);
#pragma unroll
    for (int i = 0; i < 2; ++i) { const int pc = tid + i * NTHREADS, row = pc >> 4, c8 = (pc & 15) * 8;
        *(LAS v4u*)(QS + row * QS_P + c8) = *(const v4u*)(Q + (size_t)(tok0 + row) * 512 + h * 128 + c8);
        *(LAS v4u*)(KS + row * QS_P + c8) = *(const v4u*)(Kt + (size_t)(tok0 + row) * 512 + h * 128 + c8); }
    load_vT(V, tok0, h, VTl, wave, lane);
    __syncthreads();
    const int r32 = lane & 31, hh = lane >> 5;
    f32x16 sc0 = zero16(), sc1 = zero16(), sc2 = zero16();
#pragma unroll
    for (int kk = 0; kk < 8; ++kk) {
        const bf16x8 A0 = *(const LAS bf16x8*)(KS + tau32(r32) * QS_P + 16 * kk + 8 * hh), A1 = *(const LAS bf16x8*)(KS + (32 + tau32(r32)) * QS_P + 16 * kk + 8 * hh);
        const bf16x8 B0 = *(const LAS bf16x8*)(QS + r32 * QS_P + 16 * kk + 8 * hh), B1 = *(const LAS bf16x8*)(QS + (32 + r32) * QS_P + 16 * kk + 8 * hh);
        sc0 = MFMA32(A0, B0, sc0); sc1 = MFMA32(A0, B1, sc1); sc2 = MFMA32(A1, B1, sc2);
    }
#pragma unroll
    for (int rg = 0; rg < 16; ++rg) { const int s = (rg & 3) + 4 * ((rg >> 2) & 1) + 8 * hh + 16 * (rg >> 3); if (s > r32) { sc0[rg] = 0.f; sc2[rg] = 0.f; } }
    f32x16 o0 = zero16(), o1 = zero16();
    const LAS bf16* vrow = VTl + (32 * wave + r32) * VT_P + 8 * hh;
#pragma unroll
    for (int s = 0; s < 2; ++s) {
        const bf16x8 Av0 = *(const LAS bf16x8*)(vrow + 16 * s), Av1 = *(const LAS bf16x8*)(vrow + 32 + 16 * s);
        o0 = MFMA32(Av0, pack8(sc0, s), o0); o1 = MFMA32(Av0, pack8(sc1, s), o1); o1 = MFMA32(Av1, pack8(sc2, s), o1);
    }
    const bf16* sp = US + ((size_t)unit * 256 + 32 * wave + r32) * 128 + 8 * hh;
#pragma unroll
    for (int kk = 0; kk < 8; ++kk) {
        const bf16x8 As = __builtin_bit_cast(bf16x8, *(const v4u*)(sp + 16 * kk));
        const bf16x8 B0 = *(const LAS bf16x8*)(QS + r32 * QS_P + 16 * kk + 8 * hh), B1 = *(const LAS bf16x8*)(QS + (32 + r32) * QS_P + 16 * kk + 8 * hh);
        o0 = MFMA32(As, B0, o0); o1 = MFMA32(As, B1, o1);
    }
    float q0 = 0.f, q1 = 0.f;
#pragma unroll
    for (int rg = 0; rg < 16; ++rg) { q0 += o0[rg] * o0[rg]; q1 += o1[rg] * o1[rg]; }
    q0 += __shfl_xor(q0, 32); q1 += __shfl_xor(q1, 32);
    if (hh == 0) { RED[wave * 64 + r32] = q0; RED[wave * 64 + 32 + r32] = q1; }
    __syncthreads();
    float t0 = 0.f, t1 = 0.f;
#pragma unroll
    for (int w = 0; w < 8; ++w) { t0 += RED[w * 64 + r32]; t1 += RED[w * 64 + 32 + r32]; }
    const float rs0 = 1.0f / sqrtf(t0 * (1.0f / 256.0f) + EPS), rs1 = 1.0f / sqrtf(t1 * (1.0f / 256.0f) + EPS);
#pragma unroll
    for (int tt = 0; tt < 2; ++tt) {
        const size_t rowoff = (size_t)(tok0 + 32 * tt + r32) * 1024 + h * 256 + 32 * wave + 4 * hh;
        const float rs = tt ? rs1 : rs0;
#pragma unroll
        for (int g4 = 0; g4 < 4; ++g4) {
            const v2u rw = *(const v2u*)(R + rowoff + 8 * g4); const f32x4 gn = *(const f32x4*)(onorm + h * 256 + 32 * wave + 8 * g4 + 4 * hh);
            float y[4];
#pragma unroll
            for (int j = 0; j < 4; ++j) { const float ov = tt ? o1[4 * g4 + j] : o0[4 * g4 + j]; const unsigned rr = j < 2 ? rw.x : rw.y; const float rv = (j & 1) ? bfhi(rr) : bflo(rr);
                y[j] = ov * rs * gn[j] * (rv * sigmoidf_(rv)); }
            v2u w; w.x = cvtpk(y[0], y[1]); w.y = cvtpk(y[2], y[3]); *(v2u*)(V + rowoff + 8 * g4) = w;
        }
    }
    __syncthreads();
}

__device__ __forceinline__ void sg_unit(LAS unsigned char* lds, int unit, bf16* SU, const bf16* SV, const float* lng, const float* lnb, const float* ws, const float* bs, int wave, int lane) {
    const int b = unit >> 6, n = (unit >> 2) & 15, g = unit & 3, tok0 = b * SEQ + n * 128, tid = wave * 64 + lane;
    LAS bf16* VNT = (LAS bf16*)lds;
    LAS bf16* WB = (LAS bf16*)(lds + 256 * QS_P * 2);
    LAS f32x2* RED = (LAS f32x2*)(lds + 256 * QS_P * 2 + 128 * QS_P * 2);
    { const int t = tid >> 2, s0 = (tid & 3) * 32; const float* wp = ws + ((size_t)g * 128 + t) * 128 + s0;
#pragma unroll
      for (int i = 0; i < 4; ++i) { const f32x4 a = *(const f32x4*)(wp + 8 * i), c = *(const f32x4*)(wp + 8 * i + 4); const int s = s0 + 8 * i;
          v4u w; w.x = cvtpk(s + 0 <= t ? a.x : 0.f, s + 1 <= t ? a.y : 0.f); w.y = cvtpk(s + 2 <= t ? a.z : 0.f, s + 3 <= t ? a.w : 0.f);
          w.z = cvtpk(s + 4 <= t ? c.x : 0.f, s + 5 <= t ? c.y : 0.f); w.w = cvtpk(s + 6 <= t ? c.z : 0.f, s + 7 <= t ? c.w : 0.f);
          *(LAS v4u*)(WB + t * QS_P + s) = w; } }
    const int tok = lane + 64 * (wave & 1), cq = wave >> 1;
    unsigned raw[32]; float s1 = 0.f, s2 = 0.f;
    { const v4u* p = (const v4u*)(SV + (size_t)(tok0 + tok) * 1024 + g * 256 + 64 * cq);
#pragma unroll
      for (int i = 0; i < 8; ++i) { const v4u t = p[i]; raw[4 * i] = t.x; raw[4 * i + 1] = t.y; raw[4 * i + 2] = t.z; raw[4 * i + 3] = t.w; } }
#pragma unroll
    for (int i = 0; i < 32; ++i) { const float a = bflo(raw[i]), c = bfhi(raw[i]); s1 += a + c; s2 += a * a + c * c; }
    RED[tok * 4 + cq] = (f32x2){s1, s2};
    __syncthreads();
    { const f32x2 p0 = RED[tok * 4], p1 = RED[tok * 4 + 1], p2 = RED[tok * 4 + 2], p3 = RED[tok * 4 + 3];
      const float mu = ((p0.x + p1.x) + (p2.x + p3.x)) * (1.0f / 256.0f); const float var = fmaxf(((p0.y + p1.y) + (p2.y + p3.y)) * (1.0f / 256.0f) - mu * mu, 0.f);
      const float rstd = 1.0f / sqrtf(var + EPS);
      const float* gp = lng + g * 256 + 64 * cq; const float* bp = lnb + g * 256 + 64 * cq;
#pragma unroll
      for (int i = 0; i < 32; ++i) { const int c = 64 * cq + 2 * i;
          VNT[c * QS_P + tok] = f2bf((bflo(raw[i]) - mu) * rstd * gp[2 * i] + bp[2 * i]);
          VNT[(c + 1) * QS_P + tok] = f2bf((bfhi(raw[i]) - mu) * rstd * gp[2 * i + 1] + bp[2 * i + 1]); } }
    __syncthreads();
    const int r32 = lane & 31, hh = lane >> 5;
    f32x16 acc[4];
#pragma unroll
    for (int j = 0; j < 4; ++j) {
        acc[j] = zero16();
#pragma unroll
        for (int kk = 0; kk < 2 * (j + 1); ++kk) {
            const bf16x8 Af = *(const LAS bf16x8*)(VNT + (32 * wave + r32) * QS_P + 16 * kk + 8 * hh), Bf = *(const LAS bf16x8*)(WB + (32 * j + r32) * QS_P + 16 * kk + 8 * hh);
            acc[j] = MFMA32(Af, Bf, acc[j]);
        }
    }
#pragma unroll
    for (int j = 0; j < 4; ++j) {
        const int t = 32 * j + r32; const float bias = bs[g * 128 + t];
        bf16* up = SU + (size_t)(tok0 + t) * 1024 + g * 256 + 32 * wave + 4 * hh;
#pragma unroll
        for (int g4 = 0; g4 < 4; ++g4) { const v2u uw = *(const v2u*)(up + 8 * g4);
            v2u w; w.x = cvtpk(bflo(uw.x) * (acc[j][4 * g4] + bias), bfhi(uw.x) * (acc[j][4 * g4 + 1] + bias)); w.y = cvtpk(bflo(uw.y) * (acc[j][4 * g4 + 2] + bias), bfhi(uw.y) * (acc[j][4 * g4 + 3] + bias));
            *(v2u*)(up + 8 * g4) = w; }
    }
    __syncthreads();
}

__device__ __forceinline__ void xa_task(int task, bf16* XQ, const bf16* Kb, const bf16* VTg, int lane) {
    const int qblk = task & 63, h = (task >> 6) & 3, b = task >> 8;
    const int r32 = lane & 31, hh = lane >> 5; const size_t token = (size_t)b * SEQ + 32 * qblk + r32;
    bf16x8 qf[16];
    { const bf16* qp = XQ + token * 1024 + h * 256 + 8 * hh;
#pragma unroll
      for (int kk = 0; kk < 16; ++kk) qf[kk] = __builtin_bit_cast(bf16x8, *(const v4u*)(qp + 16 * kk)); }
    f32x16 s[8];
#pragma unroll
    for (int kt = 0; kt < 8; ++kt) {
        s[kt] = zero16();
        const bf16* kp = Kb + (size_t)(b * 256 + 32 * kt + tau32(r32)) * 1024 + h * 256 + 8 * hh;
#pragma unroll
        for (int kk = 0; kk < 16; ++kk) { const bf16x8 Af = __builtin_bit_cast(bf16x8, *(const v4u*)(kp + 16 * kk)); s[kt] = MFMA32(Af, qf[kk], s[kt]); }
    }
    float mx = -3.0e38f;
#pragma unroll
    for (int kt = 0; kt < 8; ++kt)
#pragma unroll
        for (int rg = 0; rg < 16; ++rg) mx = fmaxf(mx, s[kt][rg]);
    mx = fmaxf(mx, __shfl_xor(mx, 32));
    float sum = 0.f; constexpr float C2 = 0.0625f * 1.4426950408889634f;
#pragma unroll
    for (int kt = 0; kt < 8; ++kt)
#pragma unroll
        for (int rg = 0; rg < 16; ++rg) { const float p = __builtin_amdgcn_exp2f((s[kt][rg] - mx) * C2); s[kt][rg] = p; sum += p; }
    sum += __shfl_xor(sum, 32);
    const float inv = 1.0f / sum;
    bf16x8 pf[8][2];
#pragma unroll
    for (int kt = 0; kt < 8; ++kt) { pf[kt][0] = pack8(s[kt], 0); pf[kt][1] = pack8(s[kt], 1); }
    bf16* yp = XQ + token * 1024 + h * 256 + 4 * hh;
#pragma unroll 1
    for (int dt = 0; dt < 8; ++dt) {
        f32x16 o = zero16();
        const bf16* vp = VTg + (size_t)(h * 256 + 32 * dt + r32) * 2048 + b * 256 + 8 * hh;
#pragma unroll
        for (int kt = 0; kt < 8; ++kt)
#pragma unroll
            for (int s2 = 0; s2 < 2; ++s2) { const bf16x8 Af = __builtin_bit_cast(bf16x8, *(const v4u*)(vp + 32 * kt + 16 * s2)); o = MFMA32(Af, pf[kt][s2], o); }
#pragma unroll
        for (int g4 = 0; g4 < 4; ++g4) { v2u w; w.x = cvtpk(o[4 * g4] * inv, o[4 * g4 + 1] * inv); w.y = cvtpk(o[4 * g4 + 2] * inv, o[4 * g4 + 3] * inv);
            *(v2u*)(yp + 32 * dt + 8 * g4) = w; }
    }
}

__device__ __forceinline__ void glr_tile(int tile, const bf16* XB, const bf16* Wg, const float* ss, float* GLR, int lane) {
    const int r16 = lane & 15, q4 = lane >> 4;
    const bf16* ap = XB + (size_t)(16 * tile + r16) * D + 8 * q4; const bf16* bp = Wg + (size_t)r16 * D + 8 * q4;
    f32x4 acc = (f32x4){0.f, 0.f, 0.f, 0.f};
#pragma unroll 8
    for (int kk = 0; kk < 64; ++kk) {
        const bf16x8 Af = __builtin_bit_cast(bf16x8, *(const v4u*)(ap + 32 * kk)), Bf = __builtin_bit_cast(bf16x8, *(const v4u*)(bp + 32 * kk));
        acc = __builtin_amdgcn_mfma_f32_16x16x32_bf16(Af, Bf, acc, 0, 0, 0);
    }
#pragma unroll
    for (int j = 0; j < 4; ++j) { const int token = 16 * tile + 4 * q4 + j; const float s = 1.0f / sqrtf(ss[token] * (1.0f / D) + EPS); GLR[(size_t)token * 16 + r16] = acc[j] * s; }
}

__global__ void __launch_bounds__(NTHREADS, 2) mk_fwd(Args args) {
    extern __shared__ __attribute__((aligned(16))) unsigned char lds_raw[];
    LAS unsigned char* lds = (LAS unsigned char*)lds_raw;
    const int wave = __builtin_amdgcn_readfirstlane((int)threadIdx.x >> 6);
#define CUR_LANE() lane_now()
    const int G = gridDim.x, bx = blockIdx.x;
    unsigned char* ws = args.ws;
    unsigned* ctl = (unsigned*)(ws + WS_CTL);
    volatile LAS unsigned* MISC = (volatile LAS unsigned*)(lds + MISC_OFF);
    for (int u = wave * 64 + CUR_LANE(); u < (LDS_BYTES - RING_BYTES) / 4; u += NTHREADS) ((LAS unsigned*)(lds + RING_BYTES))[u] = 0u;
    __syncthreads();
#if MK_PER_PHASE
#define GRID_BAR() do {} while (0)
#else
    XcdBarrier bar = xcd_barrier_post(ctl + CW_BAR, MISC + 8, wave == 0 && CUR_LANE() == 0);
#define GRID_BAR() xcd_barrier(bar, wave == 0 && lane_now() == 0)
#endif
    const int lo = args.ph_lo, hi = args.ph_hi;
#if MK_STAMP
    if (bx == 0 && wave == 0 && CUR_LANE() == 0) ((unsigned long long*)(ws + CTL_DBG))[32 + 20] = __builtin_amdgcn_s_memrealtime();
#endif
#define IN(k) (lo <= (k) && (k) < hi)
#define PHASE_LANE const int tid = wave * 64 + lane_now(); const int lane = tid & 63; (void)lane
#if MK_STAMP
#define SEAM(k) do { if (IN((k) + 1)) GRID_BAR(); if (bx == 0 && wave == 0 && CUR_LANE() == 0) ((unsigned long long*)(ws + CTL_DBG))[32 + (k)] = __builtin_amdgcn_s_memrealtime(); } while (0)
#else
#define SEAM(k) do { if (IN((k) + 1)) GRID_BAR(); } while (0)
#endif

    const float* x = args.in[I_X]; float* out = args.out;
    float* SS1 = (float*)(ws + CTL_SS1); float* SS2 = (float*)(ws + CTL_SS2); float* SS0 = (float*)(ws + CTL_SS0); float* SS3 = (float*)(ws + CTL_SS3);
    float* GLR = (float*)(ws + WS_GLR); float* ADEC = (float*)(ws + WS_ADEC);
    bf16* WGLR = (bf16*)(ws + WS_WGLR); bf16* KB = (bf16*)(ws + WS_KB); bf16* VTG = (bf16*)(ws + WS_VT); bf16* MEMB = (bf16*)(ws + WS_MEMB);
    bf16* WGU1 = (bf16*)(ws + WS_WGU1); bf16* WD1 = (bf16*)(ws + WS_WD1); bf16* WIN = (bf16*)(ws + WS_WIN); bf16* WKV = (bf16*)(ws + WS_WKV);
    bf16* WBR = (bf16*)(ws + WS_WB); bf16* WO = (bf16*)(ws + WS_WO); bf16* WGU2 = (bf16*)(ws + WS_WGU2); bf16* WD2 = (bf16*)(ws + WS_WD2);
    bf16* XB = (bf16*)(ws + WS_XB); bf16* ACT = (bf16*)(ws + WS_ACT);
    bf16* Qb = (bf16*)(ws + WS_Q); bf16* Kt = (bf16*)(ws + WS_K); bf16* Vb = (bf16*)(ws + WS_V); bf16* Rb = (bf16*)(ws + WS_R);
    bf16* SUb = (bf16*)(ws + WS_SU); bf16* SVb = (bf16*)(ws + WS_SV); bf16* XQb = (bf16*)(ws + WS_XQ);
    bf16* MRG = (bf16*)(ws + WS_MRG); bf16* GA = (bf16*)(ws + WS_WGU1); bf16* GB = (bf16*)(ws + WS_G); bf16* US = (bf16*)(ws + WS_G);
    const int gw = bx * NWAVES + wave, NGW = G * NWAVES;
    unsigned char* XB8 = (unsigned char*)out;
    unsigned char* WG8 = (unsigned char*)out + (size_t)M * D;
    const ConvCtx cvx{args.in, ws, WG8};

    if (IN(0)) {
      PHASE_LANE;
      for (int rep = 0; rep < (MK_DUP == 0 ? 2 : 1); ++rep) {
        for (int it = bx; it < CONV_EARLY; it += G) { ConvItem ci; f32x4 v[16]; conv_early(cvx, it, wave, ci); conv_issue(ci, v, lane); conv_finish(ci, v, lane); }
        for (int i = bx * NTHREADS + tid; i < 16 * D; i += G * NTHREADS) { const int r = i / D, k = i % D; WGLR[i] = f2bf(args.in[I_WIN][(size_t)k * INW + 3072 + r] * args.in[I_MIXN][k]); }
        for (int m = gw; m < M; m += NGW) row_to_bf16_ss(x + (size_t)m * D, XB + (size_t)m * D, SS0 + m, lane);
        for (int m = gw; m < MROWS; m += NGW) rms_row_to_bf16(args.in[I_MEM] + (size_t)m * D, args.in[I_MEMN], MEMB + (size_t)m * D, lane);
        __syncthreads();
      }
        SEAM(0);
    }
    if (IN(1)) {
        P1Sched S{(unsigned)WS_XB, (unsigned)WS_WGU1, (unsigned)WS_MEMB, (unsigned)WS_WKV, G, bx};
        EpiGU E{ws, SS0, &cvx, bx, G};
        pg8::gemm_phase(lds, ws, wave, D, D, D, S, E);
        if (bx >= 64) { PHASE_LANE; for (int it = CONV_EPI + (bx - 64); it < CONV_LATE; it += G - 64) { ConvItem ci; f32x4 v[16]; conv_late(cvx, it, wave, ci); conv_issue(ci, v, lane); conv_finish(ci, v, lane); } }
        if (MK_DUP == 1) pg8::gemm_phase(lds, ws, wave, D, D, D, S, E);
        SEAM(1);
    }
    if (IN(2)) {
        GridSched S{(unsigned)WS_ACT, (unsigned)WS_WD1, 256u * DFF * 2u, 256u * DFF * 2u, 64, 8, G, bx};
        EpiRes E{XB, SS1, 0.5f, XB8};
        pg8::gemm_phase(lds, ws, wave, DFF, DFF, DFF, S, E);
        SEAM(2);
    }
    if (IN(3)) {
        GridSched S{(unsigned)WS_XB, (unsigned)WS_WIN, 256u * D * 2u, 256u * D * 2u, 64, 24, G, bx};
        EpiProj E{SS1, ws};
        pg8::gemm_phase(lds, ws, wave, D, D, D, S, E);
        { GridSched S8{0u, (unsigned)((size_t)M * D), 256u * D, 256u * D, 64, 8, G, bx};
          EpiGate E8{SS1, GA, 1.0f / WG8_SCALE};
          pg8::gemm_phase<EpiGate, GridSched, false, true>(lds, out, wave, D / 2, D / 2, D / 2, S8, E8); }
        if (MK_DUP == 3) pg8::gemm_phase(lds, ws, wave, D, D, D, S, E);
        if (wave < 4) { PHASE_LANE; glr_tile(bx * 4 + wave, XB, WGLR, SS1, GLR, lane); }
        SEAM(3);
    }
    if (IN(4)) {
        PHASE_LANE;
        for (int i = 0; i < 4; ++i) gla_step1(lds, bx * 4 + i, Qb, Kt, Vb, GLR, args.in[I_GUP], args.in[I_GB], ADEC, US, wave, lane);
        for (int i = 0; i < 2; ++i) sg_unit(lds, bx * 2 + i, SUb, SVb, args.in[I_LNG], args.in[I_LNB], args.in[I_WS], args.in[I_BS], wave, lane);
        SEAM(4);
    }
    if (IN(5)) {
        PHASE_LANE;
        gla_scan(US, ADEC, bx * NTHREADS + tid);
        xa_task(bx * 8 + wave, XQb, KB, VTG, lane);
        SEAM(5);
    }
    if (IN(6)) {
        PHASE_LANE;
        for (int i = 0; i < 4; ++i) gla_step3(lds, bx * 4 + i, Qb, Kt, Vb, Rb, US, args.in[I_GON], wave, lane);
        SEAM(6);
    }
#pragma unroll
    for (int i = 0; i < 3; ++i) {
        if (IN(7 + i)) {
            bf16* Gcur = (i & 1) ? GB : GA; bf16* Gnxt = (i & 1) ? GA : GB;
            { GridSched S{(unsigned)(i == 0 ? WS_V : (i == 1 ? WS_SU : WS_XQ)), (unsigned)(WS_WB + (size_t)i * D * 1024 * 2), 256u * 1024u * 2u, 256u * 1024u * 2u, 64, 8, G, bx};
              EpiMerge E{Gcur, MRG, i == 0};
              pg8::gemm_phase(lds, ws, wave, 1024, 1024, 1024, S, E); }
            if (i < 2) {
              GridSched S{0u, (unsigned)((size_t)M * D + (size_t)(i + 1) * D * D), 256u * D, 256u * D, 64, 8, G, bx};
              EpiGate E{SS1, Gnxt, 1.0f / WG8_SCALE};
              pg8::gemm_phase<EpiGate, GridSched, false, true>(lds, out, wave, D / 2, D / 2, D / 2, S, E); }
            SEAM(7 + i);
        }
    }
    if (IN(10)) {
        GridSched S{(unsigned)WS_MRG, (unsigned)WS_WO, 256u * D * 2u, 256u * D * 2u, 64, 8, G, bx};
        EpiRes E{XB, SS2, 1.0f, nullptr};
        pg8::gemm_phase(lds, ws, wave, D, D, D, S, E);
        SEAM(10);
    }
    if (IN(11)) {
        GridSched S{(unsigned)WS_XB, (unsigned)WS_WGU2, 256u * D * 2u, 256u * D * 2u, 64, 44, G, bx};
        EpiGU E{ws, SS2, nullptr, 0, 0};
#if MK_STAMP
        unsigned long long* stp = (unsigned long long*)(ws + CTL_DBG) + (bx == 37 ? 0 : 8);
        const unsigned long long c0 = __builtin_amdgcn_s_memtime(), r0 = __builtin_amdgcn_s_memrealtime();
        pg8::gemm_phase<EpiGU, GridSched, true>(lds, ws, wave, D, D, D, S, E, stp);
        const unsigned long long c1 = __builtin_amdgcn_s_memtime(), r1 = __builtin_amdgcn_s_memrealtime();
        if (wave == 0 && CUR_LANE() == 0) { stp[3] = c1 - c0; stp[4] = r1 - r0; }
#else
        pg8::gemm_phase(lds, ws, wave, D, D, D, S, E);
#endif
        if (MK_DUP == 14) pg8::gemm_phase(lds, ws, wave, D, D, D, S, E);
        SEAM(11);
    }
    if (IN(12)) {
        GridSched S{(unsigned)WS_ACT, (unsigned)WS_WD2, 256u * DFF * 2u, 256u * DFF * 2u, 64, 8, G, bx};
        EpiRes E{XB, SS3, 0.5f, nullptr};
        pg8::gemm_phase(lds, ws, wave, DFF, DFF, DFF, S, E);
        SEAM(12);
    }
    if (IN(13)) {
        PHASE_LANE;
        const float* fg = args.in[I_FN];
        for (int m = gw; m < M; m += NGW) {
            const GAS v4u* xr = (const GAS v4u*)(XB + (size_t)m * D) + lane; GAS f32x4* orow = (GAS f32x4*)(out + (size_t)m * D); const GAS f32x4* gr = (const GAS f32x4*)fg;
            const float rs = 1.0f / sqrtf(SS3[m] * (1.0f / D) + EPS);
#pragma unroll
            for (int j = 0; j < 4; ++j) { const v4u w = xr[64 * j]; const int c = (64 * j + lane) * 2; const f32x4 g0 = gr[c], g1 = gr[c + 1];
                orow[c] = (f32x4){bflo(w.x) * rs * g0.x, bfhi(w.x) * rs * g0.y, bflo(w.y) * rs * g0.z, bfhi(w.y) * rs * g0.w};
                orow[c + 1] = (f32x4){bflo(w.z) * rs * g1.x, bfhi(w.z) * rs * g1.y, bflo(w.w) * rs * g1.z, bfhi(w.w) * rs * g1.w}; }
        }
#if MK_STAMP
        { const unsigned long long* stp = (const unsigned long long*)(ws + CTL_DBG);
          const float kc = (float)stp[0], ec = (float)stp[1], nun = (float)stp[2], cyc = (float)stp[3], rt = (float)stp[4];
          float c = 0.f;
          if (MK_STAMP == 1) c = floorf(4.0f * log2f(cyc / rt * 100.0f)) - 36.0f;
          if (MK_STAMP == 2) c = floorf(12.0f * log2f(kc / (nun * 32.0f))) - 120.0f;
          if (MK_STAMP == 3) c = floorf(8.0f * log2f(ec / nun)) - 90.0f;
          if (MK_STAMP == 4) c = floorf(12.0f * log2f(cyc / nun)) - 180.0f;
          if (MK_STAMP == 5) { const float us = (float)(stp[32 + MK_STAMP_B] - stp[32 + MK_STAMP_A]) * 0.01f; c = floorf(12.0f * log2f(us)) - 50.0f; }
          __syncthreads();
          for (int m = gw; m < M; m += NGW) { GAS f32x4* xr = (GAS f32x4*)(out + (size_t)m * D) + lane;
#pragma unroll
              for (int j = 0; j < 8; ++j) xr[64 * j] = (f32x4){c, c, c, c}; } }
#endif
    }
#undef IN
#undef SEAM
}
constexpr int LAST_PHASE = 14;


#if MK_DEBUG
constexpr size_t WS_DBG = 548 * MiB;
constexpr size_t DBG_SAVE = WS_DBG;
constexpr size_t DBG_QREF = WS_DBG + 2 * MiB, DBG_KREF = WS_DBG + 3 * MiB, DBG_VREF = WS_DBG + 4 * MiB, DBG_OREF = WS_DBG + 6 * MiB, DBG_AREF = WS_DBG + 8 * MiB;
constexpr int NSAVE = 64;
__device__ __forceinline__ unsigned hsh(unsigned a) { a ^= a >> 16; a *= 0x7feb352dU; a ^= a >> 15; a *= 0x846ca68bU; a ^= a >> 16; return a; }
__device__ __forceinline__ int save_row(int i) { return (int)(hsh(1000u + i) % M); }
__device__ __forceinline__ float block_sum(float v) {
    __shared__ float red[4]; __shared__ float tot;
    v = wave_sum(v); __syncthreads(); if ((threadIdx.x & 63) == 0) red[threadIdx.x >> 6] = v; __syncthreads();
    if (threadIdx.x == 0) tot = (red[0] + red[1]) + (red[2] + red[3]); __syncthreads(); return tot;
}
__device__ __forceinline__ float block_max(float v) {
    __shared__ float redm[4]; __shared__ float totm;
#pragma unroll
    for (int o = 1; o < 64; o <<= 1) v = fmaxf(v, __shfl_xor(v, o));
    __syncthreads(); if ((threadIdx.x & 63) == 0) redm[threadIdx.x >> 6] = v; __syncthreads();
    if (threadIdx.x == 0) totm = fmaxf(fmaxf(redm[0], redm[1]), fmaxf(redm[2], redm[3])); __syncthreads(); return totm;
}
__device__ __forceinline__ void dbg_add(float* dbg, int id, float got, float exp) { const float d = got - exp; atomicAdd(dbg + 2 * id, d * d); atomicAdd(dbg + 2 * id + 1, exp * exp); }
__device__ __forceinline__ float bdot(const bf16* a, const float* w, int ldw, int K, const float* gain) {
    float s = 0.f; for (int k = threadIdx.x; k < K; k += 256) s += bf2f(a[k]) * w[(size_t)k * ldw] * (gain ? gain[k] : 1.0f); return block_sum(s);
}
__device__ __forceinline__ float geluf_(float v) { return 0.5f * v * (1.0f + erff(v * 0.70710678f)); }
__device__ __forceinline__ float rsof(const float* ss, int r) { return 1.0f / sqrtf(ss[r] * (1.0f / D) + EPS); }

__global__ void chk_wt(const bf16* WT, int ldk, int nrows, const float* src, const float* src2, int ldw, int mode, const float* gain, float* dbg, int id) {
    const unsigned i = blockIdx.x * 256 + threadIdx.x; const int n = hsh(i * 2 + 1) % nrows, k = hsh(i * 2 + 2) % ldk;
    const float* s = src; int col = n;
    if (mode == 1) { const int tile = n / 256, w = n % 256; s = w < 128 ? src : src2; col = 128 * tile + (w & 127); }
    if (mode == 2) col = n < 3072 ? n : n + 16;
    if (mode == 3) col = 3072 + n;
    dbg_add(dbg, id, bf2f(WT[(size_t)n * ldk + k]), s[(size_t)k * ldw + col] * (gain ? gain[k] : 1.0f));
}
__global__ void chk_rms(const float* x, const float* gain, const bf16* xb, int nrows, float* dbg, int id) {
    const int r = hsh(77u + blockIdx.x) % nrows; float s = 0.f;
    for (int k = threadIdx.x; k < D; k += 256) { const float v = x[(size_t)r * D + k]; s += v * v; }
    const float rs = 1.0f / sqrtf(block_sum(s) * (1.0f / D) + EPS);
    for (int k = threadIdx.x; k < D; k += 256) dbg_add(dbg, id, bf2f(xb[(size_t)r * D + k]), x[(size_t)r * D + k] * rs * gain[k]);
}
__global__ void chk_act(const bf16* XBp, const float* wg, const float* wu, const float* gain, const float* ss, const bf16* ACTp, float* dbg, int id) {
    const int row = hsh(3u * blockIdx.x + 11u) % M, hid = hsh(3u * blockIdx.x + 12u) % DFF;
    float g = bdot(XBp + (size_t)row * D, wg + hid, DFF, D, gain), u = bdot(XBp + (size_t)row * D, wu + hid, DFF, D, gain);
    if (ss) { const float s = rsof(ss, row); g *= s; u *= s; }
    if (threadIdx.x == 0) dbg_add(dbg, id, bf2f(ACTp[(size_t)row * DFF + hid]), g / (1.0f + expf(-g)) * u);
}
__global__ void chk_kv(const bf16* MEMBp, const float* wkv, const bf16* KBp, const bf16* VTp, float* dbg, int idk, int idv) {
    const int row = hsh(5u * blockIdx.x + 1u) % MROWS, col = hsh(5u * blockIdx.x + 2u) % 2048;
    const float v = bdot(MEMBp + (size_t)row * D, wkv + col, D, D, nullptr);
    if (threadIdx.x == 0) { if (col < 1024) dbg_add(dbg, idk, bf2f(KBp[(size_t)row * 1024 + col]), v); else dbg_add(dbg, idv, bf2f(VTp[(size_t)(col - 1024) * 2048 + row]), v); }
}
__global__ void save_rows(const float* src, float* dst) { const int r = save_row(blockIdx.x); for (int k = threadIdx.x; k < D; k += 256) dst[(size_t)blockIdx.x * D + k] = src[(size_t)r * D + k]; }
__global__ void chk_res(const float* base, int base_saved, const bf16* a, int K, const float* w, float alpha, const float* outp, const bf16* xb, float* dbg, int id, int idb) {
    const int si = blockIdx.x % NSAVE, row = save_row(si), col = hsh(7u * blockIdx.x + 3u) % D;
    const float b = base_saved ? base[(size_t)si * D + col] : base[(size_t)row * D + col];
    const float v = b + alpha * bdot(a + (size_t)row * K, w + col, D, K, nullptr);
    if (threadIdx.x == 0) { dbg_add(dbg, id, outp[(size_t)row * D + col], v); if (xb) dbg_add(dbg, idb, bf2f(xb[(size_t)row * D + col]), v); }
}
__global__ void chk_ss(const float* outp, const float* ss, float* dbg, int id) {
    const int row = hsh(91u + blockIdx.x) % M; float s = 0.f;
    for (int k = threadIdx.x; k < D; k += 256) { const float v = outp[(size_t)row * D + k]; s += v * v; }
    s = block_sum(s); if (threadIdx.x == 0) dbg_add(dbg, id, ss[row], s);
}
__global__ void chk_proj(const bf16* XBp, const float* win, const float* mixn, const float* ss, const unsigned char* ws, float* dbg, int id, int idg) {
    const int row = hsh(9u * blockIdx.x + 1u) % M, j = hsh(9u * blockIdx.x + 2u) % (NPROJ + 16);
    const int srccol = j < 3072 ? j : (j < NPROJ ? j + 16 : 3072 + (j - NPROJ));
    float v = rsof(ss, row) * bdot(XBp + (size_t)row * D, win + srccol, INW, D, mixn);
    if (threadIdx.x != 0) return;
    if (j >= NPROJ) { dbg_add(dbg, idg, ((const float*)(ws + WS_GLR))[(size_t)row * 16 + (j - NPROJ)], v); return; }
    float got;
    if (j < 512) got = bf2f(((const bf16*)(ws + WS_Q))[(size_t)row * 512 + j]);
    else if (j < 1024) got = bf2f(((const bf16*)(ws + WS_K))[(size_t)row * 512 + j - 512]);
    else if (j < 2048) got = bf2f(((const bf16*)(ws + WS_V))[(size_t)row * 1024 + j - 1024]);
    else if (j < 3072) got = bf2f(((const bf16*)(ws + WS_R))[(size_t)row * 1024 + j - 2048]);
    else if (j < 4096) { got = bf2f(((const bf16*)(ws + WS_SU))[(size_t)row * 1024 + j - 3072]); v = geluf_(v); }
    else if (j < 5120) { got = bf2f(((const bf16*)(ws + WS_SV))[(size_t)row * 1024 + j - 4096]); v = geluf_(v); }
    else got = bf2f(((const bf16*)(ws + WS_XQ))[(size_t)row * 1024 + j - 5120]);
    dbg_add(dbg, id, got, v);
}
__global__ void chk_sg(const bf16* XBp, const float* win, const float* mixn, const float* ss, const bf16* SVp, const bf16* Ysg, const float* lng, const float* lnb, const float* wsp, const float* bsp, float* dbg, int id) {
    const int tok = hsh(13u * blockIdx.x + 1u) % M, g = hsh(13u * blockIdx.x + 2u) % 4, c = hsh(13u * blockIdx.x + 3u) % 256;
    const int t = tok % 128, tok0 = tok - t;
    const float su = geluf_(rsof(ss, tok) * bdot(XBp + (size_t)tok * D, win + 3088 + g * 256 + c, INW, D, mixn));
    float part = 0.f;
    if (threadIdx.x <= t && threadIdx.x < 128) { const int s = threadIdx.x; const bf16* p = SVp + (size_t)(tok0 + s) * 1024 + g * 256; float s1 = 0.f, s2 = 0.f;
        for (int k = 0; k < 256; ++k) { const float v = bf2f(p[k]); s1 += v; s2 += v * v; }
        const float mu = s1 / 256.0f, var = fmaxf(s2 / 256.0f - mu * mu, 0.f);
        const float vn = (bf2f(p[c]) - mu) / sqrtf(var + EPS) * lng[g * 256 + c] + lnb[g * 256 + c];
        part = wsp[((size_t)g * 128 + t) * 128 + s] * vn; }
    const float acc = block_sum(part);
    if (threadIdx.x == 0) dbg_add(dbg, id, bf2f(Ysg[(size_t)tok * 1024 + g * 256 + c]), su * (acc + bsp[g * 128 + t]));
}
__global__ void chk_xa(const bf16* XBp, const float* win, const float* mixn, const float* ss, const bf16* KBp, const bf16* VTp, const bf16* Yxa, float* dbg, int id) {
    __shared__ float qsh[256];
    const int tok = hsh(17u * blockIdx.x + 1u) % M, h = hsh(17u * blockIdx.x + 2u) % 4, e = hsh(17u * blockIdx.x + 3u) % 256, b = tok / SEQ;
    { const int d = threadIdx.x; float s = 0.f; const bf16* a = XBp + (size_t)tok * D; const float* w = win + 5136 + h * 256 + d;
      for (int k = 0; k < D; ++k) s += bf2f(a[k]) * w[(size_t)k * INW] * mixn[k];
      qsh[d] = s * rsof(ss, tok); }
    __syncthreads();
    const int m = threadIdx.x; float sc = 0.f; const bf16* kp = KBp + (size_t)(b * 256 + m) * 1024 + h * 256;
    for (int d = 0; d < 256; ++d) sc += qsh[d] * bf2f(kp[d]);
    sc *= 0.0625f;
    const float mx = block_max(sc), p = expf(sc - mx), sum = block_sum(p);
    const float o = block_sum(p * bf2f(VTp[(size_t)(h * 256 + e) * 2048 + b * 256 + m])) / sum;
    if (threadIdx.x == 0) dbg_add(dbg, id, bf2f(Yxa[(size_t)tok * 1024 + h * 256 + e]), o);
}
__global__ void gla_refA(const bf16* XBp, const float* win, const float* mixn, const float* ss, const float* GLRp, const float* wup, const float* gbias, int b, int h, float* qref, float* kref, float* vref, float* aref) {
    const int t = blockIdx.x, tok = b * SEQ + t; const bf16* a = XBp + (size_t)tok * D; const float rs = rsof(ss, tok);
    for (int o = threadIdx.x; o < 512; o += 256) {
        const int srccol = o < 128 ? h * 128 + o : (o < 256 ? 512 + h * 128 + (o - 128) : 1024 + h * 256 + (o - 256));
        float s = 0.f; const float* w = win + srccol; for (int k = 0; k < D; ++k) s += bf2f(a[k]) * w[(size_t)k * INW] * mixn[k];
        s *= rs; if (o < 128) qref[t * 128 + o] = s; else if (o < 256) kref[t * 128 + o - 128] = s; else vref[t * 256 + o - 256] = s;
    }
    if (threadIdx.x < 128) { const int d = threadIdx.x; float z = gbias[h * 128 + d]; for (int r = 0; r < 16; ++r) z += GLRp[(size_t)tok * 16 + r] * wup[r * 512 + h * 128 + d];
        const float ls = fminf(z, 0.f) - log1pf(expf(-fabsf(z))); aref[t * 128 + d] = expf(ls / 16.0f); }
}
__global__ void gla_refB(const float* qref, const float* kref, const float* vref, const float* aref, float* oref) {
    const int e = blockIdx.x, d = threadIdx.x & 127; const bool act = threadIdx.x < 128; float S = 0.f;
    for (int t = 0; t < SEQ; ++t) { float p = 0.f; if (act) { S = aref[t * 128 + d] * S + kref[t * 128 + d] * vref[t * 256 + e]; p = qref[t * 128 + d] * GLA_SCALE * S; }
        const float o = block_sum(p); if (threadIdx.x == 0) oref[t * 256 + e] = o; }
}
__global__ void gla_refC(const float* oref, const bf16* Rp, const bf16* Ygla, const float* onorm, int b, int h, float* dbg, int id) {
    const int t = blockIdx.x, e = threadIdx.x, tok = b * SEQ + t; const float o = oref[t * 256 + e];
    const float rs = 1.0f / sqrtf(block_sum(o * o) / 256.0f + EPS); const float r = bf2f(Rp[(size_t)tok * 1024 + h * 256 + e]);
    dbg_add(dbg, id, bf2f(Ygla[(size_t)tok * 1024 + h * 256 + e]), o * rs * onorm[h * 256 + e] * (r / (1.0f + expf(-r))));
}
__global__ void chk_gate(const bf16* XBp, const float* win, const float* mixn, const float* ss, const bf16* GTp, int i, float* dbg, int id) {
    const int row = hsh(19u * blockIdx.x + 1u) % M, col = hsh(19u * blockIdx.x + 2u) % D;
    const float v = rsof(ss, row) * bdot(XBp + (size_t)row * D, win + 6160 + i * D + col, INW, D, mixn);
    if (threadIdx.x == 0) dbg_add(dbg, id, bf2f(GTp[(size_t)row * D + col]), 1.0f / (1.0f + expf(-v)));
}
__global__ void chk_mrg(const bf16* XBp, const float* win, const float* mixn, const float* ss, const bf16* Y0, const bf16* Y1, const bf16* Y2, const float* wbr, const bf16* MRGp, float* dbg, int id) {
    const int row = hsh(23u * blockIdx.x + 1u) % M, col = hsh(23u * blockIdx.x + 2u) % D; float tot = 0.f;
    for (int i = 0; i < 3; ++i) { const float gp = rsof(ss, row) * bdot(XBp + (size_t)row * D, win + 6160 + i * D + col, INW, D, mixn);
        const bf16* Y = i == 0 ? Y0 : (i == 1 ? Y1 : Y2); const float z = bdot(Y + (size_t)row * 1024, wbr + (size_t)i * 1024 * D + col, D, 1024, nullptr);
        tot += z / (1.0f + expf(-gp)); }
    if (threadIdx.x == 0) dbg_add(dbg, id, bf2f(MRGp[(size_t)row * D + col]), tot);
}
__global__ void chk_final(const float* saved, const float* fn, const float* outp, float* dbg, int id) {
    const int si = blockIdx.x, row = save_row(si); float s = 0.f;
    for (int k = threadIdx.x; k < D; k += 256) { const float v = saved[(size_t)si * D + k]; s += v * v; }
    const float rs = 1.0f / sqrtf(block_sum(s) * (1.0f / D) + EPS);
    for (int k = threadIdx.x; k < D; k += 256) dbg_add(dbg, id, outp[(size_t)row * D + k], saved[(size_t)si * D + k] * rs * fn[k]);
}
__global__ void dbg_report(const float* dbg, float* outp, int nchk, int only) {
    int bad = -1;
    for (int k = 0; k < nchk; ++k) { const float num = dbg[2 * k], den = dbg[2 * k + 1]; if (num == 0.f && den == 0.f) continue; if (!(num < 1e-3f * den)) { bad = k; break; } }
    if (only >= 0) { const float num = dbg[2 * only], den = dbg[2 * only + 1]; bad = -1; if (!(num < 1e-3f * den)) bad = only; }
    if (bad < 0) return;
    const float c = (float)(bad + 2);
    for (size_t i = (size_t)blockIdx.x * 256 + threadIdx.x; i < (size_t)M * D; i += (size_t)gridDim.x * 256) outp[i] = c;
}
#endif

extern "C" void kernel_launch(void* const* d_in, const int* in_sizes, int n_in, void* d_out, int out_size, void* d_ws, size_t ws_size, hipStream_t stream) {
    static int grid = 0;
    if (grid == 0) {
        if (n_in != N_IN || in_sizes[0] != M * D || out_size != M * D || ws_size < WS_END) {
            fprintf(stderr, "kernel_launch: unexpected problem (n_in %d, in0 %d, out %d, ws %zu, need %zu); nothing launched\n", n_in, n_in > 0 ? in_sizes[0] : -1, out_size, ws_size, (size_t)WS_END); grid = -1; return; }
        int dev = 0, cus = 0, per_cu = 0;
        if (hipGetDevice(&dev) != hipSuccess || hipDeviceGetAttribute(&cus, hipDeviceAttributeMultiprocessorCount, dev) != hipSuccess) { grid = -1; return; }
        if (hipFuncSetAttribute((const void*)mk_fwd, hipFuncAttributeMaxDynamicSharedMemorySize, LDS_BYTES) != hipSuccess) { fprintf(stderr, "kernel_launch: hipFuncSetAttribute failed\n"); grid = -1; return; }
        if (hipOccupancyMaxActiveBlocksPerMultiprocessor(&per_cu, (const void*)mk_fwd, NTHREADS, LDS_BYTES) != hipSuccess || per_cu < 1)
            fprintf(stderr, "kernel_launch: note: occupancy query reports %d workgroups per CU\n", per_cu);
        (void)hipGetLastError();
        if (cus < 256) { fprintf(stderr, "kernel_launch: %d CUs; this kernel needs 256 resident workgroups (one per CU); nothing launched\n", cus); grid = -1; return; }
        grid = 256;
    }
    if (grid < 0) return;
    if (hipMemsetAsync((char*)d_ws + WS_CTL, 0, CTL_ZERO_BYTES, stream) != hipSuccess) return;
    Args a{};
    for (int i = 0; i < N_IN; ++i) a.in[i] = (const float*)d_in[i];
    a.out = (float*)d_out; a.ws = (unsigned char*)d_ws;
#if MK_PER_PHASE
    for (int p = 0; p < LAST_PHASE; ++p) { a.ph_lo = p; a.ph_hi = p + 1; hipLaunchKernelGGL(mk_fwd, dim3(grid), dim3(NTHREADS), LDS_BYTES, stream, a);
#if MK_DEBUG
        unsigned char* ws = (unsigned char*)d_ws; float* dbg = (float*)(ws + CTL_DBG); const float** in = (const float**)a.in; float* outp = (float*)d_out;
        const bf16* XBp = (const bf16*)(ws + WS_XB); const float* SS1p = (const float*)(ws + CTL_SS1); const float* SS2p = (const float*)(ws + CTL_SS2);
        float* sv1 = (float*)(ws + DBG_SAVE); float* sv2 = sv1 + NSAVE * D; float* sv3 = sv2 + NSAVE * D;
        if (p == 0) {
            chk_rms<<<64, 256, 0, stream>>>(in[I_X], in[I_F1N], XBp, M, dbg, 0);
            chk_wt<<<64, 256, 0, stream>>>((const bf16*)(ws + WS_WGU1), D, NGU, in[I_F1G], in[I_F1U], DFF, 1, nullptr, dbg, 1);
            chk_wt<<<64, 256, 0, stream>>>((const bf16*)(ws + WS_WIN), D, 12288, in[I_WIN], nullptr, INW, 2, in[I_MIXN], dbg, 2);
            chk_wt<<<64, 256, 0, stream>>>((const bf16*)(ws + WS_WD1), DFF, D, in[I_F1D], nullptr, D, 0, nullptr, dbg, 3);
            chk_wt<<<64, 256, 0, stream>>>((const bf16*)(ws + WS_WKV), D, D, in[I_WKV], nullptr, D, 0, nullptr, dbg, 4);
            for (int i = 0; i < 3; ++i) chk_wt<<<32, 256, 0, stream>>>((const bf16*)(ws + WS_WB) + (size_t)i * D * 1024, 1024, D, in[I_WBR] + (size_t)i * 1024 * D, nullptr, D, 0, nullptr, dbg, 5);
            chk_wt<<<64, 256, 0, stream>>>((const bf16*)(ws + WS_WO), D, D, in[I_WOUT], nullptr, D, 0, nullptr, dbg, 6);
            chk_wt<<<64, 256, 0, stream>>>((const bf16*)(ws + WS_WGU2), D, NGU, in[I_F2G], in[I_F2U], DFF, 1, in[I_F2N], dbg, 7);
            chk_wt<<<64, 256, 0, stream>>>((const bf16*)(ws + WS_WD2), DFF, D, in[I_F2D], nullptr, D, 0, nullptr, dbg, 8);
            chk_rms<<<64, 256, 0, stream>>>(in[I_MEM], in[I_MEMN], (const bf16*)(ws + WS_MEMB), MROWS, dbg, 9);
            chk_wt<<<16, 256, 0, stream>>>((const bf16*)(ws + WS_WGLR), D, 16, in[I_WIN], nullptr, INW, 3, in[I_MIXN], dbg, 10);
        }
        if (p == 1) { chk_act<<<512, 256, 0, stream>>>(XBp, in[I_F1G], in[I_F1U], nullptr, nullptr, (const bf16*)(ws + WS_ACT), dbg, 11);
            chk_kv<<<512, 256, 0, stream>>>((const bf16*)(ws + WS_MEMB), in[I_WKV], (const bf16*)(ws + WS_KB), (const bf16*)(ws + WS_VT), dbg, 12, 13); }
        if (p == 2) { chk_res<<<512, 256, 0, stream>>>(in[I_X], 0, (const bf16*)(ws + WS_ACT), DFF, in[I_F1D], 0.5f, outp, XBp, dbg, 14, 15);
            chk_ss<<<64, 256, 0, stream>>>(outp, SS1p, dbg, 16); save_rows<<<NSAVE, 256, 0, stream>>>(outp, sv1); }
        if (p == 3) chk_proj<<<1024, 256, 0, stream>>>(XBp, in[I_WIN], in[I_MIXN], SS1p, ws, dbg, 17, 18);
        if (p == 6) {
            chk_sg<<<256, 256, 0, stream>>>(XBp, in[I_WIN], in[I_MIXN], SS1p, (const bf16*)(ws + WS_SV), (const bf16*)(ws + WS_SU), in[I_LNG], in[I_LNB], in[I_WS], in[I_BS], dbg, 19);
            chk_xa<<<256, 256, 0, stream>>>(XBp, in[I_WIN], in[I_MIXN], SS1p, (const bf16*)(ws + WS_KB), (const bf16*)(ws + WS_VT), (const bf16*)(ws + WS_XQ), dbg, 20);
            const int gb = 3, gh = 2; float* qr = (float*)(ws + DBG_QREF); float* kr = (float*)(ws + DBG_KREF); float* vr = (float*)(ws + DBG_VREF); float* orf = (float*)(ws + DBG_OREF); float* ar = (float*)(ws + DBG_AREF);
            gla_refA<<<SEQ, 256, 0, stream>>>(XBp, in[I_WIN], in[I_MIXN], SS1p, (const float*)(ws + WS_GLR), in[I_GUP], in[I_GB], gb, gh, qr, kr, vr, ar);
            gla_refB<<<256, 256, 0, stream>>>(qr, kr, vr, ar, orf);
            gla_refC<<<SEQ, 256, 0, stream>>>(orf, (const bf16*)(ws + WS_R), (const bf16*)(ws + WS_V), in[I_GON], gb, gh, dbg, 21);
        }
        if (p == 7 || p == 9 || p == 11) chk_gate<<<256, 256, 0, stream>>>(XBp, in[I_WIN], in[I_MIXN], SS1p, (const bf16*)(ws + WS_G), (p - 7) / 2, dbg, 22 + (p - 7) / 2);
        if (p == 12) chk_mrg<<<256, 256, 0, stream>>>(XBp, in[I_WIN], in[I_MIXN], SS1p, (const bf16*)(ws + WS_V), (const bf16*)(ws + WS_SU), (const bf16*)(ws + WS_XQ), in[I_WBR], (const bf16*)(ws + WS_MRG), dbg, 25);
        if (p == 13) { chk_res<<<512, 256, 0, stream>>>(sv1, 1, (const bf16*)(ws + WS_MRG), D, in[I_WOUT], 1.0f, outp, XBp, dbg, 26, 27);
            chk_ss<<<64, 256, 0, stream>>>(outp, SS2p, dbg, 28); save_rows<<<NSAVE, 256, 0, stream>>>(outp, sv2); }
        if (p == 14) chk_act<<<512, 256, 0, stream>>>(XBp, in[I_F2G], in[I_F2U], in[I_F2N], SS2p, (const bf16*)(ws + WS_ACT), dbg, 29);
        if (p == 15) { chk_res<<<512, 256, 0, stream>>>(sv2, 1, (const bf16*)(ws + WS_ACT), DFF, in[I_F2D], 0.5f, outp, nullptr, dbg, 30, 30); save_rows<<<NSAVE, 256, 0, stream>>>(outp, sv3); }
        if (p == 16) { chk_final<<<NSAVE, 256, 0, stream>>>(sv3, in[I_FN], outp, dbg, 31); dbg_report<<<1024, 256, 0, stream>>>(dbg, outp, 32, MK_DEBUG_ONLY); }
#endif
    }
#else
    a.ph_lo = 0; a.ph_hi = LAST_PHASE;
    hipLaunchKernelGGL(mk_fwd, dim3(grid), dim3(NTHREADS), LDS_BYTES, stream, a);
#endif
}
```

```cpp
#include <hip/hip_runtime.h>
#include <cstdio>
#include <cstdint>

#ifndef MK_PER_PHASE
#define MK_PER_PHASE 0
#endif
#ifndef MK_DEBUG
#define MK_DEBUG 0
#endif
#ifndef MK_STAMP
#define MK_STAMP 0
#endif
#ifndef MK_STAMP_A
#define MK_STAMP_A 20
#endif
#ifndef MK_STAMP_B
#define MK_STAMP_B 0
#endif
#ifndef MK_DUP
#define MK_DUP (-1)
#endif
#ifndef MK_DEBUG_ONLY
#define MK_DEBUG_ONLY (-1)
#endif

#define GAS __attribute__((address_space(1)))
#define LAS __attribute__((address_space(3)))
typedef unsigned short bf16;
typedef unsigned v4u __attribute__((ext_vector_type(4)));
typedef unsigned v2u __attribute__((ext_vector_type(2)));
typedef float f32x4 __attribute__((ext_vector_type(4)));
typedef float f32x2 __attribute__((ext_vector_type(2)));
typedef float f32x16 __attribute__((ext_vector_type(16)));
typedef short bf16x8 __attribute__((ext_vector_type(8)));
typedef __bf16 bf16x2_t __attribute__((ext_vector_type(2)));
typedef int v8i __attribute__((ext_vector_type(8)));
typedef int v4i __attribute__((ext_vector_type(4)));

constexpr int D = 2048, BATCH = 8, SEQ = 2048, M = BATCH * SEQ, MEMLEN = 256, MROWS = BATCH * MEMLEN;
constexpr int DFF = 5632, NGU = 2 * DFF;
constexpr int INW = 12304;
constexpr int NPROJ = 6144;
constexpr float EPS = 1e-6f;
constexpr int NWAVES = 8, NTHREADS = 512;

constexpr size_t MiB = 1u << 20;
constexpr size_t WS_CTL = 0, CTL_ZERO_BYTES = 1 * MiB;
constexpr size_t WS_GLR = 1 * MiB;
constexpr size_t WS_ADEC = 2 * MiB;
constexpr size_t WS_WGLR = 2 * MiB + 512 * 1024;
constexpr size_t WS_KB = 3 * MiB;
constexpr size_t WS_VT = 7 * MiB;
constexpr size_t WS_MEMB = 11 * MiB;
constexpr size_t WS_WGU1 = 20 * MiB;
constexpr size_t WS_WD1 = 64 * MiB;
constexpr size_t WS_WIN = 86 * MiB;
constexpr size_t WS_WKV = 134 * MiB;
constexpr size_t WS_WB = 142 * MiB;
constexpr size_t WS_WO = 154 * MiB;
constexpr size_t WS_WGU2 = 162 * MiB;
constexpr size_t WS_WD2 = 206 * MiB;
constexpr size_t WS_XB = 228 * MiB;
constexpr size_t WS_C = 292 * MiB;
constexpr size_t WS_ACT = WS_C;
constexpr size_t WS_Q = WS_C;
constexpr size_t WS_K = WS_C + 16 * MiB;
constexpr size_t WS_V = WS_C + 32 * MiB;
constexpr size_t WS_SU = WS_C + 64 * MiB;
constexpr size_t WS_XQ = WS_C + 96 * MiB;
constexpr size_t WS_R = WS_C + 128 * MiB;
constexpr size_t WS_SV = WS_C + 160 * MiB;
constexpr size_t WS_MRG = WS_R;
constexpr size_t WS_G = WS_C + 192 * MiB;
constexpr size_t WS_END = WS_C + 256 * MiB;

constexpr int CW_TMO = 0;
constexpr int CW_BAR = 4096;
constexpr size_t CTL_SS1 = 128 * 1024, CTL_SS2 = 192 * 1024, CTL_SS0 = 320 * 1024, CTL_SS3 = 384 * 1024;
constexpr size_t CTL_DBG = 256 * 1024;

constexpr int RING_BYTES = 131072;
constexpr int MISC_OFF = RING_BYTES + 320;
constexpr int LDS_BYTES = 147456;

#define LDS_WAIT() asm volatile("s_waitcnt lgkmcnt(0)" ::: "memory")
#define VM_WAIT() asm volatile("s_waitcnt vmcnt(0)" ::: "memory")
__device__ __forceinline__ unsigned cvtpk(float lo, float hi) { f32x2 v = {lo, hi}; bf16x2_t b = __builtin_convertvector(v, bf16x2_t); return __builtin_bit_cast(unsigned, b); }
__device__ __forceinline__ int lane_now() { int l; asm volatile("v_mbcnt_lo_u32_b32 %0, -1, 0\n\tv_mbcnt_hi_u32_b32 %0, -1, %0" : "=v"(l)); return l; }
__device__ __forceinline__ unsigned cvt4_fp8(float a, float b, float c, float d) { int w = 0; w = __builtin_amdgcn_cvt_pk_fp8_f32(a, b, w, false); w = __builtin_amdgcn_cvt_pk_fp8_f32(c, d, w, true); return (unsigned)w; }
__device__ __forceinline__ float bflo(unsigned u) { return __builtin_bit_cast(float, u << 16); }
__device__ __forceinline__ float bfhi(unsigned u) { return __builtin_bit_cast(float, u & 0xffff0000u); }
__device__ __forceinline__ float bf2f(bf16 b) { return __builtin_bit_cast(float, (unsigned)b << 16); }
__device__ __forceinline__ bf16 f2bf(float f) { return (bf16)(cvtpk(f, 0.f) & 0xffffu); }
__device__ __forceinline__ float wave_sum(float v) {
#pragma unroll
    for (int o = 1; o < 64; o <<= 1) v += __shfl_xor(v, o);
    return v;
}
__device__ __forceinline__ float fast_exp(float x) { return __builtin_amdgcn_exp2f(x * 1.4426950408889634f); }
__device__ __forceinline__ float sigmoidf_(float x) { return __builtin_amdgcn_rcpf(1.0f + fast_exp(-x)); }

namespace pg8 {
constexpr int BM = 256, BK = 64, HALF = 128, HTB = HALF * BK * 2, STAGE_BYTES = 8 * HTB, NXCD = 8, WGM = 8;
__host__ __device__ __forceinline__ int lds_byte(int r, int c) { const int st = (r >> 4) * 2 + (c >> 5), rr = r & 15, cc = c & 31, ob = rr * 64 + cc * 2; return st * 1024 + (ob ^ (((ob >> 9) & 1) << 5)); }
__host__ __device__ __forceinline__ void stage_rc(int b, int& R, int& C) { const int st = b / 1024, sb = b % 1024, swz = sb ^ (((sb >> 9) & 1) << 5); R = (st >> 1) * 16 + swz / 64; C = (st & 1) * 32 + (swz % 64) / 2; }
__host__ __device__ __forceinline__ int perm32(int rho) { const int n = rho >> 4, i = rho & 15; return 8 * (i >> 2) + 4 * n + (i & 3); }

struct Unit { unsigned A, B; int pm, pn, kind, seq; };

__device__ __forceinline__ void tile_of(int L, int nM, int nN, int& pm, int& pn) {
    const int nwg = nM * nN;
    int wgid = L; { const int q = nwg / NXCD, r = nwg % NXCD, xcd = wgid % NXCD, off = wgid / NXCD; wgid = (xcd < r ? xcd * (q + 1) : r * (q + 1) + (xcd - r) * q) + off; }
    const int nig = WGM * nN, gid = wgid / nig, fm = gid * WGM, gsz = (nM - fm) < WGM ? (nM - fm) : WGM;
    pm = fm + ((wgid % nig) % gsz); pn = (wgid % nig) / gsz;
}

template <class Epi, class Sched, bool STAMP = false, bool FP8 = false>
__device__ __forceinline__ void gemm_phase(LAS unsigned char* lds, const void* base, const int wid, const int K, const int lda, const int ldb, const Sched& S, const Epi& E, unsigned long long* st = nullptr) {
    const __amdgpu_buffer_rsrc_t rsrc = __builtin_amdgcn_make_buffer_rsrc((void*)base, 0, 0x7fffffff, 0x00020000);
    unsigned long long kc = 0, ec = 0, t0 = 0; unsigned nun = 0;
    int tid = wid * 64 + lane_now();
    const int lane = tid & 63, wr = wid >> 2, wc = wid & 3, fr = lane & 15, fq = lane >> 4;
    const int nt = K / BK;
    unsigned voffA[2], voffB[2];
#pragma unroll
    for (int i = 0; i < 2; ++i) { int R, C; stage_rc(tid * 16 + i * 8192, R, C); const int Rb = (R & ~31) + perm32(R & 31);
        voffA[i] = (unsigned)(R * lda + C) * 2u; voffB[i] = (unsigned)(Rb * ldb + C) * 2u; }
    const unsigned kstep = (unsigned)(BK * 2);
    const unsigned hstepA = (unsigned)HALF * lda * 2u, hstepB = (unsigned)HALF * ldb * 2u;
    const unsigned ldsw = (unsigned)wid * 1024u;
    const int aoff = lds_byte(wr * 64 + fr, fq * 8), boff = lds_byte(wc * 32 + fr, fq * 8);
#define PG8_SA(b, h) (((b) * 2 + (h)) * HTB)
#define PG8_SB(b, h) ((4 + (b) * 2 + (h)) * HTB)
#define PG8_STAGE(bufoff, soff, voff) do { _Pragma("unroll") for (int _i = 0; _i < 2; ++_i) \
        __builtin_amdgcn_raw_ptr_buffer_load_lds(rsrc, (LAS void*)(lds + (bufoff) + ldsw + _i * 8192), 16, (int)(voff)[_i], (int)(soff), 0, 0); } while (0)
#define PG8_LDA(dst, b, h) do { _Pragma("unroll") for (int m = 0; m < 4; ++m) _Pragma("unroll") for (int k = 0; k < 2; ++k) dst[m][k] = *(const LAS bf16x8*)(lds + PG8_SA(b, h) + aoff + m * 2048 + k * 1024); } while (0)
#define PG8_LDB(dst, b, h) do { _Pragma("unroll") for (int n = 0; n < 2; ++n) _Pragma("unroll") for (int k = 0; k < 2; ++k) dst[n][k] = *(const LAS bf16x8*)(lds + PG8_SB(b, h) + boff + n * 2048 + k * 1024); } while (0)
#define PG8_MMA(ai, bj, At, Bt) do { __builtin_amdgcn_s_setprio(1); _Pragma("unroll") for (int m = 0; m < 4; ++m) _Pragma("unroll") for (int n = 0; n < 2; ++n) { \
        if constexpr (FP8) { const v8i fb = __builtin_shufflevector(__builtin_bit_cast(v4i, Bt[n][0]), __builtin_bit_cast(v4i, Bt[n][1]), 0, 1, 2, 3, 4, 5, 6, 7), \
                                      fa = __builtin_shufflevector(__builtin_bit_cast(v4i, At[m][0]), __builtin_bit_cast(v4i, At[m][1]), 0, 1, 2, 3, 4, 5, 6, 7); \
            acc[ai][bj][m][n] = __builtin_amdgcn_mfma_scale_f32_16x16x128_f8f6f4(fb, fa, acc[ai][bj][m][n], 0, 0, 0, 0, 0, 0); }     \
        else { _Pragma("unroll") for (int k = 0; k < 2; ++k) acc[ai][bj][m][n] = __builtin_amdgcn_mfma_f32_16x16x32_bf16(Bt[n][k], At[m][k], acc[ai][bj][m][n], 0, 0, 0); } } \
        __builtin_amdgcn_s_setprio(0); } while (0)
#define PG8_WAIT_V(n) asm volatile("s_waitcnt vmcnt(" #n ")" ::: "memory")
#define PG8_WAIT_L(n) asm volatile("s_waitcnt lgkmcnt(" #n ")" ::: "memory")
#define PG8_BAR __builtin_amdgcn_s_barrier()
#define PG8_SCHED __builtin_amdgcn_sched_barrier(0)
    Unit cur, nxt; int ui = 0;
    if (!S.next(0, cur)) return;
    f32x4 acc[2][2][4][2];
#pragma unroll
    for (int a = 0; a < 2; ++a)
#pragma unroll
        for (int b = 0; b < 2; ++b)
#pragma unroll
            for (int m = 0; m < 4; ++m)
#pragma unroll
                for (int n = 0; n < 2; ++n) acc[a][b][m][n] = (f32x4){0.f, 0.f, 0.f, 0.f};
    bf16x8 At[4][2], B0[2][2], B1[2][2];
    unsigned cA = cur.A, cB = cur.B;
    PG8_STAGE(PG8_SB(0, 0), cB, voffB); PG8_STAGE(PG8_SB(0, 1), cB + hstepB, voffB); PG8_STAGE(PG8_SA(0, 0), cA, voffA); PG8_STAGE(PG8_SA(0, 1), cA + hstepA, voffA);
    if (wr == 1) PG8_BAR;
    PG8_WAIT_V(2); PG8_BAR;
    PG8_STAGE(PG8_SB(1, 0), cB + kstep, voffB); PG8_STAGE(PG8_SA(1, 0), cA + kstep, voffA); PG8_STAGE(PG8_SB(1, 1), cB + hstepB + kstep, voffB);
    PG8_WAIT_V(6); PG8_BAR;
    for (;;) {
        const bool has_next = S.next(ui + 1, nxt);
        const unsigned nA = has_next ? nxt.A : cA, nB = has_next ? nxt.B : cB;
        if (STAMP) t0 = __builtin_amdgcn_s_memtime();
        for (int t = 0; t < nt; t += 2) {
            const bool last = (t == nt - 2);
            const unsigned a1 = cA + (unsigned)(t + 1) * kstep;
            const unsigned a2 = last ? nA : cA + (unsigned)(t + 2) * kstep, b2 = last ? nB : cB + (unsigned)(t + 2) * kstep;
            const unsigned a3 = a2 + kstep, b3 = b2 + kstep;
            PG8_LDB(B0, 0, 0); PG8_LDB(B1, 0, 1); PG8_SCHED; PG8_LDA(At, 0, 0); PG8_STAGE(PG8_SA(1, 1), a1 + hstepA, voffA);
            PG8_WAIT_V(8); PG8_WAIT_L(0); PG8_BAR; PG8_MMA(0, 0, At, B0); PG8_MMA(0, 1, At, B1); PG8_BAR; PG8_SCHED;
            PG8_LDA(At, 0, 1); PG8_STAGE(PG8_SB(0, 0), b2, voffB); PG8_STAGE(PG8_SB(0, 1), b2 + hstepB, voffB); PG8_STAGE(PG8_SA(0, 0), a2, voffA);
            PG8_WAIT_V(8); PG8_WAIT_L(0); PG8_BAR; PG8_MMA(1, 0, At, B0); PG8_MMA(1, 1, At, B1); PG8_BAR; PG8_SCHED;
            PG8_LDB(B0, 1, 0); PG8_LDB(B1, 1, 1); PG8_SCHED; PG8_LDA(At, 1, 0); PG8_STAGE(PG8_SA(0, 1), a2 + hstepA, voffA);
            PG8_WAIT_V(8); PG8_WAIT_L(0); PG8_BAR; PG8_MMA(0, 0, At, B0); PG8_MMA(0, 1, At, B1); PG8_BAR; PG8_SCHED;
            PG8_LDA(At, 1, 1); PG8_STAGE(PG8_SB(1, 0), b3, voffB); PG8_STAGE(PG8_SB(1, 1), b3 + hstepB, voffB); PG8_STAGE(PG8_SA(1, 0), a3, voffA);
            PG8_WAIT_V(8); PG8_WAIT_L(0); PG8_BAR; PG8_MMA(1, 0, At, B0); PG8_MMA(1, 1, At, B1); PG8_BAR; PG8_SCHED;
        }
        if (STAMP) { const unsigned long long t1 = __builtin_amdgcn_s_memtime(); kc += t1 - t0; t0 = t1; }
        if (wr == 0) PG8_BAR;
        { int efr = fr, efq = fq; asm volatile("" : "+v"(efr), "+v"(efq));
          E(acc, cur, wr, wc, efr, efq); }
        if (STAMP) { asm volatile("s_waitcnt vmcnt(0)" ::: "memory"); const unsigned long long t1 = __builtin_amdgcn_s_memtime(); ec += t1 - t0; ++nun; }
        if (!has_next) break;
#pragma unroll
        for (int a = 0; a < 2; ++a)
#pragma unroll
            for (int b = 0; b < 2; ++b)
#pragma unroll
                for (int m = 0; m < 4; ++m)
#pragma unroll
                    for (int n = 0; n < 2; ++n) acc[a][b][m][n] = (f32x4){0.f, 0.f, 0.f, 0.f};
        cur = nxt; cA = nA; cB = nB; ++ui;
        if (wr == 1) PG8_BAR;
    }
    PG8_WAIT_V(0);
    PG8_BAR;
    if (STAMP && st && tid == 0) { st[0] = kc; st[1] = ec; st[2] = nun; }
#undef PG8_SA
#undef PG8_SB
#undef PG8_STAGE
#undef PG8_LDA
#undef PG8_LDB
#undef PG8_MMA
#undef PG8_WAIT_V
#undef PG8_WAIT_L
#undef PG8_BAR
#undef PG8_SCHED
}

__device__ __forceinline__ float gelu1(float v) {
    const float av = __builtin_fabsf(v), d = av * 0.2316418882f + 1.0f;
    const float t = __builtin_amdgcn_rcpf(d);
    float q = t * 0.5307027145f + (-0.7265760135f); q = q * t + 0.7107068705f; q = q * t + (-0.142248368f); q = q * t + 0.127414796f; q = q * t;
    const float e = __builtin_amdgcn_exp2f((v * v) * (-0.72134752044f));
    const float mm = v * (q * e), r = v - mm;
    return v < 0.f ? mm : r;
}
__device__ __forceinline__ f32x2 gelu_pk(f32x2 v) {
    const f32x2 av = __builtin_elementwise_abs(v), d = av * 0.2316418882f + 1.0f;
    f32x2 t; t.x = __builtin_amdgcn_rcpf(d.x); t.y = __builtin_amdgcn_rcpf(d.y);
    f32x2 q = t * 0.5307027145f + (-0.7265760135f); q = q * t + 0.7107068705f; q = q * t + (-0.142248368f); q = q * t + 0.127414796f; q = q * t;
    const f32x2 s = (v * v) * (-0.72134752044f);
    f32x2 e; e.x = __builtin_amdgcn_exp2f(s.x); e.y = __builtin_amdgcn_exp2f(s.y);
    const f32x2 m = v * (q * e), r = v - m;
    f32x2 o; o.x = v.x < 0.f ? m.x : r.x; o.y = v.y < 0.f ? m.y : r.y; return o;
}
__device__ __forceinline__ f32x2 rcp1pexp2_pk(f32x2 t) {
    f32x2 e; e.x = __builtin_amdgcn_exp2f(t.x); e.y = __builtin_amdgcn_exp2f(t.y);
    const f32x2 d = e + 1.0f; f32x2 r; r.x = __builtin_amdgcn_rcpf(d.x); r.y = __builtin_amdgcn_rcpf(d.y); return r;
}
}

#define XB_TMO      128
#define XB_XCNT(j)  (256  + 64 * (j))
#define XB_XSUB(j)  (1280 + 64 * (j))
#define XB_XGEN(j)  (2304 + 64 * (j))
#define XB_TOP      3328
#define XB_TOPGEN   3392
#define XCD_BAR_WORDS 3456
#define XB_SPIN_CAP (1u << 18)
__device__ __forceinline__ unsigned xb_ld(unsigned* p)              { return __hip_atomic_load(p, __ATOMIC_RELAXED, __HIP_MEMORY_SCOPE_AGENT); }
__device__ __forceinline__ unsigned xb_add(unsigned* p, unsigned v) { return __hip_atomic_fetch_add(p, v, __ATOMIC_RELAXED, __HIP_MEMORY_SCOPE_AGENT); }
__device__ __forceinline__ unsigned xb_xcc_id() { return (unsigned)__builtin_amdgcn_s_getreg((3 << 11) | 20) & 0xFu; }
#define XB_SPIN(cond, bar) do { unsigned _sp = 0; while (cond) { __builtin_amdgcn_s_sleep(1); \
    if ((++_sp & 255u) == 0u) { if (xb_ld(&(bar)[XB_TMO])) break; if (_sp > XB_SPIN_CAP) { atomicAdd(&(bar)[XB_TMO], 1u); break; } } } } while (0)
struct XcdBarrier { unsigned* bar; unsigned x; volatile LAS unsigned* st; };
__device__ __forceinline__ XcdBarrier xcd_barrier_post(unsigned* bar, volatile LAS unsigned* st, bool leader) {
    XcdBarrier b; b.bar = bar; b.x = xb_xcc_id(); b.st = st;
    if (leader) (void)xb_add(&bar[XB_XCNT(b.x)], 1u);
    return b;
}
__device__ __forceinline__ void xcd_barrier_complete(unsigned* bar, unsigned x, unsigned& nloc, unsigned& nx) {
    const unsigned G = gridDim.x * gridDim.y * gridDim.z;
    unsigned sum, cnt, mine, sp = 0u;
    for (;;) {
        sum = 0u; cnt = 0u; mine = 0u;
#pragma unroll
        for (unsigned j = 0; j < 16; ++j) { const unsigned c = xb_ld(&bar[XB_XCNT(j)]); sum += c; cnt += (c > 0u) ? 1u : 0u; mine = (j == x) ? c : mine; }
        if (sum == G) break;
        __builtin_amdgcn_s_sleep(1);
        if ((++sp & 255u) == 0u) { if (xb_ld(&bar[XB_TMO])) break; if (sp > XB_SPIN_CAP) { atomicAdd(&bar[XB_TMO], 1u); break; } }
    }
    nloc = mine > 0u ? mine : 1u; nx = cnt > 0u ? cnt : 1u;
}
__device__ __forceinline__ void xcd_barrier(const XcdBarrier& b, bool leader) {
    asm volatile("s_waitcnt vmcnt(0)" ::: "memory");
    __syncthreads();
    if (leader) {
        unsigned* bar = b.bar;
        __builtin_amdgcn_s_waitcnt(0);
        unsigned nloc = b.st[0], nx = b.st[1];
        if (nloc == 0u) { xcd_barrier_complete(bar, b.x, nloc, nx); b.st[0] = nloc; b.st[1] = nx; }
        const unsigned old = xb_add(&bar[XB_XSUB(b.x)], 1u);
        const unsigned gen = old / nloc;
        if (old + 1u == (gen + 1u) * nloc) {
            __builtin_amdgcn_fence(__ATOMIC_RELEASE, "agent");
            asm volatile("s_waitcnt vmcnt(0)" ::: "memory");
            const unsigned og = xb_add(&bar[XB_TOP], 1u);
            const unsigned tg = og / nx;
            if (og + 1u == (tg + 1u) * nx) xb_add(&bar[XB_TOPGEN], 1u);
            else XB_SPIN(xb_ld(&bar[XB_TOPGEN]) == tg, bar);
            __builtin_amdgcn_fence(__ATOMIC_ACQUIRE, "agent");
            xb_add(&bar[XB_XGEN(b.x)], 1u);
            asm volatile("s_waitcnt vmcnt(0)" ::: "memory");
        } else {
            XB_SPIN(xb_ld(&bar[XB_XGEN(b.x)]) == gen, bar);
            __builtin_amdgcn_fence(__ATOMIC_ACQUIRE, "agent");
            asm volatile("s_waitcnt vmcnt(0)" ::: "memory");
        }
    }
    __syncthreads();
}

enum { I_X = 0, I_MEM, I_F1N, I_F1G, I_F1U, I_F1D, I_MIXN, I_MEMN, I_WIN, I_GUP, I_GB, I_GON, I_LNG, I_LNB, I_WS, I_BS, I_WKV, I_WBR, I_WOUT, I_F2N, I_F2G, I_F2U, I_F2D, I_FN, N_IN };
struct Args { const float* in[N_IN]; float* out; unsigned char* ws; int ph_lo, ph_hi; };
constexpr int N_PHASES = 20;

struct ConvCtx { const float* const* in; unsigned char* ws; unsigned char* WG8; };
struct ConvItem { const float* src; const float* gain; bf16* dst; int ldw, k0, src_col0, ldk, dst_row0; unsigned char* dst8; };
constexpr float WG8_SCALE = 32.0f;
constexpr int CI_GU = 4 * 176, CI_DN = 11 * 32, CI_IN = 4 * 192, CI_KV = 4 * 32, CI_BR = 3 * 2 * 32, CI_WO = 4 * 32;
constexpr int CONV_EARLY = CI_GU + CI_KV;
constexpr int CONV_LATE = CI_DN + CI_IN + CI_BR + CI_WO + CI_GU + CI_DN;
constexpr int CONV_EPI = 1400;
__device__ __forceinline__ void conv_gu(const ConvCtx& c, int r, int second, int wave, ConvItem& o) {
    const int kb = (r / 176) * 8 + wave, nb = r % 176, tile = nb >> 2, w4 = nb & 3;
    o.src = c.in[second ? (w4 < 2 ? I_F2G : I_F2U) : (w4 < 2 ? I_F1G : I_F1U)]; o.gain = c.in[second ? I_F2N : I_F1N]; o.dst = (bf16*)(c.ws + (second ? WS_WGU2 : WS_WGU1));
    o.ldw = DFF; o.k0 = 64 * kb; o.src_col0 = 128 * tile + 64 * (w4 & 1); o.ldk = D; o.dst_row0 = 64 * nb; o.dst8 = nullptr;
}
__device__ __forceinline__ void conv_plain(const float* src, bf16* dst, int r, int nbs, int ldw, int ldk, int wave, ConvItem& o) {
    const int kb = (r / nbs) * 8 + wave, nb = r % nbs; o.src = src; o.gain = nullptr; o.dst = dst; o.ldw = ldw; o.k0 = 64 * kb; o.src_col0 = 64 * nb; o.ldk = ldk; o.dst_row0 = 64 * nb; o.dst8 = nullptr;
}
__device__ __forceinline__ void conv_early(const ConvCtx& c, int r, int wave, ConvItem& o) {
    if (r < CI_GU) { conv_gu(c, r, 0, wave, o); return; }
    conv_plain(c.in[I_WKV], (bf16*)(c.ws + WS_WKV), r - CI_GU, 32, D, D, wave, o);
}
__device__ __forceinline__ void conv_late(const ConvCtx& c, int r, int wave, ConvItem& o) {
    if (r < CI_DN) { conv_plain(c.in[I_F1D], (bf16*)(c.ws + WS_WD1), r, 32, D, DFF, wave, o); return; } r -= CI_DN;
    if (r < CI_IN) { const int kb = (r / 192) * 8 + wave, nb = r % 192; o.src = c.in[I_WIN]; o.gain = c.in[I_MIXN]; o.dst = (bf16*)(c.ws + WS_WIN); o.ldw = INW; o.k0 = 64 * kb; o.src_col0 = 64 * nb + (64 * nb >= 3072 ? 16 : 0); o.ldk = D; o.dst_row0 = 64 * nb;
        o.dst8 = nullptr; if (nb >= 96) { o.dst8 = c.WG8; o.dst_row0 = 64 * (nb - 96); } return; } r -= CI_IN;
    if (r < CI_BR) { const int i = r / 64; conv_plain(c.in[I_WBR] + (size_t)i * 1024 * D, (bf16*)(c.ws + WS_WB) + (size_t)i * D * 1024, r % 64, 32, D, 1024, wave, o); return; } r -= CI_BR;
    if (r < CI_WO) { conv_plain(c.in[I_WOUT], (bf16*)(c.ws + WS_WO), r, 32, D, D, wave, o); return; } r -= CI_WO;
    if (r < CI_GU) { conv_gu(c, r, 1, wave, o); return; } r -= CI_GU;
    conv_plain(c.in[I_F2D], (bf16*)(c.ws + WS_WD2), r, 32, D, DFF, wave, o);
}
__device__ __forceinline__ void conv_issue(const ConvItem& it, f32x4 (&v)[16], int lane) {
    const float* p = it.src + (size_t)(it.k0 + 16 * (lane >> 4)) * it.ldw + it.src_col0 + (lane & 15) * 4;
#pragma unroll
    for (int i = 0; i < 16; ++i) v[i] = __builtin_nontemporal_load((const GAS f32x4*)(p + (size_t)i * it.ldw));
}
__device__ __forceinline__ void conv_finish(const ConvItem& it, f32x4 (&v)[16], int lane) {
    const int q = lane >> 4, c4 = (lane & 15) * 4;
    if (it.gain) {
#pragma unroll
        for (int i4 = 0; i4 < 4; ++i4) { const f32x4 g = *(const f32x4*)(it.gain + it.k0 + 16 * q + 4 * i4);
            v[4 * i4] *= g.x; v[4 * i4 + 1] *= g.y; v[4 * i4 + 2] *= g.z; v[4 * i4 + 3] *= g.w; }
    }
    if (it.dst8) {
#pragma unroll
        for (int j = 0; j < 4; ++j) { v4u w;
            w.x = cvt4_fp8(v[0][j] * WG8_SCALE, v[1][j] * WG8_SCALE, v[2][j] * WG8_SCALE, v[3][j] * WG8_SCALE); w.y = cvt4_fp8(v[4][j] * WG8_SCALE, v[5][j] * WG8_SCALE, v[6][j] * WG8_SCALE, v[7][j] * WG8_SCALE);
            w.z = cvt4_fp8(v[8][j] * WG8_SCALE, v[9][j] * WG8_SCALE, v[10][j] * WG8_SCALE, v[11][j] * WG8_SCALE); w.w = cvt4_fp8(v[12][j] * WG8_SCALE, v[13][j] * WG8_SCALE, v[14][j] * WG8_SCALE, v[15][j] * WG8_SCALE);
            *(GAS v4u*)(it.dst8 + (size_t)(it.dst_row0 + c4 + j) * it.ldk + it.k0 + 16 * q) = w; }
        return;
    }
#pragma unroll
    for (int j = 0; j < 4; ++j) {
        bf16* o = it.dst + (size_t)(it.dst_row0 + c4 + j) * it.ldk + it.k0 + 16 * q;
        v4u w0, w1;
        w0.x = cvtpk(v[0][j], v[1][j]); w0.y = cvtpk(v[2][j], v[3][j]); w0.z = cvtpk(v[4][j], v[5][j]); w0.w = cvtpk(v[6][j], v[7][j]);
        w1.x = cvtpk(v[8][j], v[9][j]); w1.y = cvtpk(v[10][j], v[11][j]); w1.z = cvtpk(v[12][j], v[13][j]); w1.w = cvtpk(v[14][j], v[15][j]);
        *(GAS v4u*)o = w0; *(GAS v4u*)(o + 8) = w1;
    }
}

using pg8::Unit;
struct EpiGU {
    unsigned char* ws; const float* ss; const ConvCtx* cv; int cvbase, cvstride;
    __device__ __forceinline__ void operator()(const f32x4 (&acc)[2][2][4][2], const Unit& u, int wr, int wc, int fr, int fq) const {
        f32x4 cvv[16]; ConvItem cit; const int cvi = u.seq * (cvstride >> 1) + (cvbase >> 1); const bool docv = cv && u.seq < 11 && ((cvbase + u.seq) & 1) == 0 && cvi < CONV_EPI;
        if (docv) { conv_late(*cv, cvi, wr * 4 + wc, cit); conv_issue(cit, cvv, fq * 16 + fr); }
        epi(acc, u, wr, wc, fr, fq);
        if (docv) conv_finish(cit, cvv, fq * 16 + fr);
    }
    __device__ __forceinline__ void epi(const f32x4 (&acc)[2][2][4][2], const Unit& u, int wr, int wc, int fr, int fq) const {
        if (u.kind == 0) {
            const int row0 = u.pm * 256 + wr * 64 + fr, col0 = u.pn * 128 + wc * 32 + 8 * fq;
            const float* sp = ss + u.pm * 256 + wr * 64 + fq * 16 + fr; const float run0 = ss ? sp[0] : 0.f, run1 = ss ? sp[128] : 0.f;
#pragma unroll
            for (int ai = 0; ai < 2; ++ai)
#pragma unroll
                for (int m = 0; m < 4; ++m) {
                    const int r = row0 + ai * 128 + m * 16;
                    const float s = ss ? __builtin_amdgcn_rsqf(__shfl(ai ? run1 : run0, m * 16 + fr) * (1.0f / D) + EPS) : 1.0f;
                    const float c1 = -1.4426950408889634f * s, s2 = s * s;
                    f32x2 o[4];
#pragma unroll
                    for (int n = 0; n < 2; ++n)
#pragma unroll
                        for (int jp = 0; jp < 2; ++jp) { const f32x2 g = {acc[ai][0][m][n][2 * jp], acc[ai][0][m][n][2 * jp + 1]}, uu = {acc[ai][1][m][n][2 * jp], acc[ai][1][m][n][2 * jp + 1]};
                            o[n * 2 + jp] = (g * uu) * (pg8::rcp1pexp2_pk(g * c1) * s2); }
                    v4u w; w.x = cvtpk(o[0].x, o[0].y); w.y = cvtpk(o[1].x, o[1].y); w.z = cvtpk(o[2].x, o[2].y); w.w = cvtpk(o[3].x, o[3].y);
                    *(v4u*)((bf16*)(ws + WS_ACT) + (size_t)r * DFF + col0) = w;
                }
        } else {
            bf16* base = (bf16*)(ws + (u.kind == 1 ? WS_KB : WS_VT)); const int ldc = u.kind == 1 ? 1024 : 2048;
            const int row0 = u.pm * 256 + wr * 64 + fr, col0 = u.pn * 256 + wc * 32 + 8 * fq;
#pragma unroll
            for (int ai = 0; ai < 2; ++ai)
#pragma unroll
                for (int m = 0; m < 4; ++m) {
                    bf16* rowp = base + (size_t)(row0 + ai * 128 + m * 16) * ldc + col0;
#pragma unroll
                    for (int bj = 0; bj < 2; ++bj) { const f32x4 v0 = acc[ai][bj][m][0], v1 = acc[ai][bj][m][1];
                        v4u w; w.x = cvtpk(v0[0], v0[1]); w.y = cvtpk(v0[2], v0[3]); w.z = cvtpk(v1[0], v1[1]); w.w = cvtpk(v1[2], v1[3]);
                        *(v4u*)(rowp + bj * 128) = w; }
                }
        }
    }
};
struct EpiRes {
    bf16* xb; float* ss; float alpha; unsigned char* x8;
    __device__ __forceinline__ void operator()(const f32x4 (&acc)[2][2][4][2], const Unit& u, int wr, int wc, int fr, int fq) const {
        const int row0 = u.pm * 256 + wr * 64 + fr, col0 = u.pn * 256 + wc * 32 + 8 * fq;
#pragma unroll
        for (int ai = 0; ai < 2; ++ai) {
            v4u old[4][2];
#pragma unroll
            for (int m = 0; m < 4; ++m)
#pragma unroll
                for (int bj = 0; bj < 2; ++bj) old[m][bj] = *(const v4u*)(xb + (size_t)(row0 + ai * 128 + m * 16) * D + col0 + bj * 128);
#pragma unroll
            for (int m = 0; m < 4; ++m) {
                const int r = row0 + ai * 128 + m * 16; const size_t off = (size_t)r * D + col0; float sq = 0.f;
#pragma unroll
                for (int bj = 0; bj < 2; ++bj) {
                    const v4u o = old[m][bj]; const f32x4 a0 = acc[ai][bj][m][0], a1 = acc[ai][bj][m][1];
                    float v[8];
                    v[0] = bflo(o.x) + alpha * a0[0]; v[1] = bfhi(o.x) + alpha * a0[1]; v[2] = bflo(o.y) + alpha * a0[2]; v[3] = bfhi(o.y) + alpha * a0[3];
                    v[4] = bflo(o.z) + alpha * a1[0]; v[5] = bfhi(o.z) + alpha * a1[1]; v[6] = bflo(o.w) + alpha * a1[2]; v[7] = bfhi(o.w) + alpha * a1[3];
                    v4u w; w.x = cvtpk(v[0], v[1]); w.y = cvtpk(v[2], v[3]); w.z = cvtpk(v[4], v[5]); w.w = cvtpk(v[6], v[7]);
                    *(v4u*)(xb + off + bj * 128) = w;
                    if (x8) { v2u w8; w8.x = cvt4_fp8(v[0], v[1], v[2], v[3]); w8.y = cvt4_fp8(v[4], v[5], v[6], v[7]); *(v2u*)(x8 + off + bj * 128) = w8; }
                    sq += (v[0] * v[0] + v[1] * v[1]) + (v[2] * v[2] + v[3] * v[3]) + (v[4] * v[4] + v[5] * v[5]) + (v[6] * v[6] + v[7] * v[7]);
                }
                if (ss) { sq += __shfl_xor(sq, 16); sq += __shfl_xor(sq, 32); if (fq == 0) atomicAdd(ss + r, sq); }
            }
            asm volatile("" ::: "memory");
        }
    }
};
struct EpiProj {
    const float* ss; unsigned char* ws;
    __device__ __forceinline__ void operator()(const f32x4 (&acc)[2][2][4][2], const Unit& u, int wr, int wc, int fr, int fq) const {
        size_t boff; int ldc, ct; bool act = false; const int pn = u.pn;
        if (pn < 2) { boff = WS_Q; ldc = 512; ct = pn; } else if (pn < 4) { boff = WS_K; ldc = 512; ct = pn - 2; } else if (pn < 8) { boff = WS_V; ldc = 1024; ct = pn - 4; }
        else if (pn < 12) { boff = WS_R; ldc = 1024; ct = pn - 8; } else if (pn < 16) { boff = WS_SU; ldc = 1024; ct = pn - 12; act = true; }
        else if (pn < 20) { boff = WS_SV; ldc = 1024; ct = pn - 16; act = true; } else { boff = WS_XQ; ldc = 1024; ct = pn - 20; }
        bf16* base = (bf16*)(ws + boff);
        const int row0 = u.pm * 256 + wr * 64 + fr, col0 = ct * 256 + wc * 32 + 8 * fq;
        const float* sp = ss + u.pm * 256 + wr * 64 + fq * 16 + fr; const float run0 = sp[0], run1 = sp[128];
#pragma unroll
        for (int ai = 0; ai < 2; ++ai)
#pragma unroll
            for (int m = 0; m < 4; ++m) {
                const int rr = row0 + ai * 128 + m * 16;
                const float s = __builtin_amdgcn_rsqf(__shfl(ai ? run1 : run0, m * 16 + fr) * (1.0f / D) + EPS);
                bf16* rowp = base + (size_t)rr * ldc + col0;
#pragma unroll
                for (int bj = 0; bj < 2; ++bj) { f32x4 v0 = acc[ai][bj][m][0] * s, v1 = acc[ai][bj][m][1] * s;
                    if (act) { const f32x2 a = pg8::gelu_pk((f32x2){v0[0], v0[1]}), b = pg8::gelu_pk((f32x2){v0[2], v0[3]}), c = pg8::gelu_pk((f32x2){v1[0], v1[1]}), d = pg8::gelu_pk((f32x2){v1[2], v1[3]});
                        v0 = (f32x4){a.x, a.y, b.x, b.y}; v1 = (f32x4){c.x, c.y, d.x, d.y}; }
                    v4u w; w.x = cvtpk(v0[0], v0[1]); w.y = cvtpk(v0[2], v0[3]); w.z = cvtpk(v1[0], v1[1]); w.w = cvtpk(v1[2], v1[3]);
                    *(v4u*)(rowp + bj * 128) = w; }
            }
    }
};
struct EpiGate {
    const float* ss; bf16* g; float pre;
    __device__ __forceinline__ void operator()(const f32x4 (&acc)[2][2][4][2], const Unit& u, int wr, int wc, int fr, int fq) const {
        const int row0 = u.pm * 256 + wr * 64 + fr, col0 = u.pn * 256 + wc * 32 + 8 * fq;
        const float* sp = ss + u.pm * 256 + wr * 64 + fq * 16 + fr; const float run0 = sp[0], run1 = sp[128];
#pragma unroll
        for (int ai = 0; ai < 2; ++ai)
#pragma unroll
            for (int m = 0; m < 4; ++m) {
                const int rr = row0 + ai * 128 + m * 16;
                const float s = pre * __builtin_amdgcn_rsqf(__shfl(ai ? run1 : run0, m * 16 + fr) * (1.0f / D) + EPS);
                bf16* rowp = g + (size_t)rr * D + col0;
                const float c1 = -1.4426950408889634f * s;
#pragma unroll
                for (int bj = 0; bj < 2; ++bj) { const f32x4 a0 = acc[ai][bj][m][0], a1 = acc[ai][bj][m][1];
                    const f32x2 p = pg8::rcp1pexp2_pk((f32x2){a0[0], a0[1]} * c1), q = pg8::rcp1pexp2_pk((f32x2){a0[2], a0[3]} * c1), rr2 = pg8::rcp1pexp2_pk((f32x2){a1[0], a1[1]} * c1), t2 = pg8::rcp1pexp2_pk((f32x2){a1[2], a1[3]} * c1);
                    const f32x4 v0 = (f32x4){p.x, p.y, q.x, q.y}, v1 = (f32x4){rr2.x, rr2.y, t2.x, t2.y};
                    v4u w; w.x = cvtpk(v0[0], v0[1]); w.y = cvtpk(v0[2], v0[3]); w.z = cvtpk(v1[0], v1[1]); w.w = cvtpk(v1[2], v1[3]);
                    *(v4u*)(rowp + bj * 128) = w; }
            }
    }
};
struct EpiMerge {
    const bf16* g; bf16* mrg; int first;
    __device__ __forceinline__ void operator()(const f32x4 (&acc)[2][2][4][2], const Unit& u, int wr, int wc, int fr, int fq) const {
        const int row0 = u.pm * 256 + wr * 64 + fr, col0 = u.pn * 256 + wc * 32 + 8 * fq;
#pragma unroll
        for (int ai = 0; ai < 2; ++ai) {
            v4u gws[4][2], ows[4][2];
#pragma unroll
            for (int m = 0; m < 4; ++m)
#pragma unroll
                for (int bj = 0; bj < 2; ++bj) { const size_t off = (size_t)(row0 + ai * 128 + m * 16) * D + col0 + bj * 128;
                    gws[m][bj] = *(const v4u*)(g + off); ows[m][bj] = first ? (v4u){0u, 0u, 0u, 0u} : *(const v4u*)(mrg + off); }
#pragma unroll
            for (int m = 0; m < 4; ++m)
#pragma unroll
                for (int bj = 0; bj < 2; ++bj) {
                    const size_t off = (size_t)(row0 + ai * 128 + m * 16) * D + col0 + bj * 128;
                    const v4u gw = gws[m][bj], ow = ows[m][bj]; const f32x4 a0 = acc[ai][bj][m][0], a1 = acc[ai][bj][m][1];
                    float o[8];
                    o[0] = bflo(ow.x) + bflo(gw.x) * a0[0]; o[1] = bfhi(ow.x) + bfhi(gw.x) * a0[1]; o[2] = bflo(ow.y) + bflo(gw.y) * a0[2]; o[3] = bfhi(ow.y) + bfhi(gw.y) * a0[3];
                    o[4] = bflo(ow.z) + bflo(gw.z) * a1[0]; o[5] = bfhi(ow.z) + bfhi(gw.z) * a1[1]; o[6] = bflo(ow.w) + bflo(gw.w) * a1[2]; o[7] = bfhi(ow.w) + bfhi(gw.w) * a1[3];
                    v4u w; w.x = cvtpk(o[0], o[1]); w.y = cvtpk(o[2], o[3]); w.z = cvtpk(o[4], o[5]); w.w = cvtpk(o[6], o[7]);
                    *(v4u*)(mrg + off) = w;
                }
            asm volatile("" ::: "memory");
        }
    }
};

struct GridSched {
    unsigned A, B, tA, tB; int nM, nN, G, c;
    __device__ __forceinline__ bool next(int i, Unit& u) const {
        const int L = i * G + c; if (L >= nM * nN) return false;
        pg8::tile_of(L, nM, nN, u.pm, u.pn); u.A = A + (unsigned)u.pm * tA; u.B = B + (unsigned)u.pn * tB; u.kind = 0; u.seq = i; return true;
    }
};
struct P1Sched {
    unsigned h1b, wgu, memb, wkv; int G, c;
    __device__ __forceinline__ bool next(int i, Unit& u) const {
        const int L = i * G + c; constexpr int NF = 64 * 44; constexpr unsigned T = 256u * D * 2u; u.seq = i;
        if (L < NF) { pg8::tile_of(L, 64, 44, u.pm, u.pn); u.A = h1b + (unsigned)u.pm * T; u.B = wgu + (unsigned)u.pn * T; u.kind = 0; return true; }
        const int id = L - NF; if (id >= 64) return false;
        if (id < 32) { u.pm = id >> 2; u.pn = id & 3; u.A = memb + (unsigned)u.pm * T; u.B = wkv + (unsigned)u.pn * T; u.kind = 1; }
        else { const int j = id - 32; u.pm = j >> 3; u.pn = j & 7; u.A = wkv + (unsigned)(4 + u.pm) * T; u.B = memb + (unsigned)u.pn * T; u.kind = 2; }
        return true;
    }
};

__device__ __forceinline__ void transpose64(const float* W, int ldw, int k0, int src_col0, bf16* WT, int ldk, int dst_row0, const float* gain, LAS unsigned* T, int lane) {
    const int q = lane >> 4, c4 = (lane & 15) * 4;
    const float* p = W + (size_t)(k0 + 16 * q) * ldw + src_col0 + c4;
    f32x4 v[16];
#pragma unroll
    for (int i = 0; i < 16; ++i) v[i] = __builtin_nontemporal_load((const GAS f32x4*)(p + (size_t)i * ldw));
    if (gain) {
#pragma unroll
        for (int i4 = 0; i4 < 4; ++i4) { const f32x4 g = *(const f32x4*)(gain + k0 + 16 * q + 4 * i4);
            v[4 * i4] *= g.x; v[4 * i4 + 1] *= g.y; v[4 * i4 + 2] *= g.z; v[4 * i4 + 3] *= g.w; }
    }
#pragma unroll
    for (int j = 0; j < 4; ++j) {
        v4u w0, w1;
        w0.x = cvtpk(v[0][j], v[1][j]); w0.y = cvtpk(v[2][j], v[3][j]); w0.z = cvtpk(v[4][j], v[5][j]); w0.w = cvtpk(v[6][j], v[7][j]);
        w1.x = cvtpk(v[8][j], v[9][j]); w1.y = cvtpk(v[10][j], v[11][j]); w1.z = cvtpk(v[12][j], v[13][j]); w1.w = cvtpk(v[14][j], v[15][j]);
        LAS v4u* t = (LAS v4u*)(T + (c4 + j) * 36 + 8 * q); t[0] = w0; t[1] = w1;
    }
    LDS_WAIT(); asm volatile("" ::: "memory");
#pragma unroll
    for (int r = 0; r < 8; ++r) { const int n = 8 * r + (lane >> 3), ch = lane & 7;
        const v4u w = *(const LAS v4u*)(T + n * 36 + 4 * ch);
        *(GAS v4u*)(WT + (size_t)(dst_row0 + n) * ldk + k0 + 8 * ch) = w; }
    LDS_WAIT(); asm volatile("" ::: "memory");
}
__device__ __forceinline__ void row_to_bf16_ss(const float* xrow, bf16* orow, float* ssp, int lane) {
    const GAS f32x4* xr = (const GAS f32x4*)xrow + lane;
    f32x4 v[8]; float s = 0.f;
#pragma unroll
    for (int j = 0; j < 8; ++j) { v[j] = xr[64 * j]; s += (v[j].x * v[j].x + v[j].y * v[j].y) + (v[j].z * v[j].z + v[j].w * v[j].w); }
    s = wave_sum(s); if (lane == 0) *ssp = s;
    GAS v2u* o8 = (GAS v2u*)orow + lane;
#pragma unroll
    for (int j = 0; j < 8; ++j) { v2u w; w.x = cvtpk(v[j].x, v[j].y); w.y = cvtpk(v[j].z, v[j].w); o8[64 * j] = w; }
}
__device__ __forceinline__ void rms_row_to_bf16(const float* xrow, const float* gain, bf16* orow, int lane) {
    const GAS f32x4* xr = (const GAS f32x4*)xrow + lane; const GAS f32x4* gr = (const GAS f32x4*)gain + lane;
    f32x4 v[8]; float s = 0.f;
#pragma unroll
    for (int j = 0; j < 8; ++j) { v[j] = xr[64 * j]; s += (v[j].x * v[j].x + v[j].y * v[j].y) + (v[j].z * v[j].z + v[j].w * v[j].w); }
    const float rs = 1.0f / sqrtf(wave_sum(s) * (1.0f / D) + EPS);
    GAS v2u* o8 = (GAS v2u*)orow + lane;
#pragma unroll
    for (int j = 0; j < 8; ++j) { const f32x4 g = gr[64 * j]; v2u w; w.x = cvtpk(v[j].x * rs * g.x, v[j].y * rs * g.y); w.y = cvtpk(v[j].z * rs * g.z, v[j].w * rs * g.w); o8[64 * j] = w; }
}

__device__ __forceinline__ int tau32(int r) { return (r & ~12) | ((r & 4) << 1) | ((r & 8) >> 1); }
#define MFMA32(a, b, c) __builtin_amdgcn_mfma_f32_32x32x16_bf16((a), (b), (c), 0, 0, 0)
__device__ __forceinline__ bf16x8 pack8(const f32x16& x, int s) {
    v4u p; p.x = cvtpk(x[8 * s], x[8 * s + 1]); p.y = cvtpk(x[8 * s + 2], x[8 * s + 3]); p.z = cvtpk(x[8 * s + 4], x[8 * s + 5]); p.w = cvtpk(x[8 * s + 6], x[8 * s + 7]);
    return __builtin_bit_cast(bf16x8, p);
}
__device__ __forceinline__ f32x16 zero16() { f32x16 z;
#pragma unroll
    for (int i = 0; i < 16; ++i) z[i] = 0.f; return z; }

constexpr float GLA_SCALE = 0.08838834764831845f;
constexpr int VT_P = 72, KL_P = 72, QS_P = 136;

__device__ __forceinline__ void load_vT(const bf16* V, int tok0, int h, LAS bf16* VT, int wave, int lane) {
    const bf16* src = V + (size_t)(tok0 + lane) * 1024 + h * 256 + 32 * wave;
#pragma unroll
    for (int p = 0; p < 4; ++p) { const v4u raw = *(const v4u*)(src + 8 * p); const int c0 = 32 * wave + 8 * p;
        VT[(c0 + 0) * VT_P + lane] = (bf16)(raw.x & 0xffff); VT[(c0 + 1) * VT_P + lane] = (bf16)(raw.x >> 16);
        VT[(c0 + 2) * VT_P + lane] = (bf16)(raw.y & 0xffff); VT[(c0 + 3) * VT_P + lane] = (bf16)(raw.y >> 16);
        VT[(c0 + 4) * VT_P + lane] = (bf16)(raw.z & 0xffff); VT[(c0 + 5) * VT_P + lane] = (bf16)(raw.z >> 16);
        VT[(c0 + 6) * VT_P + lane] = (bf16)(raw.w & 0xffff); VT[(c0 + 7) * VT_P + lane] = (bf16)(raw.w >> 16); }
}

__device__ __forceinline__ void gla_step1(LAS unsigned char* lds, int unit, bf16* Q, bf16* Kt, const bf16* V, const float* GLR, const float* wup, const float* gbias, float* ADEC, bf16* US, int wave, int lane) {
    const int b = unit >> 7, h = (unit >> 5) & 3, n = unit & 31, tok0 = b * SEQ + n * 64, tid = wave * 64 + lane;
    LAS float* WUP = (LAS float*)lds;
    LAS float* BIAS = (LAS float*)(lds + 8192);
    LAS bf16* KLT = (LAS bf16*)(lds + 9216);
    LAS bf16* VTl = (LAS bf16*)(lds + 9216 + 128 * KL_P * 2);
    for (int i = tid; i < 16 * 128; i += NTHREADS) WUP[i] = wup[(i >> 7) * 512 + h * 128 + (i & 127)];
    if (tid < 128) BIAS[tid] = gbias[h * 128 + tid];
    load_vT(V, tok0, h, VTl, wave, lane);
    const int token = tok0 + lane;
    float gl[16];
    { const f32x4* gp = (const f32x4*)(GLR + (size_t)token * 16);
#pragma unroll
      for (int i = 0; i < 4; ++i) { const f32x4 t = gp[i]; gl[4 * i] = t.x; gl[4 * i + 1] = t.y; gl[4 * i + 2] = t.z; gl[4 * i + 3] = t.w; } }
    __syncthreads();
    float la[16];
#pragma unroll
    for (int j = 0; j < 16; ++j) {
        float z = BIAS[16 * wave + j];
#pragma unroll
        for (int r = 0; r < 16; ++r) z += gl[r] * WUP[r * 128 + 16 * wave + j];
        const float ls = fminf(z, 0.f) - __logf(1.0f + __expf(-fabsf(z)));
        float v = ls * (1.0f / 16.0f);
#pragma unroll
        for (int o = 1; o < 64; o <<= 1) { const float t = __shfl_up(v, o); if (lane >= o) v += t; }
        la[j] = v;
    }
    unsigned qraw[8], kraw[8];
    { const v4u* qp = (const v4u*)(Q + (size_t)token * 512 + h * 128 + 16 * wave); const v4u* kp = (const v4u*)(Kt + (size_t)token * 512 + h * 128 + 16 * wave);
      const v4u q0 = qp[0], q1 = qp[1], k0 = kp[0], k1 = kp[1];
      qraw[0] = q0.x; qraw[1] = q0.y; qraw[2] = q0.z; qraw[3] = q0.w; qraw[4] = q1.x; qraw[5] = q1.y; qraw[6] = q1.z; qraw[7] = q1.w;
      kraw[0] = k0.x; kraw[1] = k0.y; kraw[2] = k0.z; kraw[3] = k0.w; kraw[4] = k1.x; kraw[5] = k1.y; kraw[6] = k1.z; kraw[7] = k1.w; }
    unsigned qo[8], ko[8];
#pragma unroll
    for (int jj = 0; jj < 8; ++jj) {
        float qs2[2], ks2[2];
#pragma unroll
        for (int e = 0; e < 2; ++e) { const int j = 2 * jj + e;
            const float bb = la[j], bl = __shfl(bb, 63), a = __expf(bl), e1 = __expf(bb), e2 = __expf(-bb);
            const float qv = e ? bfhi(qraw[jj]) : bflo(qraw[jj]), kv = e ? bfhi(kraw[jj]) : bflo(kraw[jj]);
            qs2[e] = qv * (GLA_SCALE * e1); ks2[e] = kv * e2;
            KLT[(16 * wave + j) * KL_P + lane] = f2bf(kv * (e2 * a));
            if (lane == 63) ADEC[(size_t)unit * 128 + 16 * wave + j] = a; }
        qo[jj] = cvtpk(qs2[0], qs2[1]); ko[jj] = cvtpk(ks2[0], ks2[1]);
    }
    { v4u* qp = (v4u*)(Q + (size_t)token * 512 + h * 128 + 16 * wave); v4u* kp = (v4u*)(Kt + (size_t)token * 512 + h * 128 + 16 * wave);
      qp[0] = (v4u){qo[0], qo[1], qo[2], qo[3]}; qp[1] = (v4u){qo[4], qo[5], qo[6], qo[7]};
      kp[0] = (v4u){ko[0], ko[1], ko[2], ko[3]}; kp[1] = (v4u){ko[4], ko[5], ko[6], ko[7]}; }
    __syncthreads();
    const int r32 = lane & 31, hh = lane >> 5;
    f32x16 acc[4];
#pragma unroll
    for (int dt = 0; dt < 4; ++dt) acc[dt] = zero16();
#pragma unroll
    for (int kk = 0; kk < 4; ++kk) {
        const bf16x8 Bf = *(const LAS bf16x8*)(VTl + (32 * wave + r32) * VT_P + 16 * kk + 8 * hh);
#pragma unroll
        for (int dt = 0; dt < 4; ++dt) { const bf16x8 Af = *(const LAS bf16x8*)(KLT + (32 * dt + r32) * KL_P + 16 * kk + 8 * hh); acc[dt] = MFMA32(Af, Bf, acc[dt]); }
    }
    bf16* up = US + ((size_t)unit * 256 + 32 * wave + r32) * 128;
#pragma unroll
    for (int dt = 0; dt < 4; ++dt)
#pragma unroll
        for (int g4 = 0; g4 < 4; ++g4) { v2u w; w.x = cvtpk(acc[dt][4 * g4], acc[dt][4 * g4 + 1]); w.y = cvtpk(acc[dt][4 * g4 + 2], acc[dt][4 * g4 + 3]);
            *(v2u*)(up + 32 * dt + 8 * g4 + 4 * hh) = w; }
    __syncthreads();
}

__device__ __forceinline__ void gla_scan(bf16* US, const float* ADEC, int gid) {
    const int bh = gid >> 12, e = gid & 4095, dv = e >> 4, dk0 = (e & 15) * 8;
    float S[8];
#pragma unroll
    for (int i = 0; i < 8; ++i) S[i] = 0.f;
#pragma unroll 4
    for (int n = 0; n < 32; ++n) {
        const int unit = bh * 32 + n;
        v4u* p = (v4u*)(US + ((size_t)unit * 256 + dv) * 128 + dk0);
        const v4u uu = *p; const f32x4 a0 = *(const f32x4*)(ADEC + (size_t)unit * 128 + dk0), a1 = *(const f32x4*)(ADEC + (size_t)unit * 128 + dk0 + 4);
        v4u w; w.x = cvtpk(S[0], S[1]); w.y = cvtpk(S[2], S[3]); w.z = cvtpk(S[4], S[5]); w.w = cvtpk(S[6], S[7]);
        *p = w;
        S[0] = a0.x * S[0] + bflo(uu.x); S[1] = a0.y * S[1] + bfhi(uu.x); S[2] = a0.z * S[2] + bflo(uu.y); S[3] = a0.w * S[3] + bfhi(uu.y);
        S[4] = a1.x * S[4] + bflo(uu.z); S[5] = a1.y * S[5] + bfhi(uu.z); S[6] = a1.z * S[6] + bflo(uu.w); S[7] = a1.w * S[7] + bfhi(uu.w);
    }
}

__device__ __forceinline__ void gla_step3(LAS unsigned char* lds, int unit, const bf16* Q, const bf16* Kt, bf16* V, const bf16* R, const bf16* US, const float* onorm, int wave, int lane) {
    const int b = unit >> 7, h = (unit >> 5) & 3, n = unit & 31, tok0 = b * SEQ + n * 64, tid = wave * 64 + lane;
    LAS bf16* QS = (LAS bf16*)lds;
    LAS bf16* KS = (LAS bf16*)(lds + 64 * QS_P * 2);
    LAS bf16* VTl = (LAS bf16*)(lds + 2 * 64 * QS_P * 2);
    LAS float* RED = (LAS float*)(lds + 2 * 64 * QS_P * 2 + 256 * VT_P * 2);
#pragma unroll
    for (int i = 0; i < 2; ++i) { const int pc = tid + i * NTHREADS, row = pc >> 4, c8 = (pc & 15) * 8;
        *(LAS v4u*)(QS + row * QS_P + c8) = *(const v4u*)(Q + (size_t)(tok0 + row) * 512 + h * 128 + c8);
        *(LAS v4u*)(KS + row * QS_P + c8) = *(const v4u*)(Kt + (size_t)(tok0 + row) * 512 + h * 128 + c8); }
    load_vT(V, tok0, h, VTl, wave, lane);
    __syncthreads();
    const int r32 = lane & 31, hh = lane >> 5;
    f32x16 sc0 = zero16(), sc1 = zero16(), sc2 = zero16();
#pragma unroll
    for (int kk = 0; kk < 8; ++kk) {
        const bf16x8 A0 = *(const LAS bf16x8*)(KS + tau32(r32) * QS_P + 16 * kk + 8 * hh), A1 = *(const LAS bf16x8*)(KS + (32 + tau32(r32)) * QS_P + 16 * kk + 8 * hh);
        const bf16x8 B0 = *(const LAS bf16x8*)(QS + r32 * QS_P + 16 * kk + 8 * hh), B1 = *(const LAS bf16x8*)(QS + (32 + r32) * QS_P + 16 * kk + 8 * hh);
        sc0 = MFMA32(A0, B0, sc0); sc1 = MFMA32(A0, B1, sc1); sc2 = MFMA32(A1, B1, sc2);
    }
#pragma unroll
    for (int rg = 0; rg < 16; ++rg) { const int s = (rg & 3) + 4 * ((rg >> 2) & 1) + 8 * hh + 16 * (rg >> 3); if (s > r32) { sc0[rg] = 0.f; sc2[rg] = 0.f; } }
    f32x16 o0 = zero16(), o1 = zero16();
    const LAS bf16* vrow = VTl + (32 * wave + r32) * VT_P + 8 * hh;
#pragma unroll
    for (int s = 0; s < 2; ++s) {
        const bf16x8 Av0 = *(const LAS bf16x8*)(vrow + 16 * s), Av1 = *(const LAS bf16x8*)(vrow + 32 + 16 * s);
        o0 = MFMA32(Av0, pack8(sc0, s), o0); o1 = MFMA32(Av0, pack8(sc1, s), o1); o1 = MFMA32(Av1, pack8(sc2, s), o1);
    }
    const bf16* sp = US + ((size_t)unit * 256 + 32 * wave + r32) * 128 + 8 * hh;
#pragma unroll
    for (int kk = 0; kk < 8; ++kk) {
        const bf16x8 As = __builtin_bit_cast(bf16x8, *(const v4u*)(sp + 16 * kk));
        const bf16x8 B0 = *(const LAS bf16x8*)(QS + r32 * QS_P + 16 * kk + 8 * hh), B1 = *(const LAS bf16x8*)(QS + (32 + r32) * QS_P + 16 * kk + 8 * hh);
        o0 = MFMA32(As, B0, o0); o1 = MFMA32(As, B1, o1);
    }
    float q0 = 0.f, q1 = 0.f;
#pragma unroll
    for (int rg = 0; rg < 16; ++rg) { q0 += o0[rg] * o0[rg]; q1 += o1[rg] * o1[rg]; }
    q0 += __shfl_xor(q0, 32); q1 += __shfl_xor(q1, 32);
    if (hh == 0) { RED[wave * 64 + r32] = q0; RED[wave * 64 + 32 + r32] = q1; }
    __syncthreads();
    float t0 = 0.f, t1 = 0.f;
#pragma unroll
    for (int w = 0; w < 8; ++w) { t0 += RED[w * 64 + r32]; t1 += RED[w * 64 + 32 + r32]; }
    const float rs0 = 1.0f / sqrtf(t0 * (1.0f / 256.0f) + EPS), rs1 = 1.0f / sqrtf(t1 * (1.0f / 256.0f) + EPS);
#pragma unroll
    for (int tt = 0; tt < 2; ++tt) {
        const size_t rowoff = (size_t)(tok0 + 32 * tt + r32) * 1024 + h * 256 + 32 * wave + 4 * hh;
        const float rs = tt ? rs1 : rs0;
#pragma unroll
        for (int g4 = 0; g4 < 4; ++g4) {
            const v2u rw = *(const v2u*)(R + rowoff + 8 * g4); const f32x4 gn = *(const f32x4*)(onorm + h * 256 + 32 * wave + 8 * g4 + 4 * hh);
            float y[4];
#pragma unroll
            for (int j = 0; j < 4; ++j) { const float ov = tt ? o1[4 * g4 + j] : o0[4 * g4 + j]; const unsigned rr = j < 2 ? rw.x : rw.y; const float rv = (j & 1) ? bfhi(rr) : bflo(rr);
                y[j] = ov * rs * gn[j] * (rv * sigmoidf_(rv)); }
            v2u w; w.x = cvtpk(y[0], y[1]); w.y = cvtpk(y[2], y[3]); *(v2u*)(V + rowoff + 8 * g4) = w;
        }
    }
    __syncthreads();
}

__device__ __forceinline__ void sg_unit(LAS unsigned char* lds, int unit, bf16* SU, const bf16* SV, const float* lng, const float* lnb, const float* ws, const float* bs, int wave, int lane) {
    const int b = unit >> 6, n = (unit >> 2) & 15, g = unit & 3, tok0 = b * SEQ + n * 128, tid = wave * 64 + lane;
    LAS bf16* VNT = (LAS bf16*)lds;
    LAS bf16* WB = (LAS bf16*)(lds + 256 * QS_P * 2);
    LAS f32x2* RED = (LAS f32x2*)(lds + 256 * QS_P * 2 + 128 * QS_P * 2);
    { const int t = tid >> 2, s0 = (tid & 3) * 32; const float* wp = ws + ((size_t)g * 128 + t) * 128 + s0;
#pragma unroll
      for (int i = 0; i < 4; ++i) { const f32x4 a = *(const f32x4*)(wp + 8 * i), c = *(const f32x4*)(wp + 8 * i + 4); const int s = s0 + 8 * i;
          v4u w; w.x = cvtpk(s + 0 <= t ? a.x : 0.f, s + 1 <= t ? a.y : 0.f); w.y = cvtpk(s + 2 <= t ? a.z : 0.f, s + 3 <= t ? a.w : 0.f);
          w.z = cvtpk(s + 4 <= t ? c.x : 0.f, s + 5 <= t ? c.y : 0.f); w.w = cvtpk(s + 6 <= t ? c.z : 0.f, s + 7 <= t ? c.w : 0.f);
          *(LAS v4u*)(WB + t * QS_P + s) = w; } }
    const int tok = lane + 64 * (wave & 1), cq = wave >> 1;
    unsigned raw[32]; float s1 = 0.f, s2 = 0.f;
    { const v4u* p = (const v4u*)(SV + (size_t)(tok0 + tok) * 1024 + g * 256 + 64 * cq);
#pragma unroll
      for (int i = 0; i < 8; ++i) { const v4u t = p[i]; raw[4 * i] = t.x; raw[4 * i + 1] = t.y; raw[4 * i + 2] = t.z; raw[4 * i + 3] = t.w; } }
#pragma unroll
    for (int i = 0; i < 32; ++i) { const float a = bflo(raw[i]), c = bfhi(raw[i]); s1 += a + c; s2 += a * a + c * c; }
    RED[tok * 4 + cq] = (f32x2){s1, s2};
    __syncthreads();
    { const f32x2 p0 = RED[tok * 4], p1 = RED[tok * 4 + 1], p2 = RED[tok * 4 + 2], p3 = RED[tok * 4 + 3];
      const float mu = ((p0.x + p1.x) + (p2.x + p3.x)) * (1.0f / 256.0f); const float var = fmaxf(((p0.y + p1.y) + (p2.y + p3.y)) * (1.0f / 256.0f) - mu * mu, 0.f);
      const float rstd = 1.0f / sqrtf(var + EPS);
      const float* gp = lng + g * 256 + 64 * cq; const float* bp = lnb + g * 256 + 64 * cq;
#pragma unroll
      for (int i = 0; i < 32; ++i) { const int c = 64 * cq + 2 * i;
          VNT[c * QS_P + tok] = f2bf((bflo(raw[i]) - mu) * rstd * gp[2 * i] + bp[2 * i]);
          VNT[(c + 1) * QS_P + tok] = f2bf((bfhi(raw[i]) - mu) * rstd * gp[2 * i + 1] + bp[2 * i + 1]); } }
    __syncthreads();
    const int r32 = lane & 31, hh = lane >> 5;
    f32x16 acc[4];
#pragma unroll
    for (int j = 0; j < 4; ++j) {
        acc[j] = zero16();
#pragma unroll
        for (int kk = 0; kk < 2 * (j + 1); ++kk) {
            const bf16x8 Af = *(const LAS bf16x8*)(VNT + (32 * wave + r32) * QS_P + 16 * kk + 8 * hh), Bf = *(const LAS bf16x8*)(WB + (32 * j + r32) * QS_P + 16 * kk + 8 * hh);
            acc[j] = MFMA32(Af, Bf, acc[j]);
        }
    }
#pragma unroll
    for (int j = 0; j < 4; ++j) {
        const int t = 32 * j + r32; const float bias = bs[g * 128 + t];
        bf16* up = SU + (size_t)(tok0 + t) * 1024 + g * 256 + 32 * wave + 4 * hh;
#pragma unroll
        for (int g4 = 0; g4 < 4; ++g4) { const v2u uw = *(const v2u*)(up + 8 * g4);
            v2u w; w.x = cvtpk(bflo(uw.x) * (acc[j][4 * g4] + bias), bfhi(uw.x) * (acc[j][4 * g4 + 1] + bias)); w.y = cvtpk(bflo(uw.y) * (acc[j][4 * g4 + 2] + bias), bfhi(uw.y) * (acc[j][4 * g4 + 3] + bias));
            *(v2u*)(up + 8 * g4) = w; }
    }
    __syncthreads();
}

__device__ __forceinline__ void xa_task(int task, bf16* XQ, const bf16* Kb, const bf16* VTg, int lane) {
    const int qblk = task & 63, h = (task >> 6) & 3, b = task >> 8;
    const int r32 = lane & 31, hh = lane >> 5; const size_t token = (size_t)b * SEQ + 32 * qblk + r32;
    bf16x8 qf[16];
    { const bf16* qp = XQ + token * 1024 + h * 256 + 8 * hh;
#pragma unroll
      for (int kk = 0; kk < 16; ++kk) qf[kk] = __builtin_bit_cast(bf16x8, *(const v4u*)(qp + 16 * kk)); }
    f32x16 s[8];
#pragma unroll
    for (int kt = 0; kt < 8; ++kt) {
        s[kt] = zero16();
        const bf16* kp = Kb + (size_t)(b * 256 + 32 * kt + tau32(r32)) * 1024 + h * 256 + 8 * hh;
#pragma unroll
        for (int kk = 0; kk < 16; ++kk) { const bf16x8 Af = __builtin_bit_cast(bf16x8, *(const v4u*)(kp + 16 * kk)); s[kt] = MFMA32(Af, qf[kk], s[kt]); }
    }
    float mx = -3.0e38f;
#pragma unroll
    for (int kt = 0; kt < 8; ++kt)
#pragma unroll
        for (int rg = 0; rg < 16; ++rg) mx = fmaxf(mx, s[kt][rg]);
    mx = fmaxf(mx, __shfl_xor(mx, 32));
    float sum = 0.f; constexpr float C2 = 0.0625f * 1.4426950408889634f;
#pragma unroll
    for (int kt = 0; kt < 8; ++kt)
#pragma unroll
        for (int rg = 0; rg < 16; ++rg) { const float p = __builtin_amdgcn_exp2f((s[kt][rg] - mx) * C2); s[kt][rg] = p; sum += p; }
    sum += __shfl_xor(sum, 32);
    const float inv = 1.0f / sum;
    bf16x8 pf[8][2];
#pragma unroll
    for (int kt = 0; kt < 8; ++kt) { pf[kt][0] = pack8(s[kt], 0); pf[kt][1] = pack8(s[kt], 1); }
    bf16* yp = XQ + token * 1024 + h * 256 + 4 * hh;
#pragma unroll 1
    for (int dt = 0; dt < 8; ++dt) {
        f32x16 o = zero16();
        const bf16* vp = VTg + (size_t)(h * 256 + 32 * dt + r32) * 2048 + b * 256 + 8 * hh;
#pragma unroll
        for (int kt = 0; kt < 8; ++kt)
#pragma unroll
            for (int s2 = 0; s2 < 2; ++s2) { const bf16x8 Af = __builtin_bit_cast(bf16x8, *(const v4u*)(vp + 32 * kt + 16 * s2)); o = MFMA32(Af, pf[kt][s2], o); }
#pragma unroll
        for (int g4 = 0; g4 < 4; ++g4) { v2u w; w.x = cvtpk(o[4 * g4] * inv, o[4 * g4 + 1] * inv); w.y = cvtpk(o[4 * g4 + 2] * inv, o[4 * g4 + 3] * inv);
            *(v2u*)(yp + 32 * dt + 8 * g4) = w; }
    }
}

__device__ __forceinline__ void glr_tile(int tile, const bf16* XB, const bf16* Wg, const float* ss, float* GLR, int lane) {
    const int r16 = lane & 15, q4 = lane >> 4;
    const bf16* ap = XB + (size_t)(16 * tile + r16) * D + 8 * q4; const bf16* bp = Wg + (size_t)r16 * D + 8 * q4;
    f32x4 acc = (f32x4){0.f, 0.f, 0.f, 0.f};
#pragma unroll 8
    for (int kk = 0; kk < 64; ++kk) {
        const bf16x8 Af = __builtin_bit_cast(bf16x8, *(const v4u*)(ap + 32 * kk)), Bf = __builtin_bit_cast(bf16x8, *(const v4u*)(bp + 32 * kk));
        acc = __builtin_amdgcn_mfma_f32_16x16x32_bf16(Af, Bf, acc, 0, 0, 0);
    }
#pragma unroll
    for (int j = 0; j < 4; ++j) { const int token = 16 * tile + 4 * q4 + j; const float s = 1.0f / sqrtf(ss[token] * (1.0f / D) + EPS); GLR[(size_t)token * 16 + r16] = acc[j] * s; }
}

__global__ void __launch_bounds__(NTHREADS, 2) mk_fwd(Args args) {
    extern __shared__ __attribute__((aligned(16))) unsigned char lds_raw[];
    LAS unsigned char* lds = (LAS unsigned char*)lds_raw;
    const int wave = __builtin_amdgcn_readfirstlane((int)threadIdx.x >> 6);
#define CUR_LANE() lane_now()
    const int G = gridDim.x, bx = blockIdx.x;
    unsigned char* ws = args.ws;
    unsigned* ctl = (unsigned*)(ws + WS_CTL);
    volatile LAS unsigned* MISC = (volatile LAS unsigned*)(lds + MISC_OFF);
    for (int u = wave * 64 + CUR_LANE(); u < (LDS_BYTES - RING_BYTES) / 4; u += NTHREADS) ((LAS unsigned*)(lds + RING_BYTES))[u] = 0u;
    __syncthreads();
#if MK_PER_PHASE
#define GRID_BAR() do {} while (0)
#else
    XcdBarrier bar = xcd_barrier_post(ctl + CW_BAR, MISC + 8, wave == 0 && CUR_LANE() == 0);
#define GRID_BAR() xcd_barrier(bar, wave == 0 && lane_now() == 0)
#endif
    const int lo = args.ph_lo, hi = args.ph_hi;
#if MK_STAMP
    if (bx == 0 && wave == 0 && CUR_LANE() == 0) ((unsigned long long*)(ws + CTL_DBG))[32 + 20] = __builtin_amdgcn_s_memrealtime();
#endif
#define IN(k) (lo <= (k) && (k) < hi)
#define PHASE_LANE const int tid = wave * 64 + lane_now(); const int lane = tid & 63; (void)lane
#if MK_STAMP
#define SEAM(k) do { if (IN((k) + 1)) GRID_BAR(); if (bx == 0 && wave == 0 && CUR_LANE() == 0) ((unsigned long long*)(ws + CTL_DBG))[32 + (k)] = __builtin_amdgcn_s_memrealtime(); } while (0)
#else
#define SEAM(k) do { if (IN((k) + 1)) GRID_BAR(); } while (0)
#endif

    const float* x = args.in[I_X]; float* out = args.out;
    float* SS1 = (float*)(ws + CTL_SS1); float* SS2 = (float*)(ws + CTL_SS2); float* SS0 = (float*)(ws + CTL_SS0); float* SS3 = (float*)(ws + CTL_SS3);
    float* GLR = (float*)(ws + WS_GLR); float* ADEC = (float*)(ws + WS_ADEC);
    bf16* WGLR = (bf16*)(ws + WS_WGLR); bf16* KB = (bf16*)(ws + WS_KB); bf16* VTG = (bf16*)(ws + WS_VT); bf16* MEMB = (bf16*)(ws + WS_MEMB);
    bf16* WGU1 = (bf16*)(ws + WS_WGU1); bf16* WD1 = (bf16*)(ws + WS_WD1); bf16* WIN = (bf16*)(ws + WS_WIN); bf16* WKV = (bf16*)(ws + WS_WKV);
    bf16* WBR = (bf16*)(ws + WS_WB); bf16* WO = (bf16*)(ws + WS_WO); bf16* WGU2 = (bf16*)(ws + WS_WGU2); bf16* WD2 = (bf16*)(ws + WS_WD2);
    bf16* XB = (bf16*)(ws + WS_XB); bf16* ACT = (bf16*)(ws + WS_ACT);
    bf16* Qb = (bf16*)(ws + WS_Q); bf16* Kt = (bf16*)(ws + WS_K); bf16* Vb = (bf16*)(ws + WS_V); bf16* Rb = (bf16*)(ws + WS_R);
    bf16* SUb = (bf16*)(ws + WS_SU); bf16* SVb = (bf16*)(ws + WS_SV); bf16* XQb = (bf16*)(ws + WS_XQ);
    bf16* MRG = (bf16*)(ws + WS_MRG); bf16* GT = (bf16*)(ws + WS_G); bf16* US = (bf16*)(ws + WS_G);
    const int gw = bx * NWAVES + wave, NGW = G * NWAVES;
    unsigned char* XB8 = (unsigned char*)out;
    unsigned char* WG8 = (unsigned char*)out + (size_t)M * D;
    const ConvCtx cvx{args.in, ws, WG8};

    if (IN(0)) {
      PHASE_LANE;
      for (int rep = 0; rep < (MK_DUP == 0 ? 2 : 1); ++rep) {
        for (int it = bx; it < CONV_EARLY; it += G) { ConvItem ci; f32x4 v[16]; conv_early(cvx, it, wave, ci); conv_issue(ci, v, lane); conv_finish(ci, v, lane); }
        for (int i = bx * NTHREADS + tid; i < 16 * D; i += G * NTHREADS) { const int r = i / D, k = i % D; WGLR[i] = f2bf(args.in[I_WIN][(size_t)k * INW + 3072 + r] * args.in[I_MIXN][k]); }
        for (int m = gw; m < M; m += NGW) row_to_bf16_ss(x + (size_t)m * D, XB + (size_t)m * D, SS0 + m, lane);
        for (int m = gw; m < MROWS; m += NGW) rms_row_to_bf16(args.in[I_MEM] + (size_t)m * D, args.in[I_MEMN], MEMB + (size_t)m * D, lane);
        __syncthreads();
      }
        SEAM(0);
    }
    if (IN(1)) {
        P1Sched S{(unsigned)WS_XB, (unsigned)WS_WGU1, (unsigned)WS_MEMB, (unsigned)WS_WKV, G, bx};
        EpiGU E{ws, SS0, &cvx, bx, G};
        pg8::gemm_phase(lds, ws, wave, D, D, D, S, E);
        if (bx >= 64) { PHASE_LANE; for (int it = CONV_EPI + (bx - 64); it < CONV_LATE; it += G - 64) { ConvItem ci; f32x4 v[16]; conv_late(cvx, it, wave, ci); conv_issue(ci, v, lane); conv_finish(ci, v, lane); } }
        if (MK_DUP == 1) pg8::gemm_phase(lds, ws, wave, D, D, D, S, E);
        SEAM(1);
    }
    if (IN(2)) {
        GridSched S{(unsigned)WS_ACT, (unsigned)WS_WD1, 256u * DFF * 2u, 256u * DFF * 2u, 64, 8, G, bx};
        EpiRes E{XB, SS1, 0.5f, XB8};
        pg8::gemm_phase(lds, ws, wave, DFF, DFF, DFF, S, E);
        SEAM(2);
    }
    if (IN(3)) {
        GridSched S{(unsigned)WS_XB, (unsigned)WS_WIN, 256u * D * 2u, 256u * D * 2u, 64, 24, G, bx};
        EpiProj E{SS1, ws};
        pg8::gemm_phase(lds, ws, wave, D, D, D, S, E);
        if (MK_DUP == 3) pg8::gemm_phase(lds, ws, wave, D, D, D, S, E);
        if (wave < 4) { PHASE_LANE; glr_tile(bx * 4 + wave, XB, WGLR, SS1, GLR, lane); }
        SEAM(3);
    }
    if (IN(4)) {
        PHASE_LANE;
        for (int i = 0; i < 4; ++i) gla_step1(lds, bx * 4 + i, Qb, Kt, Vb, GLR, args.in[I_GUP], args.in[I_GB], ADEC, US, wave, lane);
        for (int i = 0; i < 2; ++i) sg_unit(lds, bx * 2 + i, SUb, SVb, args.in[I_LNG], args.in[I_LNB], args.in[I_WS], args.in[I_BS], wave, lane);
        SEAM(4);
    }
    if (IN(5)) {
        PHASE_LANE;
        gla_scan(US, ADEC, bx * NTHREADS + tid);
        xa_task(bx * 8 + wave, XQb, KB, VTG, lane);
        SEAM(5);
    }
    if (IN(6)) {
        PHASE_LANE;
        for (int i = 0; i < 4; ++i) gla_step3(lds, bx * 4 + i, Qb, Kt, Vb, Rb, US, args.in[I_GON], wave, lane);
        SEAM(6);
    }
    if (IN(7)) {
#pragma unroll
        for (int i = 0; i < 3; ++i) {
            { GridSched S{0u, (unsigned)((size_t)M * D + (size_t)i * D * D), 256u * D, 256u * D, 64, 8, G, bx};
              EpiGate E{SS1, GT, 1.0f / WG8_SCALE};
              pg8::gemm_phase<EpiGate, GridSched, false, true>(lds, out, wave, D / 2, D / 2, D / 2, S, E); }
            { GridSched S{(unsigned)(i == 0 ? WS_V : (i == 1 ? WS_SU : WS_XQ)), (unsigned)(WS_WB + (size_t)i * D * 1024 * 2), 256u * 1024u * 2u, 256u * 1024u * 2u, 64, 8, G, bx};
              EpiMerge E{GT, MRG, i == 0};
              pg8::gemm_phase(lds, ws, wave, 1024, 1024, 1024, S, E); }
        }
        SEAM(7);
    }
    if (IN(8)) {
        GridSched S{(unsigned)WS_MRG, (unsigned)WS_WO, 256u * D * 2u, 256u * D * 2u, 64, 8, G, bx};
        EpiRes E{XB, SS2, 1.0f, nullptr};
        pg8::gemm_phase(lds, ws, wave, D, D, D, S, E);
        SEAM(8);
    }
    if (IN(9)) {
        GridSched S{(unsigned)WS_XB, (unsigned)WS_WGU2, 256u * D * 2u, 256u * D * 2u, 64, 44, G, bx};
        EpiGU E{ws, SS2, nullptr, 0, 0};
#if MK_STAMP
        unsigned long long* stp = (unsigned long long*)(ws + CTL_DBG) + (bx == 37 ? 0 : 8);
        const unsigned long long c0 = __builtin_amdgcn_s_memtime(), r0 = __builtin_amdgcn_s_memrealtime();
        pg8::gemm_phase<EpiGU, GridSched, true>(lds, ws, wave, D, D, D, S, E, stp);
        const unsigned long long c1 = __builtin_amdgcn_s_memtime(), r1 = __builtin_amdgcn_s_memrealtime();
        if (wave == 0 && CUR_LANE() == 0) { stp[3] = c1 - c0; stp[4] = r1 - r0; }
#else
        pg8::gemm_phase(lds, ws, wave, D, D, D, S, E);
#endif
        if (MK_DUP == 14) pg8::gemm_phase(lds, ws, wave, D, D, D, S, E);
        SEAM(9);
    }
    if (IN(10)) {
        GridSched S{(unsigned)WS_ACT, (unsigned)WS_WD2, 256u * DFF * 2u, 256u * DFF * 2u, 64, 8, G, bx};
        EpiRes E{XB, SS3, 0.5f, nullptr};
        pg8::gemm_phase(lds, ws, wave, DFF, DFF, DFF, S, E);
        SEAM(10);
    }
    if (IN(11)) {
        PHASE_LANE;
        const float* fg = args.in[I_FN];
        for (int m = gw; m < M; m += NGW) {
            const GAS v4u* xr = (const GAS v4u*)(XB + (size_t)m * D) + lane; GAS f32x4* orow = (GAS f32x4*)(out + (size_t)m * D); const GAS f32x4* gr = (const GAS f32x4*)fg;
            const float rs = 1.0f / sqrtf(SS3[m] * (1.0f / D) + EPS);
#pragma unroll
            for (int j = 0; j < 4; ++j) { const v4u w = xr[64 * j]; const int c = (64 * j + lane) * 2; const f32x4 g0 = gr[c], g1 = gr[c + 1];
                orow[c] = (f32x4){bflo(w.x) * rs * g0.x, bfhi(w.x) * rs * g0.y, bflo(w.y) * rs * g0.z, bfhi(w.y) * rs * g0.w};
                orow[c + 1] = (f32x4){bflo(w.z) * rs * g1.x, bfhi(w.z) * rs * g1.y, bflo(w.w) * rs * g1.z, bfhi(w.w) * rs * g1.w}; }
        }
#if MK_STAMP
        { const unsigned long long* stp = (const unsigned long long*)(ws + CTL_DBG);
          const float kc = (float)stp[0], ec = (float)stp[1], nun = (float)stp[2], cyc = (float)stp[3], rt = (float)stp[4];
          float c = 0.f;
          if (MK_STAMP == 1) c = floorf(4.0f * log2f(cyc / rt * 100.0f)) - 36.0f;
          if (MK_STAMP == 2) c = floorf(12.0f * log2f(kc / (nun * 32.0f))) - 120.0f;
          if (MK_STAMP == 3) c = floorf(8.0f * log2f(ec / nun)) - 90.0f;
          if (MK_STAMP == 4) c = floorf(12.0f * log2f(cyc / nun)) - 180.0f;
          if (MK_STAMP == 5) { const float us = (float)(stp[32 + MK_STAMP_B] - stp[32 + MK_STAMP_A]) * 0.01f; c = floorf(12.0f * log2f(us)) - 50.0f; }
          __syncthreads();
          for (int m = gw; m < M; m += NGW) { GAS f32x4* xr = (GAS f32x4*)(out + (size_t)m * D) + lane;
#pragma unroll
              for (int j = 0; j < 8; ++j) xr[64 * j] = (f32x4){c, c, c, c}; } }
#endif
    }
#undef IN
#undef SEAM
}
constexpr int LAST_PHASE = 12;


#if MK_DEBUG
constexpr size_t WS_DBG = 548 * MiB;
constexpr size_t DBG_SAVE = WS_DBG;
constexpr size_t DBG_QREF = WS_DBG + 2 * MiB, DBG_KREF = WS_DBG + 3 * MiB, DBG_VREF = WS_DBG + 4 * MiB, DBG_OREF = WS_DBG + 6 * MiB, DBG_AREF = WS_DBG + 8 * MiB;
constexpr int NSAVE = 64;
__device__ __forceinline__ unsigned hsh(unsigned a) { a ^= a >> 16; a *= 0x7feb352dU; a ^= a >> 15; a *= 0x846ca68bU; a ^= a >> 16; return a; }
__device__ __forceinline__ int save_row(int i) { return (int)(hsh(1000u + i) % M); }
__device__ __forceinline__ float block_sum(float v) {
    __shared__ float red[4]; __shared__ float tot;
    v = wave_sum(v); __syncthreads(); if ((threadIdx.x & 63) == 0) red[threadIdx.x >> 6] = v; __syncthreads();
    if (threadIdx.x == 0) tot = (red[0] + red[1]) + (red[2] + red[3]); __syncthreads(); return tot;
}
__device__ __forceinline__ float block_max(float v) {
    __shared__ float redm[4]; __shared__ float totm;
#pragma unroll
    for (int o = 1; o < 64; o <<= 1) v = fmaxf(v, __shfl_xor(v, o));
    __syncthreads(); if ((threadIdx.x & 63) == 0) redm[threadIdx.x >> 6] = v; __syncthreads();
    if (threadIdx.x == 0) totm = fmaxf(fmaxf(redm[0], redm[1]), fmaxf(redm[2], redm[3])); __syncthreads(); return totm;
}
__device__ __forceinline__ void dbg_add(float* dbg, int id, float got, float exp) { const float d = got - exp; atomicAdd(dbg + 2 * id, d * d); atomicAdd(dbg + 2 * id + 1, exp * exp); }
__device__ __forceinline__ float bdot(const bf16* a, const float* w, int ldw, int K, const float* gain) {
    float s = 0.f; for (int k = threadIdx.x; k < K; k += 256) s += bf2f(a[k]) * w[(size_t)k * ldw] * (gain ? gain[k] : 1.0f); return block_sum(s);
}
__device__ __forceinline__ float geluf_(float v) { return 0.5f * v * (1.0f + erff(v * 0.70710678f)); }
__device__ __forceinline__ float rsof(const float* ss, int r) { return 1.0f / sqrtf(ss[r] * (1.0f / D) + EPS); }

__global__ void chk_wt(const bf16* WT, int ldk, int nrows, const float* src, const float* src2, int ldw, int mode, const float* gain, float* dbg, int id) {
    const unsigned i = blockIdx.x * 256 + threadIdx.x; const int n = hsh(i * 2 + 1) % nrows, k = hsh(i * 2 + 2) % ldk;
    const float* s = src; int col = n;
    if (mode == 1) { const int tile = n / 256, w = n % 256; s = w < 128 ? src : src2; col = 128 * tile + (w & 127); }
    if (mode == 2) col = n < 3072 ? n : n + 16;
    if (mode == 3) col = 3072 + n;
    dbg_add(dbg, id, bf2f(WT[(size_t)n * ldk + k]), s[(size_t)k * ldw + col] * (gain ? gain[k] : 1.0f));
}
__global__ void chk_rms(const float* x, const float* gain, const bf16* xb, int nrows, float* dbg, int id) {
    const int r = hsh(77u + blockIdx.x) % nrows; float s = 0.f;
    for (int k = threadIdx.x; k < D; k += 256) { const float v = x[(size_t)r * D + k]; s += v * v; }
    const float rs = 1.0f / sqrtf(block_sum(s) * (1.0f / D) + EPS);
    for (int k = threadIdx.x; k < D; k += 256) dbg_add(dbg, id, bf2f(xb[(size_t)r * D + k]), x[(size_t)r * D + k] * rs * gain[k]);
}
__global__ void chk_act(const bf16* XBp, const float* wg, const float* wu, const float* gain, const float* ss, const bf16* ACTp, float* dbg, int id) {
    const int row = hsh(3u * blockIdx.x + 11u) % M, hid = hsh(3u * blockIdx.x + 12u) % DFF;
    float g = bdot(XBp + (size_t)row * D, wg + hid, DFF, D, gain), u = bdot(XBp + (size_t)row * D, wu + hid, DFF, D, gain);
    if (ss) { const float s = rsof(ss, row); g *= s; u *= s; }
    if (threadIdx.x == 0) dbg_add(dbg, id, bf2f(ACTp[(size_t)row * DFF + hid]), g / (1.0f + expf(-g)) * u);
}
__global__ void chk_kv(const bf16* MEMBp, const float* wkv, const bf16* KBp, const bf16* VTp, float* dbg, int idk, int idv) {
    const int row = hsh(5u * blockIdx.x + 1u) % MROWS, col = hsh(5u * blockIdx.x + 2u) % 2048;
    const float v = bdot(MEMBp + (size_t)row * D, wkv + col, D, D, nullptr);
    if (threadIdx.x == 0) { if (col < 1024) dbg_add(dbg, idk, bf2f(KBp[(size_t)row * 1024 + col]), v); else dbg_add(dbg, idv, bf2f(VTp[(size_t)(col - 1024) * 2048 + row]), v); }
}
__global__ void save_rows(const float* src, float* dst) { const int r = save_row(blockIdx.x); for (int k = threadIdx.x; k < D; k += 256) dst[(size_t)blockIdx.x * D + k] = src[(size_t)r * D + k]; }
__global__ void chk_res(const float* base, int base_saved, const bf16* a, int K, const float* w, float alpha, const float* outp, const bf16* xb, float* dbg, int id, int idb) {
    const int si = blockIdx.x % NSAVE, row = save_row(si), col = hsh(7u * blockIdx.x + 3u) % D;
    const float b = base_saved ? base[(size_t)si * D + col] : base[(size_t)row * D + col];
    const float v = b + alpha * bdot(a + (size_t)row * K, w + col, D, K, nullptr);
    if (threadIdx.x == 0) { dbg_add(dbg, id, outp[(size_t)row * D + col], v); if (xb) dbg_add(dbg, idb, bf2f(xb[(size_t)row * D + col]), v); }
}
__global__ void chk_ss(const float* outp, const float* ss, float* dbg, int id) {
    const int row = hsh(91u + blockIdx.x) % M; float s = 0.f;
    for (int k = threadIdx.x; k < D; k += 256) { const float v = outp[(size_t)row * D + k]; s += v * v; }
    s = block_sum(s); if (threadIdx.x == 0) dbg_add(dbg, id, ss[row], s);
}
__global__ void chk_proj(const bf16* XBp, const float* win, const float* mixn, const float* ss, const unsigned char* ws, float* dbg, int id, int idg) {
    const int row = hsh(9u * blockIdx.x + 1u) % M, j = hsh(9u * blockIdx.x + 2u) % (NPROJ + 16);
    const int srccol = j < 3072 ? j : (j < NPROJ ? j + 16 : 3072 + (j - NPROJ));
    float v = rsof(ss, row) * bdot(XBp + (size_t)row * D, win + srccol, INW, D, mixn);
    if (threadIdx.x != 0) return;
    if (j >= NPROJ) { dbg_add(dbg, idg, ((const float*)(ws + WS_GLR))[(size_t)row * 16 + (j - NPROJ)], v); return; }
    float got;
    if (j < 512) got = bf2f(((const bf16*)(ws + WS_Q))[(size_t)row * 512 + j]);
    else if (j < 1024) got = bf2f(((const bf16*)(ws + WS_K))[(size_t)row * 512 + j - 512]);
    else if (j < 2048) got = bf2f(((const bf16*)(ws + WS_V))[(size_t)row * 1024 + j - 1024]);
    else if (j < 3072) got = bf2f(((const bf16*)(ws + WS_R))[(size_t)row * 1024 + j - 2048]);
    else if (j < 4096) { got = bf2f(((const bf16*)(ws + WS_SU))[(size_t)row * 1024 + j - 3072]); v = geluf_(v); }
    else if (j < 5120) { got = bf2f(((const bf16*)(ws + WS_SV))[(size_t)row * 1024 + j - 4096]); v = geluf_(v); }
    else got = bf2f(((const bf16*)(ws + WS_XQ))[(size_t)row * 1024 + j - 5120]);
    dbg_add(dbg, id, got, v);
}
__global__ void chk_sg(const bf16* XBp, const float* win, const float* mixn, const float* ss, const bf16* SVp, const bf16* Ysg, const float* lng, const float* lnb, const float* wsp, const float* bsp, float* dbg, int id) {
    const int tok = hsh(13u * blockIdx.x + 1u) % M, g = hsh(13u * blockIdx.x + 2u) % 4, c = hsh(13u * blockIdx.x + 3u) % 256;
    const int t = tok % 128, tok0 = tok - t;
    const float su = geluf_(rsof(ss, tok) * bdot(XBp + (size_t)tok * D, win + 3088 + g * 256 + c, INW, D, mixn));
    float part = 0.f;
    if (threadIdx.x <= t && threadIdx.x < 128) { const int s = threadIdx.x; const bf16* p = SVp + (size_t)(tok0 + s) * 1024 + g * 256; float s1 = 0.f, s2 = 0.f;
        for (int k = 0; k < 256; ++k) { const float v = bf2f(p[k]); s1 += v; s2 += v * v; }
        const float mu = s1 / 256.0f, var = fmaxf(s2 / 256.0f - mu * mu, 0.f);
        const float vn = (bf2f(p[c]) - mu) / sqrtf(var + EPS) * lng[g * 256 + c] + lnb[g * 256 + c];
        part = wsp[((size_t)g * 128 + t) * 128 + s] * vn; }
    const float acc = block_sum(part);
    if (threadIdx.x == 0) dbg_add(dbg, id, bf2f(Ysg[(size_t)tok * 1024 + g * 256 + c]), su * (acc + bsp[g * 128 + t]));
}
__global__ void chk_xa(const bf16* XBp, const float* win, const float* mixn, const float* ss, const bf16* KBp, const bf16* VTp, const bf16* Yxa, float* dbg, int id) {
    __shared__ float qsh[256];
    const int tok = hsh(17u * blockIdx.x + 1u) % M, h = hsh(17u * blockIdx.x + 2u) % 4, e = hsh(17u * blockIdx.x + 3u) % 256, b = tok / SEQ;
    { const int d = threadIdx.x; float s = 0.f; const bf16* a = XBp + (size_t)tok * D; const float* w = win + 5136 + h * 256 + d;
      for (int k = 0; k < D; ++k) s += bf2f(a[k]) * w[(size_t)k * INW] * mixn[k];
      qsh[d] = s * rsof(ss, tok); }
    __syncthreads();
    const int m = threadIdx.x; float sc = 0.f; const bf16* kp = KBp + (size_t)(b * 256 + m) * 1024 + h * 256;
    for (int d = 0; d < 256; ++d) sc += qsh[d] * bf2f(kp[d]);
    sc *= 0.0625f;
    const float mx = block_max(sc), p = expf(sc - mx), sum = block_sum(p);
    const float o = block_sum(p * bf2f(VTp[(size_t)(h * 256 + e) * 2048 + b * 256 + m])) / sum;
    if (threadIdx.x == 0) dbg_add(dbg, id, bf2f(Yxa[(size_t)tok * 1024 + h * 256 + e]), o);
}
__global__ void gla_refA(const bf16* XBp, const float* win, const float* mixn, const float* ss, const float* GLRp, const float* wup, const float* gbias, int b, int h, float* qref, float* kref, float* vref, float* aref) {
    const int t = blockIdx.x, tok = b * SEQ + t; const bf16* a = XBp + (size_t)tok * D; const float rs = rsof(ss, tok);
    for (int o = threadIdx.x; o < 512; o += 256) {
        const int srccol = o < 128 ? h * 128 + o : (o < 256 ? 512 + h * 128 + (o - 128) : 1024 + h * 256 + (o - 256));
        float s = 0.f; const float* w = win + srccol; for (int k = 0; k < D; ++k) s += bf2f(a[k]) * w[(size_t)k * INW] * mixn[k];
        s *= rs; if (o < 128) qref[t * 128 + o] = s; else if (o < 256) kref[t * 128 + o - 128] = s; else vref[t * 256 + o - 256] = s;
    }
    if (threadIdx.x < 128) { const int d = threadIdx.x; float z = gbias[h * 128 + d]; for (int r = 0; r < 16; ++r) z += GLRp[(size_t)tok * 16 + r] * wup[r * 512 + h * 128 + d];
        const float ls = fminf(z, 0.f) - log1pf(expf(-fabsf(z))); aref[t * 128 + d] = expf(ls / 16.0f); }
}
__global__ void gla_refB(const float* qref, const float* kref, const float* vref, const float* aref, float* oref) {
    const int e = blockIdx.x, d = threadIdx.x & 127; const bool act = threadIdx.x < 128; float S = 0.f;
    for (int t = 0; t < SEQ; ++t) { float p = 0.f; if (act) { S = aref[t * 128 + d] * S + kref[t * 128 + d] * vref[t * 256 + e]; p = qref[t * 128 + d] * GLA_SCALE * S; }
        const float o = block_sum(p); if (threadIdx.x == 0) oref[t * 256 + e] = o; }
}
__global__ void gla_refC(const float* oref, const bf16* Rp, const bf16* Ygla, const float* onorm, int b, int h, float* dbg, int id) {
    const int t = blockIdx.x, e = threadIdx.x, tok = b * SEQ + t; const float o = oref[t * 256 + e];
    const float rs = 1.0f / sqrtf(block_sum(o * o) / 256.0f + EPS); const float r = bf2f(Rp[(size_t)tok * 1024 + h * 256 + e]);
    dbg_add(dbg, id, bf2f(Ygla[(size_t)tok * 1024 + h * 256 + e]), o * rs * onorm[h * 256 + e] * (r / (1.0f + expf(-r))));
}
__global__ void chk_gate(const bf16* XBp, const float* win, const float* mixn, const float* ss, const bf16* GTp, int i, float* dbg, int id) {
    const int row = hsh(19u * blockIdx.x + 1u) % M, col = hsh(19u * blockIdx.x + 2u) % D;
    const float v = rsof(ss, row) * bdot(XBp + (size_t)row * D, win + 6160 + i * D + col, INW, D, mixn);
    if (threadIdx.x == 0) dbg_add(dbg, id, bf2f(GTp[(size_t)row * D + col]), 1.0f / (1.0f + expf(-v)));
}
__global__ void chk_mrg(const bf16* XBp, const float* win, const float* mixn, const float* ss, const bf16* Y0, const bf16* Y1, const bf16* Y2, const float* wbr, const bf16* MRGp, float* dbg, int id) {
    const int row = hsh(23u * blockIdx.x + 1u) % M, col = hsh(23u * blockIdx.x + 2u) % D; float tot = 0.f;
    for (int i = 0; i < 3; ++i) { const float gp = rsof(ss, row) * bdot(XBp + (size_t)row * D, win + 6160 + i * D + col, INW, D, mixn);
        const bf16* Y = i == 0 ? Y0 : (i == 1 ? Y1 : Y2); const float z = bdot(Y + (size_t)row * 1024, wbr + (size_t)i * 1024 * D + col, D, 1024, nullptr);
        tot += z / (1.0f + expf(-gp)); }
    if (threadIdx.x == 0) dbg_add(dbg, id, bf2f(MRGp[(size_t)row * D + col]), tot);
}
__global__ void chk_final(const float* saved, const float* fn, const float* outp, float* dbg, int id) {
    const int si = blockIdx.x, row = save_row(si); float s = 0.f;
    for (int k = threadIdx.x; k < D; k += 256) { const float v = saved[(size_t)si * D + k]; s += v * v; }
    const float rs = 1.0f / sqrtf(block_sum(s) * (1.0f / D) + EPS);
    for (int k = threadIdx.x; k < D; k += 256) dbg_add(dbg, id, outp[(size_t)row * D + k], saved[(size_t)si * D + k] * rs * fn[k]);
}
__global__ void dbg_report(const float* dbg, float* outp, int nchk, int only) {
    int bad = -1;
    for (int k = 0; k < nchk; ++k) { const float num = dbg[2 * k], den = dbg[2 * k + 1]; if (num == 0.f && den == 0.f) continue; if (!(num < 1e-3f * den)) { bad = k; break; } }
    if (only >= 0) { const float num = dbg[2 * only], den = dbg[2 * only + 1]; bad = -1; if (!(num < 1e-3f * den)) bad = only; }
    if (bad < 0) return;
    const float c = (float)(bad + 2);
    for (size_t i = (size_t)blockIdx.x * 256 + threadIdx.x; i < (size_t)M * D; i += (size_t)gridDim.x * 256) outp[i] = c;
}
#endif

extern "C" void kernel_launch(void* const* d_in, const int* in_sizes, int n_in, void* d_out, int out_size, void* d_ws, size_t ws_size, hipStream_t stream) {
    static int grid = 0;
    if (grid == 0) {
        if (n_in != N_IN || in_sizes[0] != M * D || out_size != M * D || ws_size < WS_END) {
            fprintf(stderr, "kernel_launch: unexpected problem (n_in %d, in0 %d, out %d, ws %zu, need %zu); nothing launched\n", n_in, n_in > 0 ? in_sizes[0] : -1, out_size, ws_size, (size_t)WS_END); grid = -1; return; }
        int dev = 0, cus = 0, per_cu = 0;
        if (hipGetDevice(&dev) != hipSuccess || hipDeviceGetAttribute(&cus, hipDeviceAttributeMultiprocessorCount, dev) != hipSuccess) { grid = -1; return; }
        if (hipFuncSetAttribute((const void*)mk_fwd, hipFuncAttributeMaxDynamicSharedMemorySize, LDS_BYTES) != hipSuccess) { fprintf(stderr, "kernel_launch: hipFuncSetAttribute failed\n"); grid = -1; return; }
        if (hipOccupancyMaxActiveBlocksPerMultiprocessor(&per_cu, (const void*)mk_fwd, NTHREADS, LDS_BYTES) != hipSuccess || per_cu < 1)
            fprintf(stderr, "kernel_launch: note: occupancy query reports %d workgroups per CU\n", per_cu);
        (void)hipGetLastError();
        if (cus < 256) { fprintf(stderr, "kernel_launch: %d CUs; this kernel needs 256 resident workgroups (one per CU); nothing launched\n", cus); grid = -1; return; }
        grid = 256;
    }
    if (grid < 0) return;
    if (hipMemsetAsync((char*)d_ws + WS_CTL, 0, CTL_ZERO_BYTES, stream) != hipSuccess) return;
    Args a{};
    for (int i = 0; i < N_IN; ++i) a.in[i] = (const float*)d_in[i];
    a.out = (float*)d_out; a.ws = (unsigned char*)d_ws;
#if MK_PER_PHASE
    for (int p = 0; p < LAST_PHASE; ++p) { a.ph_lo = p; a.ph_hi = p + 1; hipLaunchKernelGGL(mk_fwd, dim3(grid), dim3(NTHREADS), LDS_BYTES, stream, a);
#if MK_DEBUG
        unsigned char* ws = (unsigned char*)d_ws; float* dbg = (float*)(ws + CTL_DBG); const float** in = (const float**)a.in; float* outp = (float*)d_out;
        const bf16* XBp = (const bf16*)(ws + WS_XB); const float* SS1p = (const float*)(ws + CTL_SS1); const float* SS2p = (const float*)(ws + CTL_SS2);
        float* sv1 = (float*)(ws + DBG_SAVE); float* sv2 = sv1 + NSAVE * D; float* sv3 = sv2 + NSAVE * D;
        if (p == 0) {
            chk_rms<<<64, 256, 0, stream>>>(in[I_X], in[I_F1N], XBp, M, dbg, 0);
            chk_wt<<<64, 256, 0, stream>>>((const bf16*)(ws + WS_WGU1), D, NGU, in[I_F1G], in[I_F1U], DFF, 1, nullptr, dbg, 1);
            chk_wt<<<64, 256, 0, stream>>>((const bf16*)(ws + WS_WIN), D, 12288, in[I_WIN], nullptr, INW, 2, in[I_MIXN], dbg, 2);
            chk_wt<<<64, 256, 0, stream>>>((const bf16*)(ws + WS_WD1), DFF, D, in[I_F1D], nullptr, D, 0, nullptr, dbg, 3);
            chk_wt<<<64, 256, 0, stream>>>((const bf16*)(ws + WS_WKV), D, D, in[I_WKV], nullptr, D, 0, nullptr, dbg, 4);
            for (int i = 0; i < 3; ++i) chk_wt<<<32, 256, 0, stream>>>((const bf16*)(ws + WS_WB) + (size_t)i * D * 1024, 1024, D, in[I_WBR] + (size_t)i * 1024 * D, nullptr, D, 0, nullptr, dbg, 5);
            chk_wt<<<64, 256, 0, stream>>>((const bf16*)(ws + WS_WO), D, D, in[I_WOUT], nullptr, D, 0, nullptr, dbg, 6);
            chk_wt<<<64, 256, 0, stream>>>((const bf16*)(ws + WS_WGU2), D, NGU, in[I_F2G], in[I_F2U], DFF, 1, in[I_F2N], dbg, 7);
            chk_wt<<<64, 256, 0, stream>>>((const bf16*)(ws + WS_WD2), DFF, D, in[I_F2D], nullptr, D, 0, nullptr, dbg, 8);
            chk_rms<<<64, 256, 0, stream>>>(in[I_MEM], in[I_MEMN], (const bf16*)(ws + WS_MEMB), MROWS, dbg, 9);
            chk_wt<<<16, 256, 0, stream>>>((const bf16*)(ws + WS_WGLR), D, 16, in[I_WIN], nullptr, INW, 3, in[I_MIXN], dbg, 10);
        }
        if (p == 1) { chk_act<<<512, 256, 0, stream>>>(XBp, in[I_F1G], in[I_F1U], nullptr, nullptr, (const bf16*)(ws + WS_ACT), dbg, 11);
            chk_kv<<<512, 256, 0, stream>>>((const bf16*)(ws + WS_MEMB), in[I_WKV], (const bf16*)(ws + WS_KB), (const bf16*)(ws + WS_VT), dbg, 12, 13); }
        if (p == 2) { chk_res<<<512, 256, 0, stream>>>(in[I_X], 0, (const bf16*)(ws + WS_ACT), DFF, in[I_F1D], 0.5f, outp, XBp, dbg, 14, 15);
            chk_ss<<<64, 256, 0, stream>>>(outp, SS1p, dbg, 16); save_rows<<<NSAVE, 256, 0, stream>>>(outp, sv1); }
        if (p == 3) chk_proj<<<1024, 256, 0, stream>>>(XBp, in[I_WIN], in[I_MIXN], SS1p, ws, dbg, 17, 18);
        if (p == 6) {
            chk_sg<<<256, 256, 0, stream>>>(XBp, in[I_WIN], in[I_MIXN], SS1p, (const bf16*)(ws + WS_SV), (const bf16*)(ws + WS_SU), in[I_LNG], in[I_LNB], in[I_WS], in[I_BS], dbg, 19);
            chk_xa<<<256, 256, 0, stream>>>(XBp, in[I_WIN], in[I_MIXN], SS1p, (const bf16*)(ws + WS_KB), (const bf16*)(ws + WS_VT), (const bf16*)(ws + WS_XQ), dbg, 20);
            const int gb = 3, gh = 2; float* qr = (float*)(ws + DBG_QREF); float* kr = (float*)(ws + DBG_KREF); float* vr = (float*)(ws + DBG_VREF); float* orf = (float*)(ws + DBG_OREF); float* ar = (float*)(ws + DBG_AREF);
            gla_refA<<<SEQ, 256, 0, stream>>>(XBp, in[I_WIN], in[I_MIXN], SS1p, (const float*)(ws + WS_GLR), in[I_GUP], in[I_GB], gb, gh, qr, kr, vr, ar);
            gla_refB<<<256, 256, 0, stream>>>(qr, kr, vr, ar, orf);
            gla_refC<<<SEQ, 256, 0, stream>>>(orf, (const bf16*)(ws + WS_R), (const bf16*)(ws + WS_V), in[I_GON], gb, gh, dbg, 21);
        }
        if (p == 7 || p == 9 || p == 11) chk_gate<<<256, 256, 0, stream>>>(XBp, in[I_WIN], in[I_MIXN], SS1p, (const bf16*)(ws + WS_G), (p - 7) / 2, dbg, 22 + (p - 7) / 2);
        if (p == 12) chk_mrg<<<256, 256, 0, stream>>>(XBp, in[I_WIN], in[I_MIXN], SS1p, (const bf16*)(ws + WS_V), (const bf16*)(ws + WS_SU), (const bf16*)(ws + WS_XQ), in[I_WBR], (const bf16*)(ws + WS_MRG), dbg, 25);
        if (p == 13) { chk_res<<<512, 256, 0, stream>>>(sv1, 1, (const bf16*)(ws + WS_MRG), D, in[I_WOUT], 1.0f, outp, XBp, dbg, 26, 27);
            chk_ss<<<64, 256, 0, stream>>>(outp, SS2p, dbg, 28); save_rows<<<NSAVE, 256, 0, stream>>>(outp, sv2); }
        if (p == 14) chk_act<<<512, 256, 0, stream>>>(XBp, in[I_F2G], in[I_F2U], in[I_F2N], SS2p, (const bf16*)(ws + WS_ACT), dbg, 29);
        if (p == 15) { chk_res<<<512, 256, 0, stream>>>(sv2, 1, (const bf16*)(ws + WS_ACT), DFF, in[I_F2D], 0.5f, outp, nullptr, dbg, 30, 30); save_rows<<<NSAVE, 256, 0, stream>>>(outp, sv3); }
        if (p == 16) { chk_final<<<NSAVE, 256, 0, stream>>>(sv3, in[I_FN], outp, dbg, 31); dbg_report<<<1024, 256, 0, stream>>>(dbg, outp, 32, MK_DEBUG_ONLY); }
#endif
    }
#else
    a.ph_lo = 0; a.ph_hi = LAST_PHASE;
    hipLaunchKernelGGL(mk_fwd, dim3(grid), dim3(NTHREADS), LDS_BYTES, stream, a);
#endif
}
```
